# Optimizing an MI355X kernel written in HIP

```python
import math
import jax, jax.numpy as jnp
from jax import lax
import numpy as np

D_MODEL = 1024
BATCH = 32
SEQ = 256
DEPTH = 4
DEC_BATCH = 8
DEC_SEQ = 4096
PAST_LEN = 512

GRID_W = 64
W_HY = 512
HY_ORDER = 2
HY_BANDS = 8
HY_POS_FEAT = 1 + 2 * HY_BANDS
HY_FILT_HID = 64
HY_DECAY_TARGET = 1e-2
HY_FAST_PCT = 0.3
HY_SLOW_PCT = 1.5
ATT_HEADS = 8
ATT_KV_HEADS = 2
ATT_GROUP = ATT_HEADS // ATT_KV_HEADS
HEAD_DIM = 64
W_ATT = ATT_HEADS * HEAD_DIM
W_KV = ATT_KV_HEADS * HEAD_DIM
ATT_WINDOW = 128
BLOCK = 128
RET_HEADS = 8
RET_DIM = 64
W_RET = RET_HEADS * RET_DIM
RET_CHUNK = 128
ROPE_BASE = 10000.0
EPS = 1e-6
NEG = -1e30
N_BRANCH = 3
IN_SPLITS = (3 * W_HY, W_HY, W_ATT, W_KV, W_KV, W_ATT, W_RET, W_RET, W_RET, W_RET)
IN_DIM = sum(IN_SPLITS)

kernel_name = "hybrid_hyena_gqa_retention_diffusion_step"


def rmsnorm(x, w):
    xf = x.astype(jnp.float32)
    return xf * lax.rsqrt(jnp.mean(xf * xf, axis=-1, keepdims=True) + EPS) * w.astype(jnp.float32)


def adaln(cond, w_mod, b_mod):
    mod = (jax.nn.silu(cond) @ w_mod + b_mod).astype(jnp.float32)
    shift, scale, gate = jnp.split(mod[:, None, :], 3, axis=-1)
    return shift, scale, gate


def axial_rope_tables(L):
    rows = L // GRID_W
    row = jnp.repeat(jnp.arange(rows), GRID_W).astype(jnp.float32)
    col = jnp.tile(jnp.arange(GRID_W), rows).astype(jnp.float32)
    quarter = HEAD_DIM // 4
    inv = ROPE_BASE ** (-jnp.arange(quarter, dtype=jnp.float32) / quarter)
    ang = jnp.concatenate([row[:, None] * inv, col[:, None] * inv], axis=-1)
    return jnp.cos(ang), jnp.sin(ang)


def apply_axial_rope(x, rope):
    cos, sin = rope
    q = HEAD_DIM // 4

    def rot(hx, c, s):
        h1, h2 = hx[..., :q], hx[..., q:]
        return jnp.concatenate([h1 * c - h2 * s, h1 * s + h2 * c], axis=-1)

    xf = x.astype(jnp.float32)
    xr = rot(xf[..., :2 * q], cos[:, None, :q], sin[:, None, :q])
    xc = rot(xf[..., 2 * q:], cos[:, None, q:], sin[:, None, q:])
    return jnp.concatenate([xr, xc], axis=-1)


def short_conv(u, w):
    L = u.shape[1]
    up = jnp.pad(u, ((0, 0), (1, 1), (0, 0)))
    return up[:, :L] * w[0] + up[:, 1:L + 1] * w[1] + up[:, 2:] * w[2]


def hyena_filters(L, w1, b1, freq, w2):
    t = jnp.linspace(0.0, 1.0, L, dtype=jnp.float32)[:, None]
    w = 2.0 * math.pi * jnp.arange(L, dtype=jnp.float32)[:, None] / L
    f = jnp.linspace(1e-4, HY_BANDS - 1, HY_BANDS, dtype=jnp.float32)[None, :]
    z = jnp.concatenate([t, jnp.cos(f * w), -jnp.sin(f * w)], axis=-1)
    hid = jnp.sin(freq.astype(jnp.float32) * (z @ w1.astype(jnp.float32) + b1.astype(jnp.float32)))
    h = (hid @ w2.astype(jnp.float32)).reshape(L, HY_ORDER, 2, W_HY)
    max_decay = math.log(HY_DECAY_TARGET) / HY_FAST_PCT
    min_decay = math.log(HY_DECAY_TARGET) / HY_SLOW_PCT
    deltas = jnp.linspace(min_decay, max_decay, W_HY, dtype=jnp.float32)
    window = jnp.exp(-t * jnp.abs(deltas))
    h = h * window[:, None, None, :]
    return h / jnp.sum(jnp.abs(h), axis=(0, 2), keepdims=True)


def fft_conv(u, h):
    L = u.shape[1]
    uf = jnp.fft.rfft(u, n=2 * L, axis=1)
    hf = jnp.fft.rfft(h, n=2 * L, axis=0)
    return jnp.fft.irfft(uf * hf[None], n=2 * L, axis=1)[:, :L]


def bidir_long_conv(u, h_fwd, h_bwd, skip):
    fwd = fft_conv(u, h_fwd)
    bwd = jnp.flip(fft_conv(jnp.flip(u, axis=1), h_bwd), axis=1)
    return fwd + bwd + u * skip.astype(jnp.float32)


def hyena_branch(u, conv_w, w1, b1, freq, w2, skip):
    L = u.shape[1]
    u = short_conv(u, conv_w).astype(jnp.float32)
    v, x1, x2 = jnp.split(u, 3, axis=-1)
    h = hyena_filters(L, w1, b1, freq, w2)
    z = x1 * bidir_long_conv(v, h[:, 0, 0], h[:, 0, 1], skip[0])
    z = x2 * bidir_long_conv(z, h[:, 1, 0], h[:, 1, 1], skip[1])
    return z


def sink_attend(q, k, v, bias, sink):
    s = jnp.einsum('bqhgd,bkhd->bhgqk', q.astype(jnp.float32), k.astype(jnp.float32)) * (HEAD_DIM ** -0.5)
    if bias is not None:
        s = s + bias
    sk = sink.astype(jnp.float32)[None, :, :, None, None]
    m = jnp.maximum(jnp.max(s, axis=-1, keepdims=True), sk)
    p = jnp.exp(s - m)
    denom = jnp.sum(p, axis=-1, keepdims=True) + jnp.exp(sk - m)
    return jnp.einsum('bhgqk,bkhd->bqhgd', p / denom, v.astype(jnp.float32))


def context_attention(q, k, v, sink):
    B, Lc = q.shape[:2]
    nb = Lc // BLOCK
    qb = q.reshape(B, nb, BLOCK, ATT_KV_HEADS, ATT_GROUP, HEAD_DIM).transpose(1, 0, 2, 3, 4, 5)
    out = lax.map(lambda qi: sink_attend(qi, k, v, None, sink), qb)
    return out.transpose(1, 0, 2, 3, 4, 5).reshape(B, Lc, W_ATT)


def latent_attention(q, k, v, k_ctx, v_ctx, sink):
    B, L = q.shape[:2]
    nb = L // BLOCK
    span = BLOCK + 2 * ATT_WINDOW
    q = q.astype(jnp.float32)
    kp = jnp.pad(k.astype(jnp.float32), ((0, 0), (ATT_WINDOW, ATT_WINDOW), (0, 0), (0, 0)))
    vp = jnp.pad(v.astype(jnp.float32), ((0, 0), (ATT_WINDOW, ATT_WINDOW), (0, 0), (0, 0)))
    kc = k_ctx.astype(jnp.float32)
    vc = v_ctx.astype(jnp.float32)
    rel = (jnp.arange(span)[None, :] - ATT_WINDOW) - jnp.arange(BLOCK)[:, None]
    band_ok = jnp.abs(rel) <= ATT_WINDOW
    ctx_bias = jnp.zeros((BLOCK, kc.shape[1]), jnp.float32)

    def blk(i):
        start = i * BLOCK
        qi = lax.dynamic_slice_in_dim(q, start, BLOCK, axis=1)
        ki = lax.dynamic_slice_in_dim(kp, start, span, axis=1)
        vi = lax.dynamic_slice_in_dim(vp, start, span, axis=1)
        key_abs = start - ATT_WINDOW + jnp.arange(span)
        ok = band_ok & ((key_abs >= 0) & (key_abs < L))[None, :]
        bias = jnp.concatenate([jnp.where(ok, 0.0, NEG).astype(jnp.float32), ctx_bias], axis=1)
        kk = jnp.concatenate([ki, kc], axis=1)
        vv = jnp.concatenate([vi, vc], axis=1)
        return sink_attend(qi, kk, vv, bias, sink)

    out = lax.map(blk, jnp.arange(nb))
    return out.transpose(1, 0, 2, 3, 4, 5).reshape(B, L, W_ATT)


def retention_scan(q, k, v, log_g, s0):
    B, L, H, D = q.shape
    C = RET_CHUNK
    nc = L // C

    def chunks(a):
        return a.reshape(B, nc, C, H, D).transpose(1, 0, 3, 2, 4)

    i = jnp.arange(C, dtype=jnp.float32)
    lg = log_g[:, None]
    diff = i[:, None] - i[None, :]
    dmat = jnp.where(diff >= 0, jnp.exp(lg[..., None] * jnp.maximum(diff, 0.0)), 0.0)
    q_dec = jnp.exp(lg * (i + 1.0))[..., None]
    k_dec = jnp.exp(lg * (C - 1.0 - i))[..., None]
    c_dec = jnp.exp(lg * float(C))[..., None]

    def step(s, xs):
        qc, kc, vc = xs
        inner = jnp.einsum('bhij,bhjd->bhid', jnp.einsum('bhid,bhjd->bhij', qc, kc) * dmat, vc)
        cross = jnp.einsum('bhid,bhde->bhie', qc * q_dec, s)
        s_new = c_dec * s + jnp.einsum('bhjd,bhje->bhde', kc * k_dec, vc)
        return s_new, inner + cross

    s_fin, o = lax.scan(step, s0.astype(jnp.float32), (chunks(q), chunks(k), chunks(v)))
    return o.transpose(1, 0, 3, 2, 4).reshape(B, L, H, D), s_fin


def retention_branch(q, k, v, theta, gn, s0, rope):
    B, L = q.shape[:2]
    q = q.reshape(B, L, RET_HEADS, RET_DIM).astype(jnp.float32)
    k = k.reshape(B, L, RET_HEADS, RET_DIM).astype(jnp.float32)
    v = v.reshape(B, L, RET_HEADS, RET_DIM).astype(jnp.float32)
    if rope is not None:
        q = apply_axial_rope(q, rope)
        k = apply_axial_rope(k, rope)
    k = k * (RET_DIM ** -0.5)
    lg = jax.nn.log_sigmoid(theta.astype(jnp.float32))
    o_f, s_f = retention_scan(q, k, v, lg[0], s0[:, 0])
    o_b, s_b = retention_scan(jnp.flip(q, 1), jnp.flip(k, 1), jnp.flip(v, 1), lg[1], s0[:, 1])
    o = o_f + jnp.flip(o_b, 1)
    o = o * lax.rsqrt(jnp.mean(o * o, axis=-1, keepdims=True) + EPS)
    o = o.reshape(B, L, W_RET) * gn.astype(jnp.float32)
    return o, jnp.stack([s_f, s_b], axis=1)


def mixer_layer(x, cond, p, rope, ctx):
    B, L, _ = x.shape
    shift, scale, gate = adaln(cond, p['w_mod'], p['b_mod'])
    h = (rmsnorm(x, p['norm_w']) * (1.0 + scale) + shift).astype(x.dtype)
    u = h @ p['w_in']
    idx = np.cumsum(IN_SPLITS)[:-1].tolist()
    hy_in, hy_g, qa, ka, va, ga, qr, kr, vr, gr = jnp.split(u, idx, axis=-1)

    ya = hyena_branch(hy_in, p['hy_conv'], p['hy_filt_w1'], p['hy_filt_b1'], p['hy_filt_freq'],
                      p['hy_filt_w2'], p['hy_skip']) * jax.nn.silu(hy_g.astype(jnp.float32))

    qa = qa.reshape(B, L, ATT_HEADS, HEAD_DIM)
    ka = ka.reshape(B, L, ATT_KV_HEADS, HEAD_DIM)
    va = va.reshape(B, L, ATT_KV_HEADS, HEAD_DIM)
    sink = p['attn_sink'].reshape(ATT_KV_HEADS, ATT_GROUP)
    if ctx is None:
        qg = qa.reshape(B, L, ATT_KV_HEADS, ATT_GROUP, HEAD_DIM)
        yb = context_attention(qg, ka, va, sink)
        s0 = jnp.zeros((B, 2, RET_HEADS, RET_DIM, RET_DIM), jnp.float32)
    else:
        k_ctx, v_ctx, s0 = ctx
        qg = apply_axial_rope(qa, rope).reshape(B, L, ATT_KV_HEADS, ATT_GROUP, HEAD_DIM)
        kg = apply_axial_rope(ka, rope)
        yb = latent_attention(qg, kg, va, k_ctx, v_ctx, sink)
    yb = yb * jax.nn.silu(ga.astype(jnp.float32))

    yc, s_fin = retention_branch(qr, kr, vr, p['ret_theta'], p['ret_gn'], s0, rope)
    yc = yc * jax.nn.silu(gr.astype(jnp.float32))

    g = jax.nn.sigmoid((h @ p['w_merge'] + p['b_merge']).astype(jnp.float32))
    g_a, g_b, g_c = jnp.split(g, N_BRANCH, axis=-1)
    merged = g_a * (ya @ p['w_branch_a']) + g_b * (yb @ p['w_branch_b']) + g_c * (yc @ p['w_branch_c'])
    out = merged @ p['w_out']
    x_new = (x.astype(jnp.float32) + gate * out).astype(x.dtype)
    return x_new, ka, va, s_fin


def setup_inputs(seed: int = 0) -> dict:
    key = jax.random.key(seed)
    ks = jax.random.split(key, 32)
    n = lambda i, shape: jax.random.normal(ks[i], shape, jnp.float32)
    D = D_MODEL
    gam = 1.0 - 2.0 ** (-5.0 - np.arange(RET_HEADS))
    theta0 = jnp.asarray(np.log(gam / (1.0 - gam)), jnp.float32)
    return {
        "x_prompt": n(0, (BATCH, SEQ, D)),
        "x_sample": n(1, (DEC_BATCH, DEC_SEQ, D)),
        "c": n(2, (DEC_BATCH, D)),
        "cache_k": n(3, (DEC_BATCH, DEPTH, PAST_LEN, ATT_KV_HEADS, HEAD_DIM)),
        "cache_v": n(4, (DEC_BATCH, DEPTH, PAST_LEN, ATT_KV_HEADS, HEAD_DIM)),
        "state_ret": n(5, (DEC_BATCH, DEPTH, 2, RET_HEADS, RET_DIM, RET_DIM)),
        "c_ctx": n(6, (D,)),
        "norm_w": 1.0 + 0.02 * n(7, (DEPTH, D)),
        "w_mod": 0.5 * D ** -0.5 * n(8, (DEPTH, D, 3 * D)),
        "b_mod": 0.01 * n(9, (DEPTH, 3 * D)),
        "w_in": D ** -0.5 * n(10, (DEPTH, D, IN_DIM)),
        "hy_conv": 3 ** -0.5 * n(11, (DEPTH, 3, 3 * W_HY)),
        "hy_filt_w1": HY_POS_FEAT ** -0.5 * n(12, (DEPTH, HY_POS_FEAT, HY_FILT_HID)),
        "hy_filt_b1": 0.1 * n(13, (DEPTH, HY_FILT_HID)),
        "hy_filt_freq": 1.0 + 0.1 * n(14, (DEPTH, HY_FILT_HID)),
        "hy_filt_w2": HY_FILT_HID ** -0.5 * n(15, (DEPTH, HY_FILT_HID, HY_ORDER * 2 * W_HY)),
        "hy_skip": 0.5 * n(16, (DEPTH, HY_ORDER, W_HY)),
        "attn_sink": 0.5 * n(17, (DEPTH, ATT_HEADS)),
        "ret_theta": theta0 + 0.1 * n(18, (DEPTH, 2, RET_HEADS)),
        "ret_gn": 1.0 + 0.02 * n(19, (DEPTH, W_RET)),
        "w_branch_a": W_HY ** -0.5 * n(20, (DEPTH, W_HY, D)),
        "w_branch_b": W_ATT ** -0.5 * n(21, (DEPTH, W_ATT, D)),
        "w_branch_c": W_RET ** -0.5 * n(22, (DEPTH, W_RET, D)),
        "w_merge": D ** -0.5 * n(23, (DEPTH, D, N_BRANCH * D)),
        "b_merge": 0.1 * n(24, (DEPTH, N_BRANCH * D)),
        "w_out": D ** -0.5 * n(25, (DEPTH, D, D)),
        "final_norm_w": 1.0 + 0.02 * n(26, (D,)),
    }


def reference(x_prompt, x_sample, c, cache_k, cache_v, state_ret, c_ctx, norm_w, w_mod, b_mod,
              w_in, hy_conv, hy_filt_w1, hy_filt_b1, hy_filt_freq, hy_filt_w2, hy_skip, attn_sink,
              ret_theta, ret_gn, w_branch_a, w_branch_b, w_branch_c, w_merge, b_merge, w_out,
              final_norm_w):
    rope = axial_rope_tables(x_sample.shape[1])
    xp, xs = x_prompt, x_sample
    cond_ctx = c_ctx[None, :]
    ks_out, vs_out, ss_out = [], [], []
    for l in range(DEPTH):
        p = dict(norm_w=norm_w[l], w_mod=w_mod[l], b_mod=b_mod[l], w_in=w_in[l], hy_conv=hy_conv[l],
                 hy_filt_w1=hy_filt_w1[l], hy_filt_b1=hy_filt_b1[l], hy_filt_freq=hy_filt_freq[l],
                 hy_filt_w2=hy_filt_w2[l], hy_skip=hy_skip[l], attn_sink=attn_sink[l],
                 ret_theta=ret_theta[l], ret_gn=ret_gn[l], w_branch_a=w_branch_a[l],
                 w_branch_b=w_branch_b[l], w_branch_c=w_branch_c[l], w_merge=w_merge[l],
                 b_merge=b_merge[l], w_out=w_out[l])
        xp, k_c, v_c, s_c = mixer_layer(xp, cond_ctx, p, None, None)
        ks_out.append(k_c)
        vs_out.append(v_c)
        ss_out.append(s_c)
        xs, _, _, _ = mixer_layer(xs, c, p, rope, (cache_k[:, l], cache_v[:, l], state_ret[:, l]))
    y_prompt = rmsnorm(xp, final_norm_w).astype(x_prompt.dtype)
    y_sample = rmsnorm(xs, final_norm_w).astype(x_sample.dtype)
    new_cache_k = jnp.stack(ks_out, axis=1).astype(x_prompt.dtype)
    new_cache_v = jnp.stack(vs_out, axis=1).astype(x_prompt.dtype)
    new_state_ret = jnp.stack(ss_out, axis=1).astype(x_prompt.dtype)
    return (y_prompt, y_sample, new_cache_k, new_cache_v, new_state_ret)
```

```cpp
#include <hip/hip_runtime.h>
#include <hip/hip_cooperative_groups.h>
#include <cstdio>
namespace cg = cooperative_groups;

#define DI __device__ __forceinline__
typedef unsigned short bf16;
typedef __attribute__((ext_vector_type(8))) short bf16x8;
typedef __attribute__((ext_vector_type(4))) short bf16x4;
typedef __attribute__((ext_vector_type(16))) float f32x16;
typedef __attribute__((ext_vector_type(4))) unsigned u32x4;
typedef __attribute__((ext_vector_type(4))) float f32x4v;
#define MFMA(a, b, c) __builtin_amdgcn_mfma_f32_32x32x16_bf16((a), (b), (c), 0, 0, 0)

constexpr int DM = 1024;
constexpr int DEPTH = 4;
constexpr int T_CTX = 8192;
constexpr int T_ALL = 40960;
constexpr int TG = 24576;
constexpr int IN_DIM = 5376;
constexpr float LOG2E = 1.4426950408889634f;

constexpr size_t OFF_MODS = 0;
constexpr size_t OFF_FSUM = 458752;
constexpr size_t OFF_CTR = 491520;
constexpr size_t OFF_BAR = 495616;
constexpr size_t ZERO_BYTES = 524288;
constexpr size_t OFF_ROPE = ZERO_BYTES;
constexpr size_t OFF_W = OFF_ROPE + 1048576;
constexpr size_t W_IN = 0, W_MG = 5505024, W_A = 8650752, W_B = 9175040, W_C = 9699328, W_O = 10223616, W_LAYER = 11272192;
constexpr size_t OFF_GL = OFF_W + W_LAYER * 2 * 4;
constexpr size_t OFF_GC = OFF_GL + 33554432;
constexpr size_t OFF_H = OFF_GC + 2097152;
constexpr size_t OFF_HYT = OFF_H + (size_t)TG * 2048;
constexpr size_t OFF_AQ = OFF_HYT + (size_t)TG * 4096;
constexpr size_t OFF_AK = OFF_AQ + (size_t)TG * 1024;
constexpr size_t OFF_AV = OFF_AK + (size_t)TG * 256;
constexpr size_t OFF_AG = OFF_AV + (size_t)TG * 256;
constexpr size_t OFF_RQ = OFF_AG + (size_t)TG * 1024;
constexpr size_t OFF_RK = OFF_RQ + (size_t)TG * 1024;
constexpr size_t OFF_RV = OFF_RK + (size_t)TG * 1024;
constexpr size_t OFF_RG = OFF_RV + (size_t)TG * 1024;
constexpr size_t OFF_YA = OFF_RG + (size_t)TG * 1024;
constexpr size_t OFF_OFB = OFF_YA + (size_t)TG * 1024;
constexpr size_t WS_NEEDED = OFF_OFB + (size_t)TG * 1024;
constexpr size_t OFF_MERGED = OFF_RQ;

constexpr size_t OUT_CK = 41943040, OUT_CV = 46137344, OUT_ST = 50331648;

constexpr int SMEM_BYTES = 135168;

struct Params {
  const float *x_prompt, *x_sample, *c, *cache_k, *cache_v, *state_ret, *c_ctx, *norm_w, *w_mod, *b_mod, *w_in, *hy_conv,
      *hy_w1, *hy_b1, *hy_freq, *hy_w2, *hy_skip, *attn_sink, *ret_theta, *ret_gn, *w_a, *w_b, *w_c, *w_merge, *b_merge,
      *w_out, *final_w;
  float* out;
  char* ws;
};

DI bf16 f2bf(float x) {
  __bf16 b = (__bf16)x;
  return __builtin_bit_cast(unsigned short, b);
}
DI float bf2f(bf16 u) { return __uint_as_float(((unsigned)u) << 16); }
DI int crow(int reg, int h) { return (reg & 3) + 8 * (reg >> 2) + 4 * h; }
DI float siluf(float x) { return x / (1.f + __expf(-x)); }
DI float sigmf(float x) { return 1.f / (1.f + __expf(-x)); }
DI bf16x8 pack8(const f32x16& x, int s) {
  bf16x8 r;
#pragma unroll
  for (int j = 0; j < 8; ++j) r[j] = (short)f2bf(x[8 * s + j]);
  return r;
}
DI f32x16 zero16() {
  f32x16 z;
#pragma unroll
  for (int i = 0; i < 16; ++i) z[i] = 0.f;
  return z;
}
DI const float* launder(const float* q) {
  asm volatile("" : "+s"(q));
  return q;
}
DI int otid() {
  int t = threadIdx.x;
  asm volatile("" : "+v"(t));
  return t;
}
DI int cond_of(int tg) { return tg < T_CTX ? 0 : 1 + ((tg - T_CTX) >> 12); }

DI void lds_barrier() { asm volatile("s_waitcnt lgkmcnt(0)\n\ts_barrier" ::: "memory"); }

struct GemmSrc {
  const bf16* A;
  const bf16* B;
  int lda, ldb, atr;
};
DI GemmSrc mksrc(const bf16* A, int lda, const bf16* B, int ldb, int atr) {
  GemmSrc g;
  g.A = A; g.B = B; g.lda = lda; g.ldb = ldb; g.atr = atr;
  return g;
}
template <int NI>
DI void gemm_issue(const GemmSrc& g, int kt, int tid, u32x4 (&ra)[4], u32x4 (&rb)[NI]) {
  const int lrow = tid >> 3, lkc = (tid & 7) * 8;
  const bf16* ab = g.atr ? g.A + (size_t)((tid & 63) + kt * 64) * g.lda + (tid >> 6) * 8
                         : g.A + (size_t)lrow * g.lda + lkc + kt * 64;
  const size_t astep = g.atr ? (size_t)64 : (size_t)64 * g.lda;
#pragma unroll
  for (int i = 0; i < 4; ++i) ra[i] = *(const u32x4*)(ab + astep * i);
  const bf16* bb = g.B + (size_t)lrow * g.ldb + lkc + kt * 64;
#pragma unroll
  for (int i = 0; i < NI; ++i) rb[i] = *(const u32x4*)(bb + (size_t)(64 * i) * g.ldb);
}
template <int NI, bool ATR>
DI void gemm_stage(bf16* As, bf16* Bs, int tid, const u32x4 (&ra)[4], const u32x4 (&rb)[NI]) {
  constexpr int PITCH = 72;
  const int lrow = tid >> 3, lkc = (tid & 7) * 8;
#pragma unroll
  for (int i = 0; i < 4; ++i) {
    if (ATR) {
      bf16* d = As + (((tid >> 6) + 8 * i) * 8) * PITCH + (tid & 63);
      const bf16x8 v = __builtin_bit_cast(bf16x8, ra[i]);
#pragma unroll
      for (int e = 0; e < 8; ++e) d[e * PITCH] = (bf16)v[e];
    } else {
      *(u32x4*)(As + (lrow + 64 * i) * PITCH + lkc) = ra[i];
    }
  }
#pragma unroll
  for (int i = 0; i < NI; ++i) *(u32x4*)(Bs + (lrow + 64 * i) * PITCH + lkc) = rb[i];
}

template <int NI, bool ATR>
DI void gemm_stage_part(bf16* As, bf16* Bs, int tid, const u32x4 (&ra)[4], const u32x4 (&rb)[NI], int part) {
  constexpr int PITCH = 72;
  const int lrow = tid >> 3, lkc = (tid & 7) * 8;
#pragma unroll
  for (int i = 0; i < 4; ++i) {
    if (i != part) continue;
    if (ATR) {
      bf16* d = As + (((tid >> 6) + 8 * i) * 8) * PITCH + (tid & 63);
      const bf16x8 v = __builtin_bit_cast(bf16x8, ra[i]);
#pragma unroll
      for (int e = 0; e < 8; ++e) d[e * PITCH] = (bf16)v[e];
    } else {
      *(u32x4*)(As + (lrow + 64 * i) * PITCH + lkc) = ra[i];
    }
  }
#pragma unroll
  for (int i = 0; i < NI; ++i)
    if (2 * i == part) *(u32x4*)(Bs + (lrow + 64 * i) * PITCH + lkc) = rb[i];
}

template <int NI, bool ATR>
DI void gemm_main(const GemmSrc& cur, int K, f32x16 (&acc)[2][NI], char* smem, u32x4 (&ra)[2][4], u32x4 (&rb)[2][NI],
                  bool preloaded, const GemmSrc& nxt, bool has_next) {
  constexpr int BN = 64 * NI;
  constexpr int PITCH = 72;
  bf16* As = (bf16*)smem;
  bf16* Bs = As + 2 * 256 * PITCH;
  const int tid = otid(), lane = tid & 63, wave = tid >> 6;
  const int wm = wave >> 1, wn = wave & 1, r = lane & 31, h = lane >> 5;
  const int nk = K / 64;
  if (!preloaded) {
    gemm_issue<NI>(cur, 0, tid, ra[0], rb[0]);
    gemm_issue<NI>(cur, 1, tid, ra[1], rb[1]);
  }
  lds_barrier();
  gemm_stage<NI, ATR>(As, Bs, tid, ra[0], rb[0]);
  lds_barrier();
#pragma unroll 1
  for (int kt = 0; kt < nk; kt += 2) {
#pragma unroll
    for (int u = 0; u < 2; ++u) {
      const int k = kt + u;
      {
        const bool inr = k + 2 < nk;
        GemmSrc g = (inr || !has_next) ? cur : nxt;
        const int kk = inr ? k + 2 : (has_next ? k + 2 - nk : nk - 1);
        gemm_issue<NI>(g, kk, tid, ra[u], rb[u]);
      }
      const bf16* Ab = As + u * 256 * PITCH + (wm * 64 + r) * PITCH + h * 8;
      const bf16* Bb = Bs + u * BN * PITCH + (wn * 32 * NI + r) * PITCH + h * 8;
#pragma unroll
      for (int ks = 0; ks < 4; ++ks) {
        bf16x8 a[2], b[NI];
#pragma unroll
        for (int mi = 0; mi < 2; ++mi) a[mi] = *(const bf16x8*)(Ab + mi * 32 * PITCH + ks * 16);
#pragma unroll
        for (int ni = 0; ni < NI; ++ni) b[ni] = *(const bf16x8*)(Bb + ni * 32 * PITCH + ks * 16);
#pragma unroll
        for (int mi = 0; mi < 2; ++mi)
#pragma unroll
          for (int ni = 0; ni < NI; ++ni) acc[mi][ni] = MFMA(a[mi], b[ni], acc[mi][ni]);
        gemm_stage_part<NI, ATR>(As + (u ^ 1) * 256 * PITCH, Bs + (u ^ 1) * BN * PITCH, tid, ra[u ^ 1], rb[u ^ 1], ks);
      }
      lds_barrier();
    }
  }
}

DI void p0_mod_item(const Params& p, int item, char* smem) {
  const int tid = otid();
  const int l = item / 48, rem = item % 48, nch = rem / 8, ks = rem % 8;
  float* sc = (float*)smem;
  __syncthreads();
  for (int idx = tid; idx < 9 * 128; idx += 512) {
    const int cnd = idx >> 7, k = ks * 128 + (idx & 127);
    const float *qcc = launder(p.c_ctx), *qc = launder(p.c);
    const float v = cnd == 0 ? qcc[k] : qc[(cnd - 1) * 1024 + k];
    sc[idx] = v / (1.f + expf(-v));
  }
  __syncthreads();
  const int n = nch * 512 + tid;
  float acc[9];
#pragma unroll
  for (int i = 0; i < 9; ++i) acc[i] = 0.f;
  const float* w = p.w_mod + ((size_t)l * 1024 + ks * 128) * 3072 + n;
#pragma unroll 4
  for (int kk = 0; kk < 128; ++kk) {
    const float wv = w[(size_t)kk * 3072];
#pragma unroll
    for (int i = 0; i < 9; ++i) acc[i] += sc[i * 128 + kk] * wv;
  }
  float* mods = (float*)(p.ws + OFF_MODS);
  const float bias = ks == 0 ? p.b_mod[l * 3072 + n] : 0.f;
#pragma unroll
  for (int i = 0; i < 9; ++i) atomicAdd(&mods[(l * 9 + i) * 3072 + n], acc[i] + bias);
}

DI void transpose_tile(const float* __restrict__ src, int ldn, bf16* __restrict__ dst, int ldk, int k0, int n0, char* smem) {
  float* T = (float*)smem;
  const int tid = otid();
  __syncthreads();
  {
    const int k = tid >> 3, nc = (tid & 7) * 8;
    const float* s = src + (size_t)(k0 + k) * ldn + n0 + nc;
    const float4 a = *(const float4*)s, b = *(const float4*)(s + 4);
    float* t = T + k * 65 + nc;
    t[0] = a.x; t[1] = a.y; t[2] = a.z; t[3] = a.w; t[4] = b.x; t[5] = b.y; t[6] = b.z; t[7] = b.w;
  }
  __syncthreads();
  {
    const int n = tid >> 3, kc = (tid & 7) * 8;
    bf16x8 v;
#pragma unroll
    for (int j = 0; j < 8; ++j) v[j] = (short)f2bf(T[(kc + j) * 65 + n]);
    *(bf16x8*)(dst + (size_t)(n0 + n) * ldk + k0 + kc) = v;
  }
}

DI void p0_transpose_item(const Params& p, int item, char* smem) {
  const int l = item / 2752;
  int rem = item % 2752;
  bf16* wl = (bf16*)(p.ws + OFF_W) + (size_t)l * W_LAYER;
  if (rem < 1344) {
    const int kt = rem / 84, nt = rem % 84;
    transpose_tile(p.w_in + (size_t)l * 1024 * IN_DIM, IN_DIM, wl + W_IN, 1024, kt * 64, nt * 64, smem);
    return;
  }
  rem -= 1344;
  if (rem < 768) {
    const int kt = rem / 48, nt = rem % 48;
    transpose_tile(p.w_merge + (size_t)l * 1024 * 3072, 3072, wl + W_MG, 1024, kt * 64, nt * 64, smem);
    return;
  }
  rem -= 768;
  if (rem < 384) {
    const int br = rem / 128, r2 = rem % 128, kt = r2 / 16, nt = r2 % 16;
    const float *qa = launder(p.w_a), *qb = launder(p.w_b), *qc = launder(p.w_c);
    const float* src = (br == 0 ? qa : br == 1 ? qb : qc) + (size_t)l * 512 * 1024;
    transpose_tile(src, 1024, wl + (br == 0 ? W_A : br == 1 ? W_B : W_C), 512, kt * 64, nt * 64, smem);
    return;
  }
  rem -= 384;
  {
    const int kt = rem / 16, nt = rem % 16;
    transpose_tile(p.w_out + (size_t)l * 1024 * 1024, 1024, wl + W_O, 1024, kt * 64, nt * 64, smem);
  }
}

DI void p0_rope_item(const Params& p, int item) {
  const int idx = item * 512 + otid();
  const int t = idx >> 5, f = idx & 31;
  const float inv = powf(10000.f, -(float)(f & 15) / 16.f);
  const float ang = (float)(f < 16 ? (t >> 6) : (t & 63)) * inv;
  float2 cs;
  cs.x = cosf(ang);
  cs.y = sinf(ang);
  ((float2*)(p.ws + OFF_ROPE))[idx] = cs;
}

DI void phase0(const Params& p, char* smem) {
  const int n_mod = 192, n_tr = 11008, n_rope = 256;
  for (int it = blockIdx.x; it < n_mod + n_tr + n_rope; it += gridDim.x) {
    if (it < n_mod) p0_mod_item(p, it, smem);
    else if (it < n_mod + n_tr) p0_transpose_item(p, it - n_mod, smem);
    else p0_rope_item(p, it - n_mod - n_tr);
  }
}

DI void filter_item(const Params& p, int layer, int item, char* smem) {
  const int tid = otid();
  int var, pc, cc, L;
  if (item < 512) { var = 0; pc = item >> 3; cc = item & 7; L = 4096; }
  else { var = 1; pc = (item - 512) >> 3; cc = (item - 512) & 7; L = 256; }
  float* z = (float*)smem;
  float* hid = z + 64 * 17;
  float* w2s = hid + 64 * 64;
  __syncthreads();
  {
    const int pos = tid >> 3, band = tid & 7;
    const int pa = pc * 64 + pos;
    const float w = 6.283185307179586f * (float)pa / (float)L;
    const float f = 1e-4f + (float)band * ((7.f - 1e-4f) / 7.f);
    z[pos * 17 + 1 + band] = cosf(f * w);
    z[pos * 17 + 9 + band] = -sinf(f * w);
    if (band == 0) z[pos * 17] = (float)pa / (float)(L - 1);
  }
  __syncthreads();
  {
    const int pos = tid >> 3, j0 = (tid & 7) * 8;
    const float* w1 = p.hy_w1 + layer * 17 * 64;
#pragma unroll
    for (int jj = 0; jj < 8; ++jj) {
      const int j = j0 + jj;
      float pre = p.hy_b1[layer * 64 + j];
      for (int f = 0; f < 17; ++f) pre += z[pos * 17 + f] * w1[f * 64 + j];
      hid[pos * 64 + j] = sinf(p.hy_freq[layer * 64 + j] * pre);
    }
    const float* w2 = p.hy_w2 + (size_t)layer * 64 * 2048 + cc * 256;
    for (int idx = tid; idx < 64 * 256; idx += 512) w2s[idx] = w2[(idx >> 8) * 2048 + (idx & 255)];
  }
  __syncthreads();
  {
    const int n = cc * 256 + (tid & 255), half = tid >> 8;
    const int o = n >> 10, dir = (n >> 9) & 1, c = n & 511;
    const float min_d = -3.0701134573253945f, max_d = -15.350567286626973f;
    const float ad = fabsf(min_d + (float)c * ((max_d - min_d) / 511.f));
    float* g = (float*)(p.ws + (var == 0 ? OFF_GL : OFF_GC)) + ((size_t)(o * 512 + c)) * (2 * L);
    float asum = 0.f;
    for (int pp = 0; pp < 32; ++pp) {
      const int pos = half * 32 + pp, pa = pc * 64 + pos;
      float acc = 0.f;
#pragma unroll
      for (int j = 0; j < 64; ++j) acc += hid[pos * 64 + j] * w2s[j * 256 + (tid & 255)];
      const float t = (float)pa / (float)(L - 1);
      const float v = acc * expf(-t * ad);
      asum += fabsf(v);
      int y;
      if (dir == 0) y = L - pa;
      else y = (pa == 0) ? 0 : L + pa;
      g[y] = v;
    }
    atomicAdd((float*)(p.ws + OFF_FSUM) + ((layer * 2 + var) * 2 + o) * 512 + c, asum);
  }
}

DI void p1a(const Params& p, int layer, int grp, char* smem) {
  const int g0 = grp ? TG : 0, tgn = grp ? 16384 : TG;
  const int nfilt = grp ? 0 : 544;
  const int nrow_items = tgn / 8;
  const int tid_ = otid();
  const int lane = tid_ & 63, wave = tid_ >> 6;
  bf16* H = (bf16*)(p.ws + OFF_H);
  const float* mods = (const float*)(p.ws + OFF_MODS);
  for (int it = blockIdx.x; it < nfilt + nrow_items; it += gridDim.x) {
    if (it < nfilt) { filter_item(p, layer, it, smem); continue; }
    const int tl = (it - nfilt) * 8 + wave, tg = g0 + tl;
    const float *qxp = launder(p.x_prompt), *qxs = launder(p.x_sample), *qo = launder(p.out);
    const float* x = layer == 0 ? (tg < T_CTX ? qxp + (size_t)tg * DM : qxs + (size_t)(tg - T_CTX) * DM) : qo + (size_t)tg * DM;
    float4 v[4];
    float ss = 0.f;
#pragma unroll
    for (int i = 0; i < 4; ++i) {
      v[i] = *(const float4*)(x + (lane + 64 * i) * 4);
      ss += v[i].x * v[i].x + v[i].y * v[i].y + v[i].z * v[i].z + v[i].w * v[i].w;
    }
#pragma unroll
    for (int o = 32; o > 0; o >>= 1) ss += __shfl_xor(ss, o);
    const float rstd = rsqrtf(ss * (1.f / 1024.f) + 1e-6f);
    const float* md = mods + (layer * 9 + cond_of(tg)) * 3072;
    const float* nw = p.norm_w + layer * 1024;
#pragma unroll
    for (int i = 0; i < 4; ++i) {
      const int col = (lane + 64 * i) * 4;
      const float4 sh = *(const float4*)(md + col), sc = *(const float4*)(md + 1024 + col), w = *(const float4*)(nw + col);
      bf16x4 o;
      o[0] = (short)f2bf(v[i].x * rstd * w.x * (1.f + sc.x) + sh.x);
      o[1] = (short)f2bf(v[i].y * rstd * w.y * (1.f + sc.y) + sh.y);
      o[2] = (short)f2bf(v[i].z * rstd * w.z * (1.f + sc.z) + sh.z);
      o[3] = (short)f2bf(v[i].w * rstd * w.w * (1.f + sc.w) + sh.w);
      *(bf16x4*)(H + (size_t)tl * 1024 + col) = o;
    }
  }
}

DI void p1b(const Params& p, int layer, int grp, char* smem) {
  const int g0 = grp ? TG : 0, tgn = grp ? 16384 : TG;
  const int mtiles = tgn / 256, ntot = mtiles * 42;
  const int tid = otid(), lane = tid & 63, wave = tid >> 6;
  const int wm = wave >> 1, wn = wave & 1, r = lane & 31, h = lane >> 5;
  const bf16* H = (const bf16*)(p.ws + OFF_H);
  const bf16* WinT = (const bf16*)(p.ws + OFF_W) + (size_t)layer * W_LAYER + W_IN;
  float* S = (float*)smem;
  u32x4 ra[2][4], rb[2][2];
  bool pre = false;
  for (int id = blockIdx.x; id < ntot; id += gridDim.x) {
    const int band = id / (16 * 42), rem = id % (16 * 42);
    const int mt = band * 16 + (rem & 15), nt = rem >> 4;
    const int idn = id + gridDim.x;
    const bool hn = idn < ntot;
    const int bandn = idn / (16 * 42), remn = idn % (16 * 42);
    const int mtn = bandn * 16 + (remn & 15), ntn = remn >> 4;
    f32x16 acc[2][2];
#pragma unroll
    for (int a = 0; a < 2; ++a)
#pragma unroll
      for (int b = 0; b < 2; ++b) acc[a][b] = zero16();
    gemm_main<2, false>(mksrc(H + (size_t)mt * 256 * 1024, 1024, WinT + (size_t)nt * 128 * 1024, 1024, 0), 1024, acc, smem, ra, rb, pre,
                        mksrc(H + (size_t)mtn * 256 * 1024, 1024, WinT + (size_t)ntn * 128 * 1024, 1024, 0), hn);
    pre = true;
    const int m0 = mt * 256, tg0 = g0 + m0;
    const bool lat = tg0 >= T_CTX;
    if (nt < 16) {
#pragma unroll
      for (int mi = 0; mi < 2; ++mi)
#pragma unroll
        for (int ni = 0; ni < 2; ++ni)
#pragma unroll
          for (int g4 = 0; g4 < 4; ++g4) {
            f32x4v v;
#pragma unroll
            for (int j = 0; j < 4; ++j) v[j] = acc[mi][ni][4 * g4 + j];
            *(f32x4v*)(S + (wn * 64 + ni * 32 + r) * 260 + wm * 64 + mi * 32 + 8 * g4 + 4 * h) = v;
          }
      __syncthreads();
      const int part = nt >> 2;
#pragma unroll 2
      for (int it = 0; it < 8; ++it) {
        const int pid = tid + 512 * it, cl = pid >> 5, q = pid & 31;
        const f32x4v a = *(const f32x4v*)(S + cl * 260 + q * 8), b = *(const f32x4v*)(S + cl * 260 + q * 8 + 4);
        bf16x8 v;
#pragma unroll
        for (int j = 0; j < 4; ++j) {
          v[j] = (short)f2bf(a[j]);
          v[4 + j] = (short)f2bf(b[j]);
        }
        *(bf16x8*)((bf16*)(p.ws + OFF_HYT) + ((size_t)(part * 512 + (nt & 3) * 128 + cl)) * TG + m0 + q * 8) = v;
      }
    } else {
#pragma unroll
      for (int mi = 0; mi < 2; ++mi)
#pragma unroll
        for (int ni = 0; ni < 2; ++ni)
#pragma unroll
          for (int i = 0; i < 16; ++i) S[(wm * 64 + mi * 32 + crow(i, h)) * 132 + wn * 64 + ni * 32 + r] = acc[mi][ni][i];
      __syncthreads();
      size_t off; int pitch, coloff; bool rope = false; int cache = 0;
      if (nt < 20) { off = OFF_AQ; pitch = 512; coloff = (nt - 16) * 128; rope = lat; }
      else if (nt == 20) { off = OFF_AK; pitch = 128; coloff = 0; rope = lat; cache = lat ? 0 : 1; }
      else if (nt == 21) { off = OFF_AV; pitch = 128; coloff = 0; cache = lat ? 0 : 2; }
      else if (nt < 26) { off = OFF_AG; pitch = 512; coloff = (nt - 22) * 128; }
      else if (nt < 30) { off = OFF_RQ; pitch = 512; coloff = (nt - 26) * 128; rope = lat; }
      else if (nt < 34) { off = OFF_RK; pitch = 512; coloff = (nt - 30) * 128; rope = lat; }
      else if (nt < 38) { off = OFF_RV; pitch = 512; coloff = (nt - 34) * 128; }
      else { off = OFF_RG; pitch = 512; coloff = (nt - 38) * 128; }
      bf16* dst = (bf16*)(p.ws + off);
      const float2* rt = (const float2*)(p.ws + OFF_ROPE);
#pragma unroll 2
      for (int it = 0; it < 8; ++it) {
        const int cid = tid + 512 * it, row = cid >> 4, cc = cid & 15;
        const float* sp = S + row * 132 + cc * 8;
        float v[8];
#pragma unroll
        for (int j = 0; j < 8; ++j) v[j] = sp[j];
        if (cache) {
          float* co = p.out + (cache == 1 ? OUT_CK : OUT_CV) + ((size_t)((tg0 >> 8) * 4 + layer) * 256 + row) * 128 + cc * 8;
          *(float4*)co = make_float4(v[0], v[1], v[2], v[3]);
          *(float4*)(co + 4) = make_float4(v[4], v[5], v[6], v[7]);
        }
        if (rope) {
          const int hd0 = (cc * 8) & 63, q = hd0 >> 4;
          const int tpos = (tg0 - T_CTX + row) & 4095;
          const float2* tb = rt + tpos * 32 + (q >> 1) * 16 + (hd0 & 15);
          const float* pp = sp + ((q & 1) ? -16 : 16);
          const float sg = (q & 1) ? 1.f : -1.f;
#pragma unroll
          for (int j = 0; j < 8; ++j) {
            const float2 cs = tb[j];
            v[j] = v[j] * cs.x + sg * pp[j] * cs.y;
          }
        }
        bf16x8 o;
#pragma unroll
        for (int j = 0; j < 8; ++j) o[j] = (short)f2bf(v[j]);
        *(bf16x8*)(dst + (size_t)(m0 + row) * pitch + coloff + cc * 8) = o;
      }
    }
  }
}

template <int NBT, int L>
DI void hyena_item(const Params& p, int layer, int var, int tlbase, int c, char* smem) {
  constexpr int NP = 32 / NBT, NT = (L / 8) / (32 * NP), UP = L + 8;
  bf16* U = (bf16*)smem;
  bf16* X1 = U + NBT * UP;
  bf16* X2 = X1 + NBT * UP;
  bf16* GR = X2 + NBT * UP;
  bf16* GR1 = GR + 2 * L + 8;
  const int tid = otid(), lane = tid & 63, wave = tid >> 6;
  const int n = lane & 31, hh = lane >> 5, b = n & (NBT - 1), pp = n / NBT;
  const bf16* hyT = (const bf16*)(p.ws + OFF_HYT);
  const float* fs = (const float*)(p.ws + OFF_FSUM) + (layer * 2 + var) * 1024;
  const float* gsrc = (const float*)(p.ws + (var == 0 ? OFF_GL : OFF_GC));
  __syncthreads();
#pragma unroll 1
  for (int part = 0; part < 3; ++part) {
    const bf16* src = hyT + ((size_t)(part * 512 + c)) * TG + tlbase;
    bf16* dstb = part == 0 ? U : part == 1 ? X1 : X2;
    const float w0 = p.hy_conv[(layer * 3 + 0) * 1536 + part * 512 + c];
    const float w1 = p.hy_conv[(layer * 3 + 1) * 1536 + part * 512 + c];
    const float w2 = p.hy_conv[(layer * 3 + 2) * 1536 + part * 512 + c];
#pragma unroll
    for (int it = 0; it < NBT * L / 8 / 512; ++it) {
      const int id = tid + 512 * it;
      const int bb = id / (L / 8), t8 = (id % (L / 8)) * 8;
      const bf16* s = src + bb * L + t8;
      const bf16x8 xv = *(const bf16x8*)s;
      float x[10];
      x[0] = t8 > 0 ? bf2f(s[-1]) : 0.f;
      x[9] = t8 + 8 < L ? bf2f(s[8]) : 0.f;
#pragma unroll
      for (int j = 0; j < 8; ++j) x[j + 1] = bf2f((bf16)xv[j]);
      bf16x8 o;
#pragma unroll
      for (int j = 0; j < 8; ++j) o[j] = (short)f2bf(w0 * x[j] + w1 * x[j + 1] + w2 * x[j + 2]);
      *(bf16x8*)(dstb + bb * UP + t8) = o;
    }
  }
  const int wbase = wave * (L / 8);
  const int dmin = -(wbase + (NT - 1) * 32 * NP + 32 * (NP - 1)), dmax = L - 16 - wbase;
  f32x16 acc[NT];
#pragma unroll 1
  for (int o = 0; o < 2; ++o) {
    {
      const float inv = 1.f / fs[o * 512 + c];
      const float* gs = gsrc + ((size_t)(o * 512 + c)) * (2 * L);
      const float skip = p.hy_skip[(layer * 2 + o) * 512 + c];
#pragma unroll 8
      for (int y = tid; y < 2 * L; y += 512) {
        float v = gs[y] * inv;
        if (y == L) v = (gs[L] + gs[0]) * inv + skip;
        if (y == 0) v = 0.f;
        const bf16 bv = f2bf(v);
        GR[y] = bv;
        if (y > 0) GR1[y - 1] = bv;
      }
      if (tid == 0) GR1[2 * L - 1] = 0;
    }
    __syncthreads();
#pragma unroll
    for (int q = 0; q < NT; ++q) acc[q] = zero16();
#pragma unroll 1
    for (int d = dmin; d <= dmax; d += 16) {
      const unsigned* gp = (const unsigned*)(((n & 1) ? GR1 - 1 : GR) + (L - n + d + 8 * hh));
      typedef __attribute__((ext_vector_type(4))) unsigned u4;
      u4 aw;
#pragma unroll
      for (int j = 0; j < 4; ++j) aw[j] = gp[j];
      const bf16x8 a = __builtin_bit_cast(bf16x8, aw);
#pragma unroll
      for (int q = 0; q < NT; ++q) {
        const int s0 = wbase + q * 32 * NP + 32 * pp + d;
        bf16x8 bb;
#pragma unroll
        for (int j = 0; j < 8; ++j) bb[j] = 0;
        if (s0 >= 0 && s0 <= L - 16) bb = *(const bf16x8*)(U + b * UP + s0 + 8 * hh);
        acc[q] = MFMA(a, bb, acc[q]);
      }
    }
    __syncthreads();
    if (o == 0) {
#pragma unroll
      for (int q = 0; q < NT; ++q)
#pragma unroll
        for (int i = 0; i < 16; ++i) {
          const int t = wbase + q * 32 * NP + 32 * pp + crow(i, hh);
          U[b * UP + t] = f2bf(bf2f(X1[b * UP + t]) * acc[q][i]);
        }
    } else {
      const bf16* gate = hyT + ((size_t)(3 * 512 + c)) * TG + tlbase;
#pragma unroll
      for (int q = 0; q < NT; ++q)
#pragma unroll
        for (int g4 = 0; g4 < 4; ++g4) {
          const int t = wbase + q * 32 * NP + 32 * pp + 8 * g4 + 4 * hh;
          const bf16x4 gv = *(const bf16x4*)(gate + b * L + t);
          bf16x4 ov;
#pragma unroll
          for (int j = 0; j < 4; ++j)
            ov[j] = (short)f2bf(bf2f(X2[b * UP + t + j]) * acc[q][4 * g4 + j] * siluf(bf2f((bf16)gv[j])));
          *(bf16x4*)(U + b * UP + t) = ov;
        }
      __syncthreads();
      bf16* yat = (bf16*)(p.ws + OFF_YA) + (size_t)c * TG + tlbase;
      for (int id = tid; id < NBT * L / 8; id += 512) {
        const int bb = id / (L / 8), t8 = (id % (L / 8)) * 8;
        *(bf16x8*)(yat + bb * L + t8) = *(const bf16x8*)(U + bb * UP + t8);
      }
    }
  }
}

DI void attn_item(const Params& p, int layer, bool lat, int tlbase, int bglob, int kvh, int qblk, char* smem) {
  bf16* Ks = (bf16*)smem;
  bf16* VT = Ks + 64 * 72;
  const int tid = otid(), lane = tid & 63, wave = tid >> 6;
  const int r = lane & 31, hh = lane >> 5;
  const int head = kvh * 4 + (wave >> 1);
  const int qi = qblk * 64 + (wave & 1) * 32 + r;
  const int tlq = tlbase + qi;
  const bf16* aq = (const bf16*)(p.ws + OFF_AQ);
  const bf16* ak = (const bf16*)(p.ws + OFF_AK);
  const bf16* av = (const bf16*)(p.ws + OFF_AV);
  bf16* ag = (bf16*)(p.ws + OFF_AG);
  bf16x8 bq[4];
#pragma unroll
  for (int ks = 0; ks < 4; ++ks) bq[ks] = *(const bf16x8*)(aq + (size_t)tlq * 512 + head * 64 + ks * 16 + hh * 8);
  const float sink2 = p.attn_sink[layer * 8 + head] * LOG2E;
  const float SC = 0.125f * LOG2E;
  float m = sink2, lsum = 0.f;
  f32x16 O[2];
  O[0] = zero16();
  O[1] = zero16();
  const int t_lo = lat ? (2 - qblk > 0 ? 2 - qblk : 0) : 0;
  const int t_hi = lat ? (65 - qblk < 4 ? 65 - qblk : 4) : 3;
  const int nw = t_hi - t_lo + 1;
  const int ntot = lat ? nw + 8 : nw;
  const int lj = tid >> 3, lkc = (tid & 7) * 8;
  u32x4 pr0, pr1, pr2, pr3;
  pr2 = u32x4{0, 0, 0, 0};
  pr3 = u32x4{0, 0, 0, 0};
  {
    const int kp = lat ? qblk * 64 - 128 + t_lo * 64 : 0;
    const size_t o = (size_t)(tlbase + kp + lj) * 128 + kvh * 64 + lkc;
    pr0 = *(const u32x4*)(ak + o);
    pr1 = *(const u32x4*)(av + o);
  }
#pragma unroll 1
  for (int n = 0; n < ntot; ++n) {
    const bool from_cache = lat && n >= nw;
    const bool window = lat && n < nw;
    const int kpos0 = from_cache ? (n - nw) * 64 : (lat ? qblk * 64 - 128 + (t_lo + n) * 64 : n * 64);
    lds_barrier();
    {
      bf16x8 kv, vv;
      if (from_cache) {
        const f32x4v k0 = __builtin_bit_cast(f32x4v, pr0), k1 = __builtin_bit_cast(f32x4v, pr1);
        const f32x4v v0 = __builtin_bit_cast(f32x4v, pr2), v1 = __builtin_bit_cast(f32x4v, pr3);
#pragma unroll
        for (int e = 0; e < 4; ++e) {
          kv[e] = (short)f2bf(k0[e]);
          kv[4 + e] = (short)f2bf(k1[e]);
          vv[e] = (short)f2bf(v0[e]);
          vv[4 + e] = (short)f2bf(v1[e]);
        }
      } else {
        kv = __builtin_bit_cast(bf16x8, pr0);
        vv = __builtin_bit_cast(bf16x8, pr1);
      }
      *(bf16x8*)(Ks + lj * 72 + lkc) = kv;
#pragma unroll
      for (int jj = 0; jj < 8; ++jj) VT[(lkc + jj) * 68 + lj] = (bf16)vv[jj];
    }
    lds_barrier();
    {
      const int nn = n + 1 < ntot ? n + 1 : n;
      if (lat && nn >= nw) {
        const size_t o = ((((size_t)bglob * 4 + layer) * 512 + (nn - nw) * 64 + lj) * 2 + kvh) * 64 + lkc;
        pr0 = *(const u32x4*)(p.cache_k + o);
        pr1 = *(const u32x4*)(p.cache_k + o + 4);
        pr2 = *(const u32x4*)(p.cache_v + o);
        pr3 = *(const u32x4*)(p.cache_v + o + 4);
      } else {
        const int kp = lat ? qblk * 64 - 128 + (t_lo + nn) * 64 : nn * 64;
        const size_t o = (size_t)(tlbase + kp + lj) * 128 + kvh * 64 + lkc;
        pr0 = *(const u32x4*)(ak + o);
        pr1 = *(const u32x4*)(av + o);
      }
    }
    f32x16 sc[2];
#pragma unroll
    for (int sub = 0; sub < 2; ++sub) {
      sc[sub] = zero16();
#pragma unroll
      for (int ks = 0; ks < 4; ++ks) {
        const bf16x8 a = *(const bf16x8*)(Ks + (sub * 32 + r) * 72 + ks * 16 + hh * 8);
        sc[sub] = MFMA(a, bq[ks], sc[sub]);
      }
    }
    float mx = -3.0e38f;
#pragma unroll
    for (int sub = 0; sub < 2; ++sub)
#pragma unroll
      for (int i = 0; i < 16; ++i) {
        float sv = sc[sub][i] * SC;
        if (window) {
          const int diff = qi - (kpos0 + sub * 32 + crow(i, hh));
          if (diff > 128 || diff < -128) sv = -1e30f;
        }
        sc[sub][i] = sv;
        mx = fmaxf(mx, sv);
      }
    mx = fmaxf(mx, __shfl_xor(mx, 32));
    const float mnew = fmaxf(m, mx);
    const float alpha = __builtin_amdgcn_exp2f(m - mnew);
    m = mnew;
    float ps = 0.f;
#pragma unroll
    for (int sub = 0; sub < 2; ++sub)
#pragma unroll
      for (int i = 0; i < 16; ++i) {
        sc[sub][i] = __builtin_amdgcn_exp2f(sc[sub][i] - m);
        ps += sc[sub][i];
      }
    lsum = lsum * alpha + ps;
    if (__builtin_amdgcn_ballot_w64(alpha != 1.f) != 0) {
#pragma unroll
      for (int i = 0; i < 16; ++i) {
        O[0][i] *= alpha;
        O[1][i] *= alpha;
      }
    }
#pragma unroll
    for (int sub = 0; sub < 2; ++sub)
#pragma unroll
      for (int st = 0; st < 2; ++st) {
        const bf16x8 pf = pack8(sc[sub], st);
#pragma unroll
        for (int mi = 0; mi < 2; ++mi) {
          const bf16* vp = VT + (mi * 32 + r) * 68 + sub * 32 + 16 * st + 4 * hh;
          const bf16x4 lo = *(const bf16x4*)vp, hi = *(const bf16x4*)(vp + 8);
          const bf16x8 va = __builtin_shufflevector(lo, hi, 0, 1, 2, 3, 4, 5, 6, 7);
          O[mi] = MFMA(va, pf, O[mi]);
        }
      }
  }
  const float ltot = lsum + __shfl_xor(lsum, 32) + exp2f(sink2 - m);
  const float inv = 1.f / ltot;
#pragma unroll
  for (int mi = 0; mi < 2; ++mi)
#pragma unroll
    for (int g4 = 0; g4 < 4; ++g4) {
      bf16* gp = ag + (size_t)tlq * 512 + head * 64 + mi * 32 + 8 * g4 + 4 * hh;
      const bf16x4 gv = *(const bf16x4*)gp;
      bf16x4 o;
#pragma unroll
      for (int j = 0; j < 4; ++j) o[j] = (short)f2bf(O[mi][4 * g4 + j] * inv * siluf(bf2f((bf16)gv[j])));
      *(bf16x4*)gp = o;
    }
}

DI void ret_item(const Params& p, int layer, bool lat, int NC, int tlbase, int bglob, int hd, char* smem) {
  const int tid = otid(), lane = tid & 63, wave = tid >> 6;
  const int dir = wave >> 2, w4 = wave & 3, r = lane & 31, hh = lane >> 5, dt = tid & 255;
  bf16* Ks = (bf16*)smem + dir * 31232;
  bf16* KdT = Ks + 128 * 72;
  bf16* VT = KdT + 64 * 136;
  bf16* ST = VT + 64 * 136;
  const bf16* rq = (const bf16*)(p.ws + OFF_RQ);
  const bf16* rk = (const bf16*)(p.ws + OFF_RK);
  const bf16* rv = (const bf16*)(p.ws + OFF_RV);
  bf16* rg = (bf16*)(p.ws + OFF_RG);
  bf16* ofb = (bf16*)(p.ws + OFF_OFB);
  const float theta = p.ret_theta[(layer * 2 + dir) * 8 + hd];
  const float lg2 = -log1pf(expf(-theta)) * LOG2E;
  const float cdec = exp2f(lg2 * 128.f);
  const int etile = w4 >> 1, dtile = w4 & 1;
  f32x16 Sacc;
  if (lat) {
    const float* s0 = p.state_ret + ((((size_t)bglob * 4 + layer) * 2 + dir) * 8 + hd) * 4096;
#pragma unroll
    for (int i = 0; i < 16; ++i) Sacc[i] = s0[(dtile * 32 + r) * 64 + etile * 32 + crow(i, hh)];
  } else {
    Sacc = zero16();
  }
  __syncthreads();
#pragma unroll
  for (int i = 0; i < 16; ++i) ST[(etile * 32 + crow(i, hh)) * 72 + dtile * 32 + r] = f2bf(Sacc[i]);
#pragma unroll 1
  for (int step = 0; step < NC; ++step) {
    const int ch = dir ? NC - 1 - step : step;
    const int tl0 = tlbase + ch * 128;
    const int iq = w4 * 32 + r, tlq = tl0 + iq;
    const bool second = step >= NC / 2;
    bf16x8 kv[4], vv[4], bq[4];
    bf16x4 pp[8], pg[8];
    const int jrow = dt & 127;
#pragma unroll
    for (int i = 0; i < 4; ++i) {
      const int kc = ((dt >> 7) + 2 * i) * 8;
      const size_t o = (size_t)(tl0 + jrow) * 512 + hd * 64 + kc;
      kv[i] = *(const bf16x8*)(rk + o);
      vv[i] = *(const bf16x8*)(rv + o);
    }
#pragma unroll
    for (int ks = 0; ks < 4; ++ks) bq[ks] = *(const bf16x8*)(rq + (size_t)tlq * 512 + hd * 64 + ks * 16 + hh * 8);
    if (second) {
#pragma unroll
      for (int mi = 0; mi < 2; ++mi)
#pragma unroll
        for (int g4 = 0; g4 < 4; ++g4) {
          const size_t o = (size_t)tlq * 512 + hd * 64 + mi * 32 + 8 * g4 + 4 * hh;
          pp[mi * 4 + g4] = *(const bf16x4*)(ofb + o);
          pg[mi * 4 + g4] = *(const bf16x4*)(rg + o);
        }
    } else {
#pragma unroll
      for (int i = 0; i < 8; ++i) {
        pp[i] = bf16x4{0, 0, 0, 0};
        pg[i] = bf16x4{0, 0, 0, 0};
      }
    }
    {
      const float kd = exp2f(lg2 * (float)(dir ? jrow : 127 - jrow)) * 0.125f;
#pragma unroll
      for (int i = 0; i < 4; ++i) {
        const int kc = ((dt >> 7) + 2 * i) * 8;
        *(bf16x8*)(Ks + jrow * 72 + kc) = kv[i];
#pragma unroll
        for (int jj = 0; jj < 8; ++jj) {
          KdT[(kc + jj) * 136 + jrow] = f2bf(bf2f((bf16)kv[i][jj]) * kd);
          VT[(kc + jj) * 136 + jrow] = (bf16)vv[i][jj];
        }
      }
    }
    __syncthreads();
    f32x16 O[2];
    {
      const float qd = exp2f(lg2 * (float)(dir ? 128 - iq : iq + 1));
#pragma unroll
      for (int mi = 0; mi < 2; ++mi) {
        f32x16 oc = zero16();
#pragma unroll
        for (int ks = 0; ks < 4; ++ks) {
          const bf16x8 a = *(const bf16x8*)(ST + (mi * 32 + r) * 72 + ks * 16 + hh * 8);
          oc = MFMA(a, bq[ks], oc);
        }
#pragma unroll
        for (int i = 0; i < 16; ++i) O[mi][i] = oc[i] * qd;
      }
    }
#pragma unroll 1
    for (int jt = 0; jt < 4; ++jt) {
      if (dir == 0 ? (jt <= w4) : (jt >= w4)) {
        f32x16 s = zero16();
#pragma unroll
        for (int ks = 0; ks < 4; ++ks) {
          const bf16x8 a = *(const bf16x8*)(Ks + (jt * 32 + r) * 72 + ks * 16 + hh * 8);
          s = MFMA(a, bq[ks], s);
        }
#pragma unroll
        for (int i = 0; i < 16; ++i) {
          const int j = jt * 32 + crow(i, hh);
          const int diff = dir ? j - iq : iq - j;
          s[i] = diff >= 0 ? s[i] * 0.125f * __builtin_amdgcn_exp2f(lg2 * (float)diff) : 0.f;
        }
#pragma unroll
        for (int st = 0; st < 2; ++st) {
          const bf16x8 pf = pack8(s, st);
#pragma unroll
          for (int mi = 0; mi < 2; ++mi) {
            const bf16* vp = VT + (mi * 32 + r) * 136 + jt * 32 + 16 * st + 4 * hh;
            const bf16x4 lo = *(const bf16x4*)vp, hi = *(const bf16x4*)(vp + 8);
            const bf16x8 va = __builtin_shufflevector(lo, hi, 0, 1, 2, 3, 4, 5, 6, 7);
            O[mi] = MFMA(va, pf, O[mi]);
          }
        }
      }
    }
#pragma unroll
    for (int i = 0; i < 16; ++i) Sacc[i] *= cdec;
#pragma unroll 2
    for (int jk = 0; jk < 8; ++jk) {
      const bf16x8 a = *(const bf16x8*)(VT + (etile * 32 + r) * 136 + jk * 16 + hh * 8);
      const bf16x8 bb = *(const bf16x8*)(KdT + (dtile * 32 + r) * 136 + jk * 16 + hh * 8);
      Sacc = MFMA(a, bb, Sacc);
    }
    if (!second) {
#pragma unroll
      for (int mi = 0; mi < 2; ++mi)
#pragma unroll
        for (int g4 = 0; g4 < 4; ++g4) {
          bf16x4 o;
#pragma unroll
          for (int j = 0; j < 4; ++j) o[j] = (short)f2bf(O[mi][4 * g4 + j]);
          *(bf16x4*)(ofb + (size_t)tlq * 512 + hd * 64 + mi * 32 + 8 * g4 + 4 * hh) = o;
        }
    } else {
      float ss = 0.f;
#pragma unroll
      for (int mi = 0; mi < 2; ++mi)
#pragma unroll
        for (int g4 = 0; g4 < 4; ++g4) {
          const bf16x4 pv = pp[mi * 4 + g4];
#pragma unroll
          for (int j = 0; j < 4; ++j) {
            const float v = O[mi][4 * g4 + j] + bf2f((bf16)pv[j]);
            O[mi][4 * g4 + j] = v;
            ss += v * v;
          }
        }
      ss += __shfl_xor(ss, 32);
      const float rn = rsqrtf(ss * (1.f / 64.f) + 1e-6f);
#pragma unroll
      for (int mi = 0; mi < 2; ++mi)
#pragma unroll
        for (int g4 = 0; g4 < 4; ++g4) {
          const int e0 = hd * 64 + mi * 32 + 8 * g4 + 4 * hh;
          bf16* gp = rg + (size_t)tlq * 512 + e0;
          const bf16x4 gv = pg[mi * 4 + g4];
          const float4 gn = *(const float4*)(p.ret_gn + layer * 512 + e0);
          bf16x4 o;
          o[0] = (short)f2bf(O[mi][4 * g4 + 0] * rn * gn.x * siluf(bf2f((bf16)gv[0])));
          o[1] = (short)f2bf(O[mi][4 * g4 + 1] * rn * gn.y * siluf(bf2f((bf16)gv[1])));
          o[2] = (short)f2bf(O[mi][4 * g4 + 2] * rn * gn.z * siluf(bf2f((bf16)gv[2])));
          o[3] = (short)f2bf(O[mi][4 * g4 + 3] * rn * gn.w * siluf(bf2f((bf16)gv[3])));
          *(bf16x4*)gp = o;
        }
    }
    __builtin_amdgcn_fence(__ATOMIC_SEQ_CST, "workgroup");
    __syncthreads();
#pragma unroll
    for (int i = 0; i < 16; ++i) ST[(etile * 32 + crow(i, hh)) * 72 + dtile * 32 + r] = f2bf(Sacc[i]);
  }
  if (!lat) {
    float* so = p.out + OUT_ST + ((((size_t)bglob * 4 + layer) * 2 + dir) * 8 + hd) * 4096;
#pragma unroll
    for (int i = 0; i < 16; ++i) so[(dtile * 32 + r) * 64 + etile * 32 + crow(i, hh)] = Sacc[i];
  }
}

DI void p2(const Params& p, int layer, int grp, char* smem, int* s_item) {
  int* ctr = (int*)(p.ws + OFF_CTR) + layer * 2 + grp;
  const int n_rl = 32, n_hl = 512, n_al = 512;
  const int n_hc = grp ? 0 : 512, n_rc = grp ? 0 : 256, n_ac = grp ? 0 : 256;
  const int total = n_rl + n_hl + n_al + n_hc + n_rc + n_ac;
  const int latbase = grp ? 0 : T_CTX;
  const int latb0 = grp ? 4 : 0;
  for (;;) {
    __syncthreads();
    if (threadIdx.x == 0) *s_item = atomicAdd(ctr, 1);
    __syncthreads();
    int it = *s_item;
    if (it >= total) break;
    if (it < n_rl) {
      const int b = it >> 3, hd = it & 7;
      ret_item(p, layer, true, 32, latbase + b * 4096, latb0 + b, hd, smem);
      continue;
    }
    it -= n_rl;
    if (it < n_hl) { hyena_item<4, 4096>(p, layer, 0, latbase, it, smem); continue; }
    it -= n_hl;
    if (it < n_al) {
      const int b = it >> 7, kvh = (it >> 6) & 1, qb = it & 63;
      attn_item(p, layer, true, latbase + b * 4096, latb0 + b, kvh, qb, smem);
      continue;
    }
    it -= n_al;
    if (it < n_hc) { hyena_item<32, 256>(p, layer, 1, 0, it, smem); continue; }
    it -= n_hc;
    if (it < n_rc) {
      const int b = it >> 3, hd = it & 7;
      ret_item(p, layer, false, 2, b * 256, b, hd, smem);
      continue;
    }
    it -= n_rc;
    {
      const int b = it >> 3, kvh = (it >> 2) & 1, qb = it & 3;
      attn_item(p, layer, false, b * 256, b, kvh, qb, smem);
    }
  }
}

DI unsigned pk2(float a, float b) { return (unsigned)f2bf(a) | ((unsigned)f2bf(b) << 16); }
DI float pklo(unsigned u) { return __uint_as_float(u << 16); }
DI float pkhi(unsigned u) { return __uint_as_float(u & 0xffff0000u); }
DI void p3a(const Params& p, int layer, int grp, char* smem) {
  const int tgn = grp ? 16384 : TG;
  const int mtiles = tgn / 256, ntot = mtiles * 8;
  const int tid = otid(), lane = tid & 63, wave = tid >> 6;
  const int wm = wave >> 1, wn = wave & 1, r = lane & 31, h = lane >> 5;
  const bf16* H = (const bf16*)(p.ws + OFF_H);
  const bf16* wl = (const bf16*)(p.ws + OFF_W) + (size_t)layer * W_LAYER;
  bf16* MG = (bf16*)(p.ws + OFF_MERGED);
  u32x4 ra[2][4], rb[2][2];
  bool pre = false;
  const bf16* YaT = (const bf16*)(p.ws + OFF_YA);
  for (int id = blockIdx.x; id < ntot; id += gridDim.x) {
    const int m0 = ((id >> 7) * 16 + (id & 15)) * 256, n0 = ((id & 127) >> 4) * 128;
    const int idn = id + gridDim.x;
    const bool hn = idn < ntot;
    const int m0n = ((idn >> 7) * 16 + (idn & 15)) * 256, n0n = ((idn & 127) >> 4) * 128;
    unsigned mgp[2][2][8];
#pragma unroll
    for (int a = 0; a < 2; ++a)
#pragma unroll
      for (int b = 0; b < 2; ++b)
#pragma unroll
        for (int i = 0; i < 8; ++i) mgp[a][b][i] = 0u;
#pragma unroll 1
    for (int br = 0; br < 3; ++br) {
      const GemmSrc gate = mksrc(H + (size_t)m0 * 1024, 1024, wl + W_MG + (size_t)(br * 1024 + n0) * 1024, 1024, 0);
      const bf16* WB = wl + (br == 0 ? W_A : br == 1 ? W_B : W_C);
      const GemmSrc bsrc = br == 0 ? mksrc(YaT + m0, TG, WB + (size_t)n0 * 512, 512, 1)
                                   : mksrc((const bf16*)(p.ws + (br == 1 ? OFF_AG : OFF_RG)) + (size_t)m0 * 512, 512, WB + (size_t)n0 * 512, 512, 0);
      const GemmSrc after = br < 2 ? mksrc(H + (size_t)m0 * 1024, 1024, wl + W_MG + (size_t)((br + 1) * 1024 + n0) * 1024, 1024, 0)
                                   : mksrc(H + (size_t)m0n * 1024, 1024, wl + W_MG + (size_t)n0n * 1024, 1024, 0);
      unsigned sg[2][2][8];
      {
        f32x16 ag[2][2];
#pragma unroll
        for (int a = 0; a < 2; ++a)
#pragma unroll
          for (int b = 0; b < 2; ++b) ag[a][b] = zero16();
        gemm_main<2, false>(gate, 1024, ag, smem, ra, rb, false, bsrc, false);
#pragma unroll
        for (int ni = 0; ni < 2; ++ni) {
          const float bias = p.b_merge[layer * 3072 + br * 1024 + n0 + wn * 64 + ni * 32 + r];
#pragma unroll
          for (int mi = 0; mi < 2; ++mi) {
#pragma unroll
            for (int i = 0; i < 8; ++i)
              sg[mi][ni][i] = pk2(sigmf(ag[mi][ni][2 * i] + bias), sigmf(ag[mi][ni][2 * i + 1] + bias));
            __builtin_amdgcn_sched_barrier(0);
          }
        }
      }
      f32x16 ay[2][2];
#pragma unroll
      for (int a = 0; a < 2; ++a)
#pragma unroll
        for (int b = 0; b < 2; ++b) ay[a][b] = zero16();
      if (br == 0) gemm_main<2, true>(bsrc, 512, ay, smem, ra, rb, false, after, false);
      else gemm_main<2, false>(bsrc, 512, ay, smem, ra, rb, false, after, false);
#pragma unroll
      for (int mi = 0; mi < 2; ++mi)
#pragma unroll
        for (int ni = 0; ni < 2; ++ni) {
#pragma unroll
          for (int i = 0; i < 8; ++i) {
            const float lo = pklo(mgp[mi][ni][i]) + pklo(sg[mi][ni][i]) * ay[mi][ni][2 * i];
            const float hi = pkhi(mgp[mi][ni][i]) + pkhi(sg[mi][ni][i]) * ay[mi][ni][2 * i + 1];
            mgp[mi][ni][i] = pk2(lo, hi);
          }
          __builtin_amdgcn_sched_barrier(0);
        }
    }
#pragma unroll
    for (int mi = 0; mi < 2; ++mi)
#pragma unroll
      for (int ni = 0; ni < 2; ++ni)
#pragma unroll
        for (int i = 0; i < 8; ++i) {
          bf16* d = MG + (size_t)(m0 + wm * 64 + mi * 32) * 1024 + n0 + wn * 64 + ni * 32 + r;
          d[(size_t)crow(2 * i, h) * 1024] = (bf16)(mgp[mi][ni][i] & 0xffffu);
          d[(size_t)crow(2 * i + 1, h) * 1024] = (bf16)(mgp[mi][ni][i] >> 16);
        }
  }
}

DI void p3b(const Params& p, int layer, int grp, char* smem) {
  const int g0 = grp ? TG : 0, tgn = grp ? 16384 : TG;
  const int mtiles = tgn / 256, ntot = mtiles * 8;
  const int tid = otid(), lane = tid & 63, wave = tid >> 6;
  const int wm = wave >> 1, wn = wave & 1, r = lane & 31, h = lane >> 5;
  const bf16* MG = (const bf16*)(p.ws + OFF_MERGED);
  const bf16* WoT = (const bf16*)(p.ws + OFF_W) + (size_t)layer * W_LAYER + W_O;
  const float* mods = (const float*)(p.ws + OFF_MODS);
  u32x4 ra[2][4], rb[2][2];
  bool pre = false;
  for (int id = blockIdx.x; id < ntot; id += gridDim.x) {
    const int band = id >> 7, rem = id & 127;
    const int mt = band * 16 + (rem & 15), nt = rem >> 4;
    const int m0 = mt * 256, n0 = nt * 128;
    const int idn = id + gridDim.x;
    const bool hn = idn < ntot;
    const int m0n = ((idn >> 7) * 16 + (idn & 15)) * 256, n0n = ((idn & 127) >> 4) * 128;
    f32x16 acc[2][2];
#pragma unroll
    for (int a = 0; a < 2; ++a)
#pragma unroll
      for (int b = 0; b < 2; ++b) acc[a][b] = zero16();
    gemm_main<2, false>(mksrc(MG + (size_t)m0 * 1024, 1024, WoT + (size_t)n0 * 1024, 1024, 0), 1024, acc, smem, ra, rb, pre,
                        mksrc(MG + (size_t)m0n * 1024, 1024, WoT + (size_t)n0n * 1024, 1024, 0), hn);
    pre = true;
    const int tg0 = g0 + m0;
    const float* gate = mods + (layer * 9 + cond_of(tg0)) * 3072 + 2048;
    const float *qxp = launder(p.x_prompt), *qxs = launder(p.x_sample), *qo = launder(p.out);
    const float* xsb = layer == 0 ? (tg0 < T_CTX ? qxp + (size_t)tg0 * DM : qxs + (size_t)(tg0 - T_CTX) * DM) : qo + (size_t)tg0 * DM;
    float* xdb = p.out + (size_t)tg0 * DM;
#pragma unroll
    for (int ni = 0; ni < 2; ++ni) {
      const int col = n0 + wn * 64 + ni * 32 + r;
      const float gt = gate[col];
#pragma unroll
      for (int mi = 0; mi < 2; ++mi)
#pragma unroll
        for (int i = 0; i < 16; ++i) {
          const int ro = (wm * 64 + mi * 32 + crow(i, h)) * DM + col;
          xdb[ro] = xsb[ro] + gt * acc[mi][ni][i];
        }
    }
  }
}

DI void final_norm(const Params& p) {
  const int tid_ = otid();
  const int lane = tid_ & 63, wave = tid_ >> 6;
  for (int it = blockIdx.x; it < T_ALL / 8; it += gridDim.x) {
    const int tg = it * 8 + wave;
    float* x = p.out + (size_t)tg * DM;
    float4 v[4];
    float ss = 0.f;
#pragma unroll
    for (int i = 0; i < 4; ++i) {
      v[i] = *(const float4*)(x + (lane + 64 * i) * 4);
      ss += v[i].x * v[i].x + v[i].y * v[i].y + v[i].z * v[i].z + v[i].w * v[i].w;
    }
#pragma unroll
    for (int o = 32; o > 0; o >>= 1) ss += __shfl_xor(ss, o);
    const float rstd = rsqrtf(ss * (1.f / 1024.f) + 1e-6f);
#pragma unroll
    for (int i = 0; i < 4; ++i) {
      const int col = (lane + 64 * i) * 4;
      const float4 w = *(const float4*)(p.final_w + col);
      *(float4*)(x + col) = make_float4(v[i].x * rstd * w.x, v[i].y * rstd * w.y, v[i].z * rstd * w.z, v[i].w * rstd * w.w);
    }
  }
}


#define XB_TMO 128
#define XB_XCNT(j) (256 + 64 * (j))
#define XB_XSUB(j) (1280 + 64 * (j))
#define XB_XGEN(j) (2304 + 64 * (j))
#define XB_TOP 3328
#define XB_TOPGEN 3392
#define XB_SPIN_CAP (1u << 22)
DI unsigned xb_ld(unsigned* p) { return __hip_atomic_load(p, __ATOMIC_RELAXED, __HIP_MEMORY_SCOPE_AGENT); }
DI unsigned xb_add(unsigned* p, unsigned v) { return __hip_atomic_fetch_add(p, v, __ATOMIC_RELAXED, __HIP_MEMORY_SCOPE_AGENT); }
DI unsigned xb_xcc_id() { return (unsigned)__builtin_amdgcn_s_getreg((3 << 11) | 20) & 0xFu; }
#define XB_SPIN(cond, bar)                                          \
  do {                                                              \
    unsigned _sp = 0;                                               \
    while (cond) {                                                  \
      __builtin_amdgcn_s_sleep(1);                                  \
      if ((++_sp & 255u) == 0u) {                                   \
        if (xb_ld(&(bar)[XB_TMO])) break;                           \
        if (_sp > XB_SPIN_CAP) {                                    \
          atomicAdd(&(bar)[XB_TMO], 1u);                            \
          break;                                                    \
        }                                                           \
      }                                                             \
    }                                                               \
  } while (0)
struct XcdBarrier {
  unsigned* bar;
  unsigned x;
  volatile unsigned* st;
};
DI void xcd_barrier_complete(unsigned* bar, unsigned x, unsigned& nloc, unsigned& nx) {
  const unsigned G = gridDim.x;
  unsigned sum, cnt, mine, sp = 0u;
  for (;;) {
    sum = 0u; cnt = 0u; mine = 0u;
#pragma unroll
    for (unsigned j = 0; j < 16; ++j) {
      const unsigned c = xb_ld(&bar[XB_XCNT(j)]);
      sum += c;
      cnt += (c > 0u) ? 1u : 0u;
      mine = (j == x) ? c : mine;
    }
    if (sum == G) break;
    __builtin_amdgcn_s_sleep(1);
    if ((++sp & 255u) == 0u) {
      if (xb_ld(&bar[XB_TMO])) break;
      if (sp > XB_SPIN_CAP) { atomicAdd(&bar[XB_TMO], 1u); break; }
    }
  }
  nloc = mine > 0u ? mine : 1u;
  nx = cnt > 0u ? cnt : 1u;
}
DI void xcd_barrier(char* ws, volatile unsigned* st) {
  asm volatile("" : "+s"(ws));
  XcdBarrier b;
  b.bar = (unsigned*)(ws + OFF_BAR);
  b.x = xb_xcc_id();
  b.st = st;
  asm volatile("s_waitcnt vmcnt(0)" ::: "memory");
  __syncthreads();
  if (threadIdx.x == 0) {
    unsigned* bar = b.bar;
    __builtin_amdgcn_s_waitcnt(0);
    unsigned nloc = b.st[0], nx = b.st[1];
    if (nloc == 0u) {
      xcd_barrier_complete(bar, b.x, nloc, nx);
      b.st[0] = nloc;
      b.st[1] = nx;
    }
    const unsigned old = xb_add(&bar[XB_XSUB(b.x)], 1u);
    const unsigned gen = old / nloc;
    if (old + 1u == (gen + 1u) * nloc) {
      __builtin_amdgcn_fence(__ATOMIC_RELEASE, "agent");
      asm volatile("s_waitcnt vmcnt(0)" ::: "memory");
      const unsigned og = xb_add(&bar[XB_TOP], 1u);
      const unsigned tg = og / nx;
      if (og + 1u == (tg + 1u) * nx) xb_add(&bar[XB_TOPGEN], 1u);
      else XB_SPIN(xb_ld(&bar[XB_TOPGEN]) == tg, bar);
      __builtin_amdgcn_fence(__ATOMIC_ACQUIRE, "agent");
      xb_add(&bar[XB_XGEN(b.x)], 1u);
      asm volatile("s_waitcnt vmcnt(0)" ::: "memory");
    } else {
      XB_SPIN(xb_ld(&bar[XB_XGEN(b.x)]) == gen, bar);
      __builtin_amdgcn_fence(__ATOMIC_ACQUIRE, "agent");
      asm volatile("s_waitcnt vmcnt(0)" ::: "memory");
    }
  }
  __syncthreads();
}

__global__ void __launch_bounds__(512) mega(Params p) {
  __shared__ __attribute__((aligned(16))) char smem[SMEM_BYTES];
  __shared__ __attribute__((aligned(16))) unsigned xb_words[4];
  __shared__ int s_item;
  cg::grid_group grid = cg::this_grid();
  if (threadIdx.x == 0) { xb_words[0] = 0u; xb_words[1] = 0u; xb_words[2] = 0u; xb_words[3] = 0u; }
  __syncthreads();
  if (threadIdx.x == 0) (void)xb_add(&((unsigned*)(p.ws + OFF_BAR))[XB_XCNT(xb_xcc_id())], 1u);
  phase0(p, smem);
  grid.sync();
#pragma unroll 1
  for (int layer = 0; layer < DEPTH; ++layer) {
#pragma unroll 1
    for (int grp = 0; grp < 2; ++grp) {
      int ly = layer, gp = grp;
      asm volatile("" : "+s"(ly), "+s"(gp));
      p1a(p, ly, gp, smem);
      xcd_barrier(p.ws, xb_words);
      asm volatile("" : "+s"(ly), "+s"(gp));
      p1b(p, ly, gp, smem);
      xcd_barrier(p.ws, xb_words);
      asm volatile("" : "+s"(ly), "+s"(gp));
      p2(p, ly, gp, smem, &s_item);
      xcd_barrier(p.ws, xb_words);
      asm volatile("" : "+s"(ly), "+s"(gp));
      p3a(p, ly, gp, smem);
      xcd_barrier(p.ws, xb_words);
      asm volatile("" : "+s"(ly), "+s"(gp));
      p3b(p, ly, gp, smem);
      xcd_barrier(p.ws, xb_words);
    }
  }
  final_norm(p);
}

extern "C" void kernel_launch(void* const* d_in, const int* in_sizes, int n_in, void* d_out, int out_size, void* d_ws,
                              size_t ws_size, hipStream_t stream) {
  static int grid_blocks = 0;
  if (!grid_blocks) {
    int dev = 0, cus = 0, per_cu = 0;
    hipGetDevice(&dev);
    hipDeviceGetAttribute(&cus, hipDeviceAttributeMultiprocessorCount, dev);
    hipOccupancyMaxActiveBlocksPerMultiprocessor(&per_cu, mega, 512, 0);
    if (per_cu < 1) per_cu = 1;
    if (per_cu > 1) per_cu = 1;
    grid_blocks = cus * per_cu;
  }
  Params p{};
  const float** pp = (const float**)&p;
  for (int i = 0; i < 27; ++i) pp[i] = (const float*)d_in[i];
  p.out = (float*)d_out;
  p.ws = (char*)d_ws;
  if (ws_size < WS_NEEDED) fprintf(stderr, "workspace too small: %zu < %zu\n", ws_size, (size_t)WS_NEEDED);
  hipMemsetAsync(d_ws, 0, ZERO_BYTES, stream);
  void* args[] = {&p};
  hipError_t e = hipLaunchCooperativeKernel((void*)mega, dim3(grid_blocks), dim3(512), args, 0, stream);
  if (e != hipSuccess) fprintf(stderr, "cooperative launch failed: %s (grid %d)\n", hipGetErrorString(e), grid_blocks);
}
```

```cpp
#include <hip/hip_runtime.h>
#include <hip/hip_cooperative_groups.h>
#include <cstdio>
namespace cg = cooperative_groups;

#define DI __device__ __forceinline__
typedef unsigned short bf16;
typedef __attribute__((ext_vector_type(8))) short bf16x8;
typedef __attribute__((ext_vector_type(4))) short bf16x4;
typedef __attribute__((ext_vector_type(16))) float f32x16;
typedef __attribute__((ext_vector_type(4))) unsigned u32x4;
typedef __attribute__((ext_vector_type(4))) float f32x4v;
#define MFMA(a, b, c) __builtin_amdgcn_mfma_f32_32x32x16_bf16((a), (b), (c), 0, 0, 0)

constexpr int DM = 1024;
constexpr int DEPTH = 4;
constexpr int T_CTX = 8192;
constexpr int T_ALL = 40960;
constexpr int TG = 24576;
constexpr int IN_DIM = 5376;
constexpr float LOG2E = 1.4426950408889634f;

constexpr size_t OFF_MODS = 0;
constexpr size_t OFF_FSUM = 458752;
constexpr size_t OFF_CTR = 491520;
constexpr size_t OFF_BAR = 495616;
constexpr size_t ZERO_BYTES = 524288;
constexpr size_t OFF_ROPE = ZERO_BYTES;
constexpr size_t OFF_W = OFF_ROPE + 1048576;
constexpr size_t W_IN = 0, W_MG = 5505024, W_A = 8650752, W_B = 9175040, W_C = 9699328, W_O = 10223616, W_LAYER = 11272192;
constexpr size_t OFF_GL = OFF_W + W_LAYER * 2 * 4;
constexpr size_t OFF_GC = OFF_GL + 33554432;
constexpr size_t OFF_H = OFF_GC + 2097152;
constexpr size_t OFF_HYT = OFF_H + (size_t)TG * 2048;
constexpr size_t OFF_AQ = OFF_HYT + (size_t)TG * 4096;
constexpr size_t OFF_AK = OFF_AQ + (size_t)TG * 1024;
constexpr size_t OFF_AV = OFF_AK + (size_t)TG * 256;
constexpr size_t OFF_AG = OFF_AV + (size_t)TG * 256;
constexpr size_t OFF_RQ = OFF_AG + (size_t)TG * 1024;
constexpr size_t OFF_RK = OFF_RQ + (size_t)TG * 1024;
constexpr size_t OFF_RV = OFF_RK + (size_t)TG * 1024;
constexpr size_t OFF_RG = OFF_RV + (size_t)TG * 1024;
constexpr size_t OFF_YA = OFF_RG + (size_t)TG * 1024;
constexpr size_t OFF_OFB = OFF_YA + (size_t)TG * 1024;
constexpr size_t WS_NEEDED = OFF_OFB + (size_t)TG * 1024;
constexpr size_t OFF_MERGED = OFF_RQ;

constexpr size_t OUT_CK = 41943040, OUT_CV = 46137344, OUT_ST = 50331648;

constexpr int SMEM_BYTES = 135168;

struct Params {
  const float *x_prompt, *x_sample, *c, *cache_k, *cache_v, *state_ret, *c_ctx, *norm_w, *w_mod, *b_mod, *w_in, *hy_conv,
      *hy_w1, *hy_b1, *hy_freq, *hy_w2, *hy_skip, *attn_sink, *ret_theta, *ret_gn, *w_a, *w_b, *w_c, *w_merge, *b_merge,
      *w_out, *final_w;
  float* out;
  char* ws;
};

DI bf16 f2bf(float x) {
  __bf16 b = (__bf16)x;
  return __builtin_bit_cast(unsigned short, b);
}
DI float bf2f(bf16 u) { return __uint_as_float(((unsigned)u) << 16); }
DI int crow(int reg, int h) { return (reg & 3) + 8 * (reg >> 2) + 4 * h; }
DI float siluf(float x) { return x / (1.f + __expf(-x)); }
DI float sigmf(float x) { return 1.f / (1.f + __expf(-x)); }
DI bf16x8 pack8(const f32x16& x, int s) {
  bf16x8 r;
#pragma unroll
  for (int j = 0; j < 8; ++j) r[j] = (short)f2bf(x[8 * s + j]);
  return r;
}
DI f32x16 zero16() {
  f32x16 z;
#pragma unroll
  for (int i = 0; i < 16; ++i) z[i] = 0.f;
  return z;
}
DI const float* launder(const float* q) {
  asm volatile("" : "+s"(q));
  return q;
}
DI int otid() {
  int t = threadIdx.x;
  asm volatile("" : "+v"(t));
  return t;
}
DI int cond_of(int tg) { return tg < T_CTX ? 0 : 1 + ((tg - T_CTX) >> 12); }

DI void lds_barrier() { asm volatile("s_waitcnt lgkmcnt(0)\n\ts_barrier" ::: "memory"); }

struct GemmSrc {
  const bf16* A;
  const bf16* B;
  int lda, ldb, atr;
};
DI GemmSrc mksrc(const bf16* A, int lda, const bf16* B, int ldb, int atr) {
  GemmSrc g;
  g.A = A; g.B = B; g.lda = lda; g.ldb = ldb; g.atr = atr;
  return g;
}
template <int NI>
DI void gemm_issue(const GemmSrc& g, int kt, int tid, u32x4 (&ra)[4], u32x4 (&rb)[NI]) {
  const int lrow = tid >> 3, lkc = (tid & 7) * 8;
  const bf16* ab = g.atr ? g.A + (size_t)((tid & 63) + kt * 64) * g.lda + (tid >> 6) * 8
                         : g.A + (size_t)lrow * g.lda + lkc + kt * 64;
  const size_t astep = g.atr ? (size_t)64 : (size_t)64 * g.lda;
#pragma unroll
  for (int i = 0; i < 4; ++i) ra[i] = *(const u32x4*)(ab + astep * i);
  const bf16* bb = g.B + (size_t)lrow * g.ldb + lkc + kt * 64;
#pragma unroll
  for (int i = 0; i < NI; ++i) rb[i] = *(const u32x4*)(bb + (size_t)(64 * i) * g.ldb);
}
template <int NI, bool ATR>
DI void gemm_stage(bf16* As, bf16* Bs, int tid, const u32x4 (&ra)[4], const u32x4 (&rb)[NI]) {
  constexpr int PITCH = 72;
  const int lrow = tid >> 3, lkc = (tid & 7) * 8;
#pragma unroll
  for (int i = 0; i < 4; ++i) {
    if (ATR) {
      bf16* d = As + (((tid >> 6) + 8 * i) * 8) * PITCH + (tid & 63);
      const bf16x8 v = __builtin_bit_cast(bf16x8, ra[i]);
#pragma unroll
      for (int e = 0; e < 8; ++e) d[e * PITCH] = (bf16)v[e];
    } else {
      *(u32x4*)(As + (lrow + 64 * i) * PITCH + lkc) = ra[i];
    }
  }
#pragma unroll
  for (int i = 0; i < NI; ++i) *(u32x4*)(Bs + (lrow + 64 * i) * PITCH + lkc) = rb[i];
}

template <int NI, bool ATR>
DI void gemm_stage_part(bf16* As, bf16* Bs, int tid, const u32x4 (&ra)[4], const u32x4 (&rb)[NI], int part) {
  constexpr int PITCH = 72;
  const int lrow = tid >> 3, lkc = (tid & 7) * 8;
#pragma unroll
  for (int i = 0; i < 4; ++i) {
    if (i != part) continue;
    if (ATR) {
      bf16* d = As + (((tid >> 6) + 8 * i) * 8) * PITCH + (tid & 63);
      const bf16x8 v = __builtin_bit_cast(bf16x8, ra[i]);
#pragma unroll
      for (int e = 0; e < 8; ++e) d[e * PITCH] = (bf16)v[e];
    } else {
      *(u32x4*)(As + (lrow + 64 * i) * PITCH + lkc) = ra[i];
    }
  }
#pragma unroll
  for (int i = 0; i < NI; ++i)
    if (2 * i == part) *(u32x4*)(Bs + (lrow + 64 * i) * PITCH + lkc) = rb[i];
}

template <int NI, bool ATR>
DI void gemm_main(const GemmSrc& cur, int K, f32x16 (&acc)[2][NI], char* smem, u32x4 (&ra)[2][4], u32x4 (&rb)[2][NI],
                  bool preloaded, const GemmSrc& nxt, bool has_next) {
  constexpr int BN = 64 * NI;
  constexpr int PITCH = 72;
  bf16* As = (bf16*)smem;
  bf16* Bs = As + 2 * 256 * PITCH;
  const int tid = otid(), lane = tid & 63, wave = tid >> 6;
  const int wm = wave >> 1, wn = wave & 1, r = lane & 31, h = lane >> 5;
  const int nk = K / 64;
  if (!preloaded) {
    gemm_issue<NI>(cur, 0, tid, ra[0], rb[0]);
    gemm_issue<NI>(cur, 1, tid, ra[1], rb[1]);
  }
  lds_barrier();
  gemm_stage<NI, ATR>(As, Bs, tid, ra[0], rb[0]);
  lds_barrier();
#pragma unroll 1
  for (int kt = 0; kt < nk; kt += 2) {
#pragma unroll
    for (int u = 0; u < 2; ++u) {
      const int k = kt + u;
      {
        const bool inr = k + 2 < nk;
        GemmSrc g = (inr || !has_next) ? cur : nxt;
        const int kk = inr ? k + 2 : (has_next ? k + 2 - nk : nk - 1);
        gemm_issue<NI>(g, kk, tid, ra[u], rb[u]);
      }
      const bf16* Ab = As + u * 256 * PITCH + (wm * 64 + r) * PITCH + h * 8;
      const bf16* Bb = Bs + u * BN * PITCH + (wn * 32 * NI + r) * PITCH + h * 8;
#pragma unroll
      for (int ks = 0; ks < 4; ++ks) {
        bf16x8 a[2], b[NI];
#pragma unroll
        for (int mi = 0; mi < 2; ++mi) a[mi] = *(const bf16x8*)(Ab + mi * 32 * PITCH + ks * 16);
#pragma unroll
        for (int ni = 0; ni < NI; ++ni) b[ni] = *(const bf16x8*)(Bb + ni * 32 * PITCH + ks * 16);
#pragma unroll
        for (int mi = 0; mi < 2; ++mi)
#pragma unroll
          for (int ni = 0; ni < NI; ++ni) acc[mi][ni] = MFMA(a[mi], b[ni], acc[mi][ni]);
        gemm_stage_part<NI, ATR>(As + (u ^ 1) * 256 * PITCH, Bs + (u ^ 1) * BN * PITCH, tid, ra[u ^ 1], rb[u ^ 1], ks);
      }
      lds_barrier();
    }
  }
}

DI void p0_mod_item(const Params& p, int item, char* smem) {
  const int tid = otid();
  const int l = item / 48, rem = item % 48, nch = rem / 8, ks = rem % 8;
  float* sc = (float*)smem;
  __syncthreads();
  for (int idx = tid; idx < 9 * 128; idx += 512) {
    const int cnd = idx >> 7, k = ks * 128 + (idx & 127);
    const float *qcc = launder(p.c_ctx), *qc = launder(p.c);
    const float v = cnd == 0 ? qcc[k] : qc[(cnd - 1) * 1024 + k];
    sc[idx] = v / (1.f + expf(-v));
  }
  __syncthreads();
  const int n = nch * 512 + tid;
  float acc[9];
#pragma unroll
  for (int i = 0; i < 9; ++i) acc[i] = 0.f;
  const float* w = p.w_mod + ((size_t)l * 1024 + ks * 128) * 3072 + n;
#pragma unroll 4
  for (int kk = 0; kk < 128; ++kk) {
    const float wv = w[(size_t)kk * 3072];
#pragma unroll
    for (int i = 0; i < 9; ++i) acc[i] += sc[i * 128 + kk] * wv;
  }
  float* mods = (float*)(p.ws + OFF_MODS);
  const float bias = ks == 0 ? p.b_mod[l * 3072 + n] : 0.f;
#pragma unroll
  for (int i = 0; i < 9; ++i) atomicAdd(&mods[(l * 9 + i) * 3072 + n], acc[i] + bias);
}

DI void transpose_tile(const float* __restrict__ src, int ldn, bf16* __restrict__ dst, int ldk, int k0, int n0, char* smem) {
  float* T = (float*)smem;
  const int tid = otid();
  __syncthreads();
  {
    const int k = tid >> 3, nc = (tid & 7) * 8;
    const float* s = src + (size_t)(k0 + k) * ldn + n0 + nc;
    const float4 a = *(const float4*)s, b = *(const float4*)(s + 4);
    float* t = T + k * 65 + nc;
    t[0] = a.x; t[1] = a.y; t[2] = a.z; t[3] = a.w; t[4] = b.x; t[5] = b.y; t[6] = b.z; t[7] = b.w;
  }
  __syncthreads();
  {
    const int n = tid >> 3, kc = (tid & 7) * 8;
    bf16x8 v;
#pragma unroll
    for (int j = 0; j < 8; ++j) v[j] = (short)f2bf(T[(kc + j) * 65 + n]);
    *(bf16x8*)(dst + (size_t)(n0 + n) * ldk + k0 + kc) = v;
  }
}

DI void p0_transpose_item(const Params& p, int item, char* smem) {
  const int l = item / 2752;
  int rem = item % 2752;
  bf16* wl = (bf16*)(p.ws + OFF_W) + (size_t)l * W_LAYER;
  if (rem < 1344) {
    const int kt = rem / 84, nt = rem % 84;
    transpose_tile(p.w_in + (size_t)l * 1024 * IN_DIM, IN_DIM, wl + W_IN, 1024, kt * 64, nt * 64, smem);
    return;
  }
  rem -= 1344;
  if (rem < 768) {
    const int kt = rem / 48, nt = rem % 48;
    transpose_tile(p.w_merge + (size_t)l * 1024 * 3072, 3072, wl + W_MG, 1024, kt * 64, nt * 64, smem);
    return;
  }
  rem -= 768;
  if (rem < 384) {
    const int br = rem / 128, r2 = rem % 128, kt = r2 / 16, nt = r2 % 16;
    const float *qa = launder(p.w_a), *qb = launder(p.w_b), *qc = launder(p.w_c);
    const float* src = (br == 0 ? qa : br == 1 ? qb : qc) + (size_t)l * 512 * 1024;
    transpose_tile(src, 1024, wl + (br == 0 ? W_A : br == 1 ? W_B : W_C), 512, kt * 64, nt * 64, smem);
    return;
  }
  rem -= 384;
  {
    const int kt = rem / 16, nt = rem % 16;
    transpose_tile(p.w_out + (size_t)l * 1024 * 1024, 1024, wl + W_O, 1024, kt * 64, nt * 64, smem);
  }
}

DI void p0_rope_item(const Params& p, int item) {
  const int idx = item * 512 + otid();
  const int t = idx >> 5, f = idx & 31;
  const float inv = powf(10000.f, -(float)(f & 15) / 16.f);
  const float ang = (float)(f < 16 ? (t >> 6) : (t & 63)) * inv;
  float2 cs;
  cs.x = cosf(ang);
  cs.y = sinf(ang);
  ((float2*)(p.ws + OFF_ROPE))[idx] = cs;
}

DI void phase0(const Params& p, char* smem) {
  const int n_mod = 192, n_tr = 11008, n_rope = 256;
  for (int it = blockIdx.x; it < n_mod + n_tr + n_rope; it += gridDim.x) {
    if (it < n_mod) p0_mod_item(p, it, smem);
    else if (it < n_mod + n_tr) p0_transpose_item(p, it - n_mod, smem);
    else p0_rope_item(p, it - n_mod - n_tr);
  }
}

DI void filter_item(const Params& p, int layer, int item, char* smem) {
  const int tid = otid();
  int var, pc, cc, L;
  if (item < 512) { var = 0; pc = item >> 3; cc = item & 7; L = 4096; }
  else { var = 1; pc = (item - 512) >> 3; cc = (item - 512) & 7; L = 256; }
  float* z = (float*)smem;
  float* hid = z + 64 * 17;
  float* w2s = hid + 64 * 64;
  __syncthreads();
  {
    const int pos = tid >> 3, band = tid & 7;
    const int pa = pc * 64 + pos;
    const float w = 6.283185307179586f * (float)pa / (float)L;
    const float f = 1e-4f + (float)band * ((7.f - 1e-4f) / 7.f);
    z[pos * 17 + 1 + band] = cosf(f * w);
    z[pos * 17 + 9 + band] = -sinf(f * w);
    if (band == 0) z[pos * 17] = (float)pa / (float)(L - 1);
  }
  __syncthreads();
  {
    const int pos = tid >> 3, j0 = (tid & 7) * 8;
    const float* w1 = p.hy_w1 + layer * 17 * 64;
#pragma unroll
    for (int jj = 0; jj < 8; ++jj) {
      const int j = j0 + jj;
      float pre = p.hy_b1[layer * 64 + j];
      for (int f = 0; f < 17; ++f) pre += z[pos * 17 + f] * w1[f * 64 + j];
      hid[pos * 64 + j] = sinf(p.hy_freq[layer * 64 + j] * pre);
    }
    const float* w2 = p.hy_w2 + (size_t)layer * 64 * 2048 + cc * 256;
    for (int idx = tid; idx < 64 * 256; idx += 512) w2s[idx] = w2[(idx >> 8) * 2048 + (idx & 255)];
  }
  __syncthreads();
  {
    const int n = cc * 256 + (tid & 255), half = tid >> 8;
    const int o = n >> 10, dir = (n >> 9) & 1, c = n & 511;
    const float min_d = -3.0701134573253945f, max_d = -15.350567286626973f;
    const float ad = fabsf(min_d + (float)c * ((max_d - min_d) / 511.f));
    float* g = (float*)(p.ws + (var == 0 ? OFF_GL : OFF_GC)) + ((size_t)(o * 512 + c)) * (2 * L);
    float asum = 0.f;
    for (int pp = 0; pp < 32; ++pp) {
      const int pos = half * 32 + pp, pa = pc * 64 + pos;
      float acc = 0.f;
#pragma unroll
      for (int j = 0; j < 64; ++j) acc += hid[pos * 64 + j] * w2s[j * 256 + (tid & 255)];
      const float t = (float)pa / (float)(L - 1);
      const float v = acc * expf(-t * ad);
      asum += fabsf(v);
      int y;
      if (dir == 0) y = L - pa;
      else y = (pa == 0) ? 0 : L + pa;
      g[y] = v;
    }
    atomicAdd((float*)(p.ws + OFF_FSUM) + ((layer * 2 + var) * 2 + o) * 512 + c, asum);
  }
}

DI void p1a(const Params& p, int layer, int grp, char* smem) {
  const int g0 = grp ? TG : 0, tgn = grp ? 16384 : TG;
  const int nfilt = grp ? 0 : 544;
  const int nrow_items = tgn / 8;
  const int tid_ = otid();
  const int lane = tid_ & 63, wave = tid_ >> 6;
  bf16* H = (bf16*)(p.ws + OFF_H);
  const float* mods = (const float*)(p.ws + OFF_MODS);
  for (int it = blockIdx.x; it < nfilt + nrow_items; it += gridDim.x) {
    if (it < nfilt) { filter_item(p, layer, it, smem); continue; }
    const int tl = (it - nfilt) * 8 + wave, tg = g0 + tl;
    const float *qxp = launder(p.x_prompt), *qxs = launder(p.x_sample), *qo = launder(p.out);
    const float* x = layer == 0 ? (tg < T_CTX ? qxp + (size_t)tg * DM : qxs + (size_t)(tg - T_CTX) * DM) : qo + (size_t)tg * DM;
    float4 v[4];
    float ss = 0.f;
#pragma unroll
    for (int i = 0; i < 4; ++i) {
      v[i] = *(const float4*)(x + (lane + 64 * i) * 4);
      ss += v[i].x * v[i].x + v[i].y * v[i].y + v[i].z * v[i].z + v[i].w * v[i].w;
    }
#pragma unroll
    for (int o = 32; o > 0; o >>= 1) ss += __shfl_xor(ss, o);
    const float rstd = rsqrtf(ss * (1.f / 1024.f) + 1e-6f);
    const float* md = mods + (layer * 9 + cond_of(tg)) * 3072;
    const float* nw = p.norm_w + layer * 1024;
#pragma unroll
    for (int i = 0; i < 4; ++i) {
      const int col = (lane + 64 * i) * 4;
      const float4 sh = *(const float4*)(md + col), sc = *(const float4*)(md + 1024 + col), w = *(const float4*)(nw + col);
      bf16x4 o;
      o[0] = (short)f2bf(v[i].x * rstd * w.x * (1.f + sc.x) + sh.x);
      o[1] = (short)f2bf(v[i].y * rstd * w.y * (1.f + sc.y) + sh.y);
      o[2] = (short)f2bf(v[i].z * rstd * w.z * (1.f + sc.z) + sh.z);
      o[3] = (short)f2bf(v[i].w * rstd * w.w * (1.f + sc.w) + sh.w);
      *(bf16x4*)(H + (size_t)tl * 1024 + col) = o;
    }
  }
}

DI void p1b(const Params& p, int layer, int grp, char* smem) {
  const int g0 = grp ? TG : 0, tgn = grp ? 16384 : TG;
  const int mtiles = tgn / 256, ntot = mtiles * 42;
  const int tid = otid(), lane = tid & 63, wave = tid >> 6;
  const int wm = wave >> 1, wn = wave & 1, r = lane & 31, h = lane >> 5;
  const bf16* H = (const bf16*)(p.ws + OFF_H);
  const bf16* WinT = (const bf16*)(p.ws + OFF_W) + (size_t)layer * W_LAYER + W_IN;
  float* S = (float*)smem;
  u32x4 ra[2][4], rb[2][2];
  bool pre = false;
  for (int id = blockIdx.x; id < ntot; id += gridDim.x) {
    const int band = id / (16 * 42), rem = id % (16 * 42);
    const int mt = band * 16 + (rem & 15), nt = rem >> 4;
    const int idn = id + gridDim.x;
    const bool hn = idn < ntot;
    const int bandn = idn / (16 * 42), remn = idn % (16 * 42);
    const int mtn = bandn * 16 + (remn & 15), ntn = remn >> 4;
    f32x16 acc[2][2];
#pragma unroll
    for (int a = 0; a < 2; ++a)
#pragma unroll
      for (int b = 0; b < 2; ++b) acc[a][b] = zero16();
    gemm_main<2, false>(mksrc(H + (size_t)mt * 256 * 1024, 1024, WinT + (size_t)nt * 128 * 1024, 1024, 0), 1024, acc, smem, ra, rb, pre,
                        mksrc(H + (size_t)mtn * 256 * 1024, 1024, WinT + (size_t)ntn * 128 * 1024, 1024, 0), hn);
    pre = true;
    const int m0 = mt * 256, tg0 = g0 + m0;
    const bool lat = tg0 >= T_CTX;
    if (nt < 16) {
#pragma unroll
      for (int mi = 0; mi < 2; ++mi)
#pragma unroll
        for (int ni = 0; ni < 2; ++ni)
#pragma unroll
          for (int g4 = 0; g4 < 4; ++g4) {
            f32x4v v;
#pragma unroll
            for (int j = 0; j < 4; ++j) v[j] = acc[mi][ni][4 * g4 + j];
            *(f32x4v*)(S + (wn * 64 + ni * 32 + r) * 260 + wm * 64 + mi * 32 + 8 * g4 + 4 * h) = v;
          }
      __syncthreads();
      const int part = nt >> 2;
#pragma unroll 2
      for (int it = 0; it < 8; ++it) {
        const int pid = tid + 512 * it, cl = pid >> 5, q = pid & 31;
        const f32x4v a = *(const f32x4v*)(S + cl * 260 + q * 8), b = *(const f32x4v*)(S + cl * 260 + q * 8 + 4);
        bf16x8 v;
#pragma unroll
        for (int j = 0; j < 4; ++j) {
          v[j] = (short)f2bf(a[j]);
          v[4 + j] = (short)f2bf(b[j]);
        }
        *(bf16x8*)((bf16*)(p.ws + OFF_HYT) + ((size_t)(part * 512 + (nt & 3) * 128 + cl)) * TG + m0 + q * 8) = v;
      }
    } else {
#pragma unroll
      for (int mi = 0; mi < 2; ++mi)
#pragma unroll
        for (int ni = 0; ni < 2; ++ni)
#pragma unroll
          for (int i = 0; i < 16; ++i) S[(wm * 64 + mi * 32 + crow(i, h)) * 132 + wn * 64 + ni * 32 + r] = acc[mi][ni][i];
      __syncthreads();
      size_t off; int pitch, coloff; bool rope = false; int cache = 0;
      if (nt < 20) { off = OFF_AQ; pitch = 512; coloff = (nt - 16) * 128; rope = lat; }
      else if (nt == 20) { off = OFF_AK; pitch = 128; coloff = 0; rope = lat; cache = lat ? 0 : 1; }
      else if (nt == 21) { off = OFF_AV; pitch = 128; coloff = 0; cache = lat ? 0 : 2; }
      else if (nt < 26) { off = OFF_AG; pitch = 512; coloff = (nt - 22) * 128; }
      else if (nt < 30) { off = OFF_RQ; pitch = 512; coloff = (nt - 26) * 128; rope = lat; }
      else if (nt < 34) { off = OFF_RK; pitch = 512; coloff = (nt - 30) * 128; rope = lat; }
      else if (nt < 38) { off = OFF_RV; pitch = 512; coloff = (nt - 34) * 128; }
      else { off = OFF_RG; pitch = 512; coloff = (nt - 38) * 128; }
      bf16* dst = (bf16*)(p.ws + off);
      const float2* rt = (const float2*)(p.ws + OFF_ROPE);
#pragma unroll 2
      for (int it = 0; it < 8; ++it) {
        const int cid = tid + 512 * it, row = cid >> 4, cc = cid & 15;
        const float* sp = S + row * 132 + cc * 8;
        float v[8];
#pragma unroll
        for (int j = 0; j < 8; ++j) v[j] = sp[j];
        if (cache) {
          float* co = p.out + (cache == 1 ? OUT_CK : OUT_CV) + ((size_t)((tg0 >> 8) * 4 + layer) * 256 + row) * 128 + cc * 8;
          *(float4*)co = make_float4(v[0], v[1], v[2], v[3]);
          *(float4*)(co + 4) = make_float4(v[4], v[5], v[6], v[7]);
        }
        if (rope) {
          const int hd0 = (cc * 8) & 63, q = hd0 >> 4;
          const int tpos = (tg0 - T_CTX + row) & 4095;
          const float2* tb = rt + tpos * 32 + (q >> 1) * 16 + (hd0 & 15);
          const float* pp = sp + ((q & 1) ? -16 : 16);
          const float sg = (q & 1) ? 1.f : -1.f;
#pragma unroll
          for (int j = 0; j < 8; ++j) {
            const float2 cs = tb[j];
            v[j] = v[j] * cs.x + sg * pp[j] * cs.y;
          }
        }
        bf16x8 o;
#pragma unroll
        for (int j = 0; j < 8; ++j) o[j] = (short)f2bf(v[j]);
        *(bf16x8*)(dst + (size_t)(m0 + row) * pitch + coloff + cc * 8) = o;
      }
    }
  }
}

template <int NBT, int L>
DI void hyena_item(const Params& p, int layer, int var, int tlbase, int c, char* smem) {
  constexpr int NP = 32 / NBT, NT = (L / 8) / (32 * NP), UP = L + 8;
  bf16* U = (bf16*)smem;
  bf16* X1 = U + NBT * UP;
  bf16* X2 = X1 + NBT * UP;
  bf16* GR = X2 + NBT * UP;
  bf16* GR1 = GR + 2 * L + 8;
  const int tid = otid(), lane = tid & 63, wave = tid >> 6;
  const int n = lane & 31, hh = lane >> 5, b = n & (NBT - 1), pp = n / NBT;
  const bf16* hyT = (const bf16*)(p.ws + OFF_HYT);
  const float* fs = (const float*)(p.ws + OFF_FSUM) + (layer * 2 + var) * 1024;
  const float* gsrc = (const float*)(p.ws + (var == 0 ? OFF_GL : OFF_GC));
  __syncthreads();
#pragma unroll 1
  for (int part = 0; part < 3; ++part) {
    const bf16* src = hyT + ((size_t)(part * 512 + c)) * TG + tlbase;
    bf16* dstb = part == 0 ? U : part == 1 ? X1 : X2;
    const float w0 = p.hy_conv[(layer * 3 + 0) * 1536 + part * 512 + c];
    const float w1 = p.hy_conv[(layer * 3 + 1) * 1536 + part * 512 + c];
    const float w2 = p.hy_conv[(layer * 3 + 2) * 1536 + part * 512 + c];
#pragma unroll
    for (int it = 0; it < NBT * L / 8 / 512; ++it) {
      const int id = tid + 512 * it;
      const int bb = id / (L / 8), t8 = (id % (L / 8)) * 8;
      const bf16* s = src + bb * L + t8;
      const bf16x8 xv = *(const bf16x8*)s;
      float x[10];
      x[0] = t8 > 0 ? bf2f(s[-1]) : 0.f;
      x[9] = t8 + 8 < L ? bf2f(s[8]) : 0.f;
#pragma unroll
      for (int j = 0; j < 8; ++j) x[j + 1] = bf2f((bf16)xv[j]);
      bf16x8 o;
#pragma unroll
      for (int j = 0; j < 8; ++j) o[j] = (short)f2bf(w0 * x[j] + w1 * x[j + 1] + w2 * x[j + 2]);
      *(bf16x8*)(dstb + bb * UP + t8) = o;
    }
  }
  const int wbase = wave * (L / 8);
  const int dmin = -(wbase + (NT - 1) * 32 * NP + 32 * (NP - 1)), dmax = L - 16 - wbase;
  f32x16 acc[NT];
#pragma unroll 1
  for (int o = 0; o < 2; ++o) {
    {
      const float inv = 1.f / fs[o * 512 + c];
      const float* gs = gsrc + ((size_t)(o * 512 + c)) * (2 * L);
      const float skip = p.hy_skip[(layer * 2 + o) * 512 + c];
#pragma unroll 8
      for (int y = tid; y < 2 * L; y += 512) {
        float v = gs[y] * inv;
        if (y == L) v = (gs[L] + gs[0]) * inv + skip;
        if (y == 0) v = 0.f;
        const bf16 bv = f2bf(v);
        GR[y] = bv;
        if (y > 0) GR1[y - 1] = bv;
      }
      if (tid == 0) GR1[2 * L - 1] = 0;
    }
    __syncthreads();
#pragma unroll
    for (int q = 0; q < NT; ++q) acc[q] = zero16();
#pragma unroll 1
    for (int d = dmin; d <= dmax; d += 16) {
      const unsigned* gp = (const unsigned*)(((n & 1) ? GR1 - 1 : GR) + (L - n + d + 8 * hh));
      typedef __attribute__((ext_vector_type(4))) unsigned u4;
      u4 aw;
#pragma unroll
      for (int j = 0; j < 4; ++j) aw[j] = gp[j];
      const bf16x8 a = __builtin_bit_cast(bf16x8, aw);
#pragma unroll
      for (int q = 0; q < NT; ++q) {
        const int s0 = wbase + q * 32 * NP + 32 * pp + d;
        bf16x8 bb;
#pragma unroll
        for (int j = 0; j < 8; ++j) bb[j] = 0;
        if (s0 >= 0 && s0 <= L - 16) bb = *(const bf16x8*)(U + b * UP + s0 + 8 * hh);
        acc[q] = MFMA(a, bb, acc[q]);
      }
    }
    __syncthreads();
    if (o == 0) {
#pragma unroll
      for (int q = 0; q < NT; ++q)
#pragma unroll
        for (int i = 0; i < 16; ++i) {
          const int t = wbase + q * 32 * NP + 32 * pp + crow(i, hh);
          U[b * UP + t] = f2bf(bf2f(X1[b * UP + t]) * acc[q][i]);
        }
    } else {
      const bf16* gate = hyT + ((size_t)(3 * 512 + c)) * TG + tlbase;
#pragma unroll
      for (int q = 0; q < NT; ++q)
#pragma unroll
        for (int g4 = 0; g4 < 4; ++g4) {
          const int t = wbase + q * 32 * NP + 32 * pp + 8 * g4 + 4 * hh;
          const bf16x4 gv = *(const bf16x4*)(gate + b * L + t);
          bf16x4 ov;
#pragma unroll
          for (int j = 0; j < 4; ++j)
            ov[j] = (short)f2bf(bf2f(X2[b * UP + t + j]) * acc[q][4 * g4 + j] * siluf(bf2f((bf16)gv[j])));
          *(bf16x4*)(U + b * UP + t) = ov;
        }
      __syncthreads();
      bf16* yat = (bf16*)(p.ws + OFF_YA) + (size_t)c * TG + tlbase;
      for (int id = tid; id < NBT * L / 8; id += 512) {
        const int bb = id / (L / 8), t8 = (id % (L / 8)) * 8;
        *(bf16x8*)(yat + bb * L + t8) = *(const bf16x8*)(U + bb * UP + t8);
      }
    }
  }
}

DI void attn_item(const Params& p, int layer, bool lat, int tlbase, int bglob, int kvh, int qblk, char* smem) {
  bf16* Ks = (bf16*)smem;
  bf16* VT = Ks + 64 * 72;
  const int tid = otid(), lane = tid & 63, wave = tid >> 6;
  const int r = lane & 31, hh = lane >> 5;
  const int head = kvh * 4 + (wave >> 1);
  const int qi = qblk * 64 + (wave & 1) * 32 + r;
  const int tlq = tlbase + qi;
  const bf16* aq = (const bf16*)(p.ws + OFF_AQ);
  const bf16* ak = (const bf16*)(p.ws + OFF_AK);
  const bf16* av = (const bf16*)(p.ws + OFF_AV);
  bf16* ag = (bf16*)(p.ws + OFF_AG);
  bf16x8 bq[4];
#pragma unroll
  for (int ks = 0; ks < 4; ++ks) bq[ks] = *(const bf16x8*)(aq + (size_t)tlq * 512 + head * 64 + ks * 16 + hh * 8);
  const float sink2 = p.attn_sink[layer * 8 + head] * LOG2E;
  const float SC = 0.125f * LOG2E;
  float m = sink2, lsum = 0.f;
  f32x16 O[2];
  O[0] = zero16();
  O[1] = zero16();
  const int t_lo = lat ? (2 - qblk > 0 ? 2 - qblk : 0) : 0;
  const int t_hi = lat ? (65 - qblk < 4 ? 65 - qblk : 4) : 3;
  const int nw = t_hi - t_lo + 1;
  const int ntot = lat ? nw + 8 : nw;
  const int lj = tid >> 3, lkc = (tid & 7) * 8;
  u32x4 pr0, pr1, pr2, pr3;
  pr2 = u32x4{0, 0, 0, 0};
  pr3 = u32x4{0, 0, 0, 0};
  {
    const int kp = lat ? qblk * 64 - 128 + t_lo * 64 : 0;
    const size_t o = (size_t)(tlbase + kp + lj) * 128 + kvh * 64 + lkc;
    pr0 = *(const u32x4*)(ak + o);
    pr1 = *(const u32x4*)(av + o);
  }
#pragma unroll 1
  for (int n = 0; n < ntot; ++n) {
    const bool from_cache = lat && n >= nw;
    const bool window = lat && n < nw;
    const int kpos0 = from_cache ? (n - nw) * 64 : (lat ? qblk * 64 - 128 + (t_lo + n) * 64 : n * 64);
    lds_barrier();
    {
      bf16x8 kv, vv;
      if (from_cache) {
        const f32x4v k0 = __builtin_bit_cast(f32x4v, pr0), k1 = __builtin_bit_cast(f32x4v, pr1);
        const f32x4v v0 = __builtin_bit_cast(f32x4v, pr2), v1 = __builtin_bit_cast(f32x4v, pr3);
#pragma unroll
        for (int e = 0; e < 4; ++e) {
          kv[e] = (short)f2bf(k0[e]);
          kv[4 + e] = (short)f2bf(k1[e]);
          vv[e] = (short)f2bf(v0[e]);
          vv[4 + e] = (short)f2bf(v1[e]);
        }
      } else {
        kv = __builtin_bit_cast(bf16x8, pr0);
        vv = __builtin_bit_cast(bf16x8, pr1);
      }
      *(bf16x8*)(Ks + lj * 72 + lkc) = kv;
#pragma unroll
      for (int jj = 0; jj < 8; ++jj) VT[(lkc + jj) * 68 + lj] = (bf16)vv[jj];
    }
    lds_barrier();
    {
      const int nn = n + 1 < ntot ? n + 1 : n;
      if (lat && nn >= nw) {
        const size_t o = ((((size_t)bglob * 4 + layer) * 512 + (nn - nw) * 64 + lj) * 2 + kvh) * 64 + lkc;
        pr0 = *(const u32x4*)(p.cache_k + o);
        pr1 = *(const u32x4*)(p.cache_k + o + 4);
        pr2 = *(const u32x4*)(p.cache_v + o);
        pr3 = *(const u32x4*)(p.cache_v + o + 4);
      } else {
        const int kp = lat ? qblk * 64 - 128 + (t_lo + nn) * 64 : nn * 64;
        const size_t o = (size_t)(tlbase + kp + lj) * 128 + kvh * 64 + lkc;
        pr0 = *(const u32x4*)(ak + o);
        pr1 = *(const u32x4*)(av + o);
      }
    }
    f32x16 sc[2];
#pragma unroll
    for (int sub = 0; sub < 2; ++sub) {
      sc[sub] = zero16();
#pragma unroll
      for (int ks = 0; ks < 4; ++ks) {
        const bf16x8 a = *(const bf16x8*)(Ks + (sub * 32 + r) * 72 + ks * 16 + hh * 8);
        sc[sub] = MFMA(a, bq[ks], sc[sub]);
      }
    }
    float mx = -3.0e38f;
#pragma unroll
    for (int sub = 0; sub < 2; ++sub)
#pragma unroll
      for (int i = 0; i < 16; ++i) {
        float sv = sc[sub][i] * SC;
        if (window) {
          const int diff = qi - (kpos0 + sub * 32 + crow(i, hh));
          if (diff > 128 || diff < -128) sv = -1e30f;
        }
        sc[sub][i] = sv;
        mx = fmaxf(mx, sv);
      }
    mx = fmaxf(mx, __shfl_xor(mx, 32));
    const float mnew = fmaxf(m, mx);
    const float alpha = __builtin_amdgcn_exp2f(m - mnew);
    m = mnew;
    float ps = 0.f;
#pragma unroll
    for (int sub = 0; sub < 2; ++sub)
#pragma unroll
      for (int i = 0; i < 16; ++i) {
        sc[sub][i] = __builtin_amdgcn_exp2f(sc[sub][i] - m);
        ps += sc[sub][i];
      }
    lsum = lsum * alpha + ps;
    if (__builtin_amdgcn_ballot_w64(alpha != 1.f) != 0) {
#pragma unroll
      for (int i = 0; i < 16; ++i) {
        O[0][i] *= alpha;
        O[1][i] *= alpha;
      }
    }
#pragma unroll
    for (int sub = 0; sub < 2; ++sub)
#pragma unroll
      for (int st = 0; st < 2; ++st) {
        const bf16x8 pf = pack8(sc[sub], st);
#pragma unroll
        for (int mi = 0; mi < 2; ++mi) {
          const bf16* vp = VT + (mi * 32 + r) * 68 + sub * 32 + 16 * st + 4 * hh;
          const bf16x4 lo = *(const bf16x4*)vp, hi = *(const bf16x4*)(vp + 8);
          const bf16x8 va = __builtin_shufflevector(lo, hi, 0, 1, 2, 3, 4, 5, 6, 7);
          O[mi] = MFMA(va, pf, O[mi]);
        }
      }
  }
  const float ltot = lsum + __shfl_xor(lsum, 32) + exp2f(sink2 - m);
  const float inv = 1.f / ltot;
#pragma unroll
  for (int mi = 0; mi < 2; ++mi)
#pragma unroll
    for (int g4 = 0; g4 < 4; ++g4) {
      bf16* gp = ag + (size_t)tlq * 512 + head * 64 + mi * 32 + 8 * g4 + 4 * hh;
      const bf16x4 gv = *(const bf16x4*)gp;
      bf16x4 o;
#pragma unroll
      for (int j = 0; j < 4; ++j) o[j] = (short)f2bf(O[mi][4 * g4 + j] * inv * siluf(bf2f((bf16)gv[j])));
      *(bf16x4*)gp = o;
    }
}

DI void dir_barrier(volatile unsigned* cnt, unsigned& target, int lane) {
  asm volatile("s_waitcnt lgkmcnt(0)" ::: "memory");
  target += 4u;
  if (lane == 0) __hip_atomic_fetch_add((unsigned*)cnt, 1u, __ATOMIC_RELAXED, __HIP_MEMORY_SCOPE_WORKGROUP);
  unsigned spins = 0;
  while (*cnt < target && ++spins < (1u << 22)) __builtin_amdgcn_s_sleep(1);
  asm volatile("" ::: "memory");
}

DI void ret_item(const Params& p, int layer, bool lat, int NC, int tlbase, int bglob, int hd, char* smem) {
  const int tid = otid(), lane = tid & 63, wave = tid >> 6;
  const int dir = wave >> 2, w4 = wave & 3, r = lane & 31, hh = lane >> 5, dt = tid & 255;
  bf16* Ks = (bf16*)smem + dir * 31232;
  bf16* KdT = Ks + 128 * 72;
  bf16* VT = KdT + 64 * 136;
  bf16* ST = VT + 64 * 136;
  const bf16* rq = (const bf16*)(p.ws + OFF_RQ);
  const bf16* rk = (const bf16*)(p.ws + OFF_RK);
  const bf16* rv = (const bf16*)(p.ws + OFF_RV);
  bf16* rg = (bf16*)(p.ws + OFF_RG);
  bf16* ofb = (bf16*)(p.ws + OFF_OFB);
  const float theta = p.ret_theta[(layer * 2 + dir) * 8 + hd];
  const float lg2 = -log1pf(expf(-theta)) * LOG2E;
  const float cdec = exp2f(lg2 * 128.f);
  const int etile = w4 >> 1, dtile = w4 & 1;
  f32x16 Sacc;
  if (lat) {
    const float* s0 = p.state_ret + ((((size_t)bglob * 4 + layer) * 2 + dir) * 8 + hd) * 4096;
#pragma unroll
    for (int i = 0; i < 16; ++i) Sacc[i] = s0[(dtile * 32 + r) * 64 + etile * 32 + crow(i, hh)];
  } else {
    Sacc = zero16();
  }
  volatile unsigned* sy = (volatile unsigned*)(smem + 124928);
  if (tid < 16) sy[tid] = 0u;
  unsigned btarget = 0u;
  __syncthreads();
#pragma unroll
  for (int i = 0; i < 16; ++i) ST[(etile * 32 + crow(i, hh)) * 72 + dtile * 32 + r] = f2bf(Sacc[i]);
  bf16x8 kv[4], vv[4], nq[4];
  {
    const int ftl0 = tlbase + (dir ? NC - 1 : 0) * 128;
#pragma unroll
    for (int i = 0; i < 4; ++i) {
      const int kc = ((dt >> 7) + 2 * i) * 8;
      const size_t o = (size_t)(ftl0 + (dt & 127)) * 512 + hd * 64 + kc;
      kv[i] = *(const bf16x8*)(rk + o);
      vv[i] = *(const bf16x8*)(rv + o);
    }
#pragma unroll
    for (int ks = 0; ks < 4; ++ks) nq[ks] = *(const bf16x8*)(rq + (size_t)(ftl0 + w4 * 32 + r) * 512 + hd * 64 + ks * 16 + hh * 8);
  }
#pragma unroll 1
  for (int step = 0; step < NC; ++step) {
    const int tid_s = otid();
    const int lane = tid_s & 63, r = lane & 31, hh = lane >> 5, dt = tid_s & 255;
    const int ch = dir ? NC - 1 - step : step;
    const int tl0 = tlbase + ch * 128;
    const int iq = w4 * 32 + r, tlq = tl0 + iq;
    const bool second = step >= NC / 2;
    bf16x8 bq[4];
    const int jrow = dt & 127;
#pragma unroll
    for (int ks = 0; ks < 4; ++ks) bq[ks] = nq[ks];
    {
      const float kd = exp2f(lg2 * (float)(dir ? jrow : 127 - jrow)) * 0.125f;
#pragma unroll
      for (int i = 0; i < 4; ++i) {
        const int kc = ((dt >> 7) + 2 * i) * 8;
        *(bf16x8*)(Ks + jrow * 72 + kc) = kv[i];
#pragma unroll
        for (int jj = 0; jj < 8; ++jj) {
          KdT[(kc + jj) * 136 + jrow] = f2bf(bf2f((bf16)kv[i][jj]) * kd);
          VT[(kc + jj) * 136 + jrow] = (bf16)vv[i][jj];
        }
      }
    }
    {
      const int nstep = step + 1 < NC ? step + 1 : step;
      const int ntl0 = tlbase + (dir ? NC - 1 - nstep : nstep) * 128;
#pragma unroll
      for (int i = 0; i < 4; ++i) {
        const int kc = ((dt >> 7) + 2 * i) * 8;
        const size_t o = (size_t)(ntl0 + jrow) * 512 + hd * 64 + kc;
        kv[i] = *(const bf16x8*)(rk + o);
        vv[i] = *(const bf16x8*)(rv + o);
      }
#pragma unroll
      for (int ks = 0; ks < 4; ++ks) nq[ks] = *(const bf16x8*)(rq + (size_t)(ntl0 + w4 * 32 + r) * 512 + hd * 64 + ks * 16 + hh * 8);
    }
    dir_barrier(sy + dir, btarget, lane);
    f32x16 O[2];
    {
      const float qd = exp2f(lg2 * (float)(dir ? 128 - iq : iq + 1));
#pragma unroll
      for (int mi = 0; mi < 2; ++mi) {
        f32x16 oc = zero16();
#pragma unroll
        for (int ks = 0; ks < 4; ++ks) {
          const bf16x8 a = *(const bf16x8*)(ST + (mi * 32 + r) * 72 + ks * 16 + hh * 8);
          oc = MFMA(a, bq[ks], oc);
        }
#pragma unroll
        for (int i = 0; i < 16; ++i) O[mi][i] = oc[i] * qd;
      }
    }
#pragma unroll 1
    for (int jt = 0; jt < 4; ++jt) {
      if (dir == 0 ? (jt <= w4) : (jt >= w4)) {
        f32x16 s = zero16();
#pragma unroll
        for (int ks = 0; ks < 4; ++ks) {
          const bf16x8 a = *(const bf16x8*)(Ks + (jt * 32 + r) * 72 + ks * 16 + hh * 8);
          s = MFMA(a, bq[ks], s);
        }
#pragma unroll
        for (int i = 0; i < 16; ++i) {
          const int j = jt * 32 + crow(i, hh);
          const int diff = dir ? j - iq : iq - j;
          s[i] = diff >= 0 ? s[i] * 0.125f * __builtin_amdgcn_exp2f(lg2 * (float)diff) : 0.f;
        }
#pragma unroll
        for (int st = 0; st < 2; ++st) {
          const bf16x8 pf = pack8(s, st);
#pragma unroll
          for (int mi = 0; mi < 2; ++mi) {
            const bf16* vp = VT + (mi * 32 + r) * 136 + jt * 32 + 16 * st + 4 * hh;
            const bf16x4 lo = *(const bf16x4*)vp, hi = *(const bf16x4*)(vp + 8);
            const bf16x8 va = __builtin_shufflevector(lo, hi, 0, 1, 2, 3, 4, 5, 6, 7);
            O[mi] = MFMA(va, pf, O[mi]);
          }
        }
      }
    }
#pragma unroll
    for (int i = 0; i < 16; ++i) Sacc[i] *= cdec;
#pragma unroll 2
    for (int jk = 0; jk < 8; ++jk) {
      const bf16x8 a = *(const bf16x8*)(VT + (etile * 32 + r) * 136 + jk * 16 + hh * 8);
      const bf16x8 bb = *(const bf16x8*)(KdT + (dtile * 32 + r) * 136 + jk * 16 + hh * 8);
      Sacc = MFMA(a, bb, Sacc);
    }
    if (!second) {
#pragma unroll
      for (int mi = 0; mi < 2; ++mi)
#pragma unroll
        for (int g4 = 0; g4 < 4; ++g4) {
          bf16x4 o;
#pragma unroll
          for (int j = 0; j < 4; ++j) o[j] = (short)f2bf(O[mi][4 * g4 + j]);
          *(bf16x4*)(ofb + (size_t)tlq * 512 + hd * 64 + mi * 32 + 8 * g4 + 4 * hh) = o;
        }
    } else {
      {
        volatile unsigned* pr = sy + 2 + (1 - dir) * 4 + w4;
        unsigned spins = 0;
        while (*pr < (unsigned)(NC - step) && ++spins < (1u << 22)) __builtin_amdgcn_s_sleep(1);
        asm volatile("" ::: "memory");
      }
      float ss = 0.f;
#pragma unroll
      for (int mi = 0; mi < 2; ++mi)
#pragma unroll
        for (int g4 = 0; g4 < 4; ++g4) {
          const bf16x4 pv = *(const bf16x4*)(ofb + (size_t)tlq * 512 + hd * 64 + mi * 32 + 8 * g4 + 4 * hh);
#pragma unroll
          for (int j = 0; j < 4; ++j) {
            const float v = O[mi][4 * g4 + j] + bf2f((bf16)pv[j]);
            O[mi][4 * g4 + j] = v;
            ss += v * v;
          }
        }
      ss += __shfl_xor(ss, 32);
      const float rn = rsqrtf(ss * (1.f / 64.f) + 1e-6f);
#pragma unroll
      for (int mi = 0; mi < 2; ++mi)
#pragma unroll
        for (int g4 = 0; g4 < 4; ++g4) {
          const int e0 = hd * 64 + mi * 32 + 8 * g4 + 4 * hh;
          bf16* gp = rg + (size_t)tlq * 512 + e0;
          const bf16x4 gv = *(const bf16x4*)gp;
          const float4 gn = *(const float4*)(p.ret_gn + layer * 512 + e0);
          bf16x4 o;
          o[0] = (short)f2bf(O[mi][4 * g4 + 0] * rn * gn.x * siluf(bf2f((bf16)gv[0])));
          o[1] = (short)f2bf(O[mi][4 * g4 + 1] * rn * gn.y * siluf(bf2f((bf16)gv[1])));
          o[2] = (short)f2bf(O[mi][4 * g4 + 2] * rn * gn.z * siluf(bf2f((bf16)gv[2])));
          o[3] = (short)f2bf(O[mi][4 * g4 + 3] * rn * gn.w * siluf(bf2f((bf16)gv[3])));
          *(bf16x4*)gp = o;
        }
    }
    if (!second) {
      asm volatile("s_waitcnt vmcnt(0)" ::: "memory");
      if (lane == 0) sy[2 + dir * 4 + w4] = (unsigned)(step + 1);
    }
    dir_barrier(sy + dir, btarget, lane);
#pragma unroll
    for (int i = 0; i < 16; ++i) ST[(etile * 32 + crow(i, hh)) * 72 + dtile * 32 + r] = f2bf(Sacc[i]);
  }
  if (!lat) {
    float* so = p.out + OUT_ST + ((((size_t)bglob * 4 + layer) * 2 + dir) * 8 + hd) * 4096;
#pragma unroll
    for (int i = 0; i < 16; ++i) so[(dtile * 32 + r) * 64 + etile * 32 + crow(i, hh)] = Sacc[i];
  }
}

DI void p2(const Params& p, int layer, int grp, char* smem, int* s_item) {
  int* ctr = (int*)(p.ws + OFF_CTR) + layer * 2 + grp;
  const int n_rl = 32, n_hl = 512, n_al = 512;
  const int n_hc = grp ? 0 : 512, n_rc = grp ? 0 : 256, n_ac = grp ? 0 : 256;
  const int total = n_rl + n_hl + n_al + n_hc + n_rc + n_ac;
  const int latbase = grp ? 0 : T_CTX;
  const int latb0 = grp ? 4 : 0;
  for (;;) {
    __syncthreads();
    if (threadIdx.x == 0) *s_item = atomicAdd(ctr, 1);
    __syncthreads();
    int it = *s_item;
    if (it >= total) break;
    if (it < n_rl) {
      const int b = it >> 3, hd = it & 7;
      ret_item(p, layer, true, 32, latbase + b * 4096, latb0 + b, hd, smem);
      continue;
    }
    it -= n_rl;
    if (it < n_hl) { hyena_item<4, 4096>(p, layer, 0, latbase, it, smem); continue; }
    it -= n_hl;
    if (it < n_al) {
      const int b = it >> 7, kvh = (it >> 6) & 1, qb = it & 63;
      attn_item(p, layer, true, latbase + b * 4096, latb0 + b, kvh, qb, smem);
      continue;
    }
    it -= n_al;
    if (it < n_hc) { hyena_item<32, 256>(p, layer, 1, 0, it, smem); continue; }
    it -= n_hc;
    if (it < n_rc) {
      const int b = it >> 3, hd = it & 7;
      ret_item(p, layer, false, 2, b * 256, b, hd, smem);
      continue;
    }
    it -= n_rc;
    {
      const int b = it >> 3, kvh = (it >> 2) & 1, qb = it & 3;
      attn_item(p, layer, false, b * 256, b, kvh, qb, smem);
    }
  }
}

DI unsigned pk2(float a, float b) { return (unsigned)f2bf(a) | ((unsigned)f2bf(b) << 16); }
DI float pklo(unsigned u) { return __uint_as_float(u << 16); }
DI float pkhi(unsigned u) { return __uint_as_float(u & 0xffff0000u); }
DI void p3a(const Params& p, int layer, int grp, char* smem) {
  const int tgn = grp ? 16384 : TG;
  const int mtiles = tgn / 256, ntot = mtiles * 8;
  const int tid = otid(), lane = tid & 63, wave = tid >> 6;
  const int wm = wave >> 1, wn = wave & 1, r = lane & 31, h = lane >> 5;
  const bf16* H = (const bf16*)(p.ws + OFF_H);
  const bf16* wl = (const bf16*)(p.ws + OFF_W) + (size_t)layer * W_LAYER;
  bf16* MG = (bf16*)(p.ws + OFF_MERGED);
  u32x4 ra[2][4], rb[2][2];
  const bf16* YaT = (const bf16*)(p.ws + OFF_YA);
  for (int id = blockIdx.x; id < ntot; id += gridDim.x) {
    const int m0 = ((id >> 7) * 16 + (id & 15)) * 256, n0 = ((id & 127) >> 4) * 128;
    unsigned mgp[2][2][8];
#pragma unroll
    for (int a = 0; a < 2; ++a)
#pragma unroll
      for (int b = 0; b < 2; ++b)
#pragma unroll
        for (int i = 0; i < 8; ++i) mgp[a][b][i] = 0u;
#pragma unroll 1
    for (int br = 0; br < 3; ++br) {
      const GemmSrc gate = mksrc(H + (size_t)m0 * 1024, 1024, wl + W_MG + (size_t)(br * 1024 + n0) * 1024, 1024, 0);
      const bf16* WB = wl + (br == 0 ? W_A : br == 1 ? W_B : W_C);
      const GemmSrc bsrc = br == 0 ? mksrc(YaT + m0, TG, WB + (size_t)n0 * 512, 512, 1)
                                   : mksrc((const bf16*)(p.ws + (br == 1 ? OFF_AG : OFF_RG)) + (size_t)m0 * 512, 512, WB + (size_t)n0 * 512, 512, 0);
      unsigned sg[2][2][8];
      {
        f32x16 ag[2][2];
#pragma unroll
        for (int a = 0; a < 2; ++a)
#pragma unroll
          for (int b = 0; b < 2; ++b) ag[a][b] = zero16();
        gemm_main<2, false>(gate, 1024, ag, smem, ra, rb, false, bsrc, false);
#pragma unroll
        for (int ni = 0; ni < 2; ++ni) {
          const float bias = p.b_merge[layer * 3072 + br * 1024 + n0 + wn * 64 + ni * 32 + r];
#pragma unroll
          for (int mi = 0; mi < 2; ++mi) {
#pragma unroll
            for (int i = 0; i < 8; ++i)
              sg[mi][ni][i] = pk2(sigmf(ag[mi][ni][2 * i] + bias), sigmf(ag[mi][ni][2 * i + 1] + bias));
            __builtin_amdgcn_sched_barrier(0);
          }
        }
      }
      f32x16 ay[2][2];
#pragma unroll
      for (int a = 0; a < 2; ++a)
#pragma unroll
        for (int b = 0; b < 2; ++b) ay[a][b] = zero16();
      if (br == 0) gemm_main<2, true>(bsrc, 512, ay, smem, ra, rb, false, bsrc, false);
      else gemm_main<2, false>(bsrc, 512, ay, smem, ra, rb, false, bsrc, false);
#pragma unroll
      for (int mi = 0; mi < 2; ++mi)
#pragma unroll
        for (int ni = 0; ni < 2; ++ni) {
#pragma unroll
          for (int i = 0; i < 8; ++i) {
            const float lo = pklo(mgp[mi][ni][i]) + pklo(sg[mi][ni][i]) * ay[mi][ni][2 * i];
            const float hi = pkhi(mgp[mi][ni][i]) + pkhi(sg[mi][ni][i]) * ay[mi][ni][2 * i + 1];
            mgp[mi][ni][i] = pk2(lo, hi);
          }
          __builtin_amdgcn_sched_barrier(0);
        }
    }
    {
      const int t2 = otid(), l2 = t2 & 63, w2 = t2 >> 6;
      const int wm2 = w2 >> 1, wn2 = w2 & 1, r2 = l2 & 31, h2 = l2 >> 5;
#pragma unroll
      for (int mi = 0; mi < 2; ++mi)
#pragma unroll
        for (int ni = 0; ni < 2; ++ni)
#pragma unroll
          for (int i = 0; i < 8; ++i) {
            bf16* d = MG + (size_t)(m0 + wm2 * 64 + mi * 32) * 1024 + n0 + wn2 * 64 + ni * 32 + r2;
            d[(size_t)crow(2 * i, h2) * 1024] = (bf16)(mgp[mi][ni][i] & 0xffffu);
            d[(size_t)crow(2 * i + 1, h2) * 1024] = (bf16)(mgp[mi][ni][i] >> 16);
          }
    }
  }
}

DI void p3b(const Params& p, int layer, int grp, char* smem) {
  const int g0 = grp ? TG : 0, tgn = grp ? 16384 : TG;
  const int mtiles = tgn / 256, ntot = mtiles * 8;
  const int tid = otid(), lane = tid & 63, wave = tid >> 6;
  const int wm = wave >> 1, wn = wave & 1, r = lane & 31, h = lane >> 5;
  const bf16* MG = (const bf16*)(p.ws + OFF_MERGED);
  const bf16* WoT = (const bf16*)(p.ws + OFF_W) + (size_t)layer * W_LAYER + W_O;
  const float* mods = (const float*)(p.ws + OFF_MODS);
  u32x4 ra[2][4], rb[2][2];
  bool pre = false;
  for (int id = blockIdx.x; id < ntot; id += gridDim.x) {
    const int band = id >> 7, rem = id & 127;
    const int mt = band * 16 + (rem & 15), nt = rem >> 4;
    const int m0 = mt * 256, n0 = nt * 128;
    const int idn = id + gridDim.x;
    const bool hn = idn < ntot;
    const int m0n = ((idn >> 7) * 16 + (idn & 15)) * 256, n0n = ((idn & 127) >> 4) * 128;
    f32x16 acc[2][2];
#pragma unroll
    for (int a = 0; a < 2; ++a)
#pragma unroll
      for (int b = 0; b < 2; ++b) acc[a][b] = zero16();
    gemm_main<2, false>(mksrc(MG + (size_t)m0 * 1024, 1024, WoT + (size_t)n0 * 1024, 1024, 0), 1024, acc, smem, ra, rb, pre,
                        mksrc(MG + (size_t)m0n * 1024, 1024, WoT + (size_t)n0n * 1024, 1024, 0), hn);
    pre = true;
    const int tg0 = g0 + m0;
    const float* gate = mods + (layer * 9 + cond_of(tg0)) * 3072 + 2048;
    const float *qxp = launder(p.x_prompt), *qxs = launder(p.x_sample), *qo = launder(p.out);
    const float* xsb = layer == 0 ? (tg0 < T_CTX ? qxp + (size_t)tg0 * DM : qxs + (size_t)(tg0 - T_CTX) * DM) : qo + (size_t)tg0 * DM;
    float* xdb = p.out + (size_t)tg0 * DM;
#pragma unroll
    for (int ni = 0; ni < 2; ++ni) {
      const int col = n0 + wn * 64 + ni * 32 + r;
      const float gt = gate[col];
#pragma unroll
      for (int mi = 0; mi < 2; ++mi)
#pragma unroll
        for (int i = 0; i < 16; ++i) {
          const int ro = (wm * 64 + mi * 32 + crow(i, h)) * DM + col;
          xdb[ro] = xsb[ro] + gt * acc[mi][ni][i];
        }
    }
  }
}

DI void final_norm(const Params& p) {
  const int tid_ = otid();
  const int lane = tid_ & 63, wave = tid_ >> 6;
  for (int it = blockIdx.x; it < T_ALL / 8; it += gridDim.x) {
    const int tg = it * 8 + wave;
    float* x = p.out + (size_t)tg * DM;
    float4 v[4];
    float ss = 0.f;
#pragma unroll
    for (int i = 0; i < 4; ++i) {
      v[i] = *(const float4*)(x + (lane + 64 * i) * 4);
      ss += v[i].x * v[i].x + v[i].y * v[i].y + v[i].z * v[i].z + v[i].w * v[i].w;
    }
#pragma unroll
    for (int o = 32; o > 0; o >>= 1) ss += __shfl_xor(ss, o);
    const float rstd = rsqrtf(ss * (1.f / 1024.f) + 1e-6f);
#pragma unroll
    for (int i = 0; i < 4; ++i) {
      const int col = (lane + 64 * i) * 4;
      const float4 w = *(const float4*)(p.final_w + col);
      *(float4*)(x + col) = make_float4(v[i].x * rstd * w.x, v[i].y * rstd * w.y, v[i].z * rstd * w.z, v[i].w * rstd * w.w);
    }
  }
}


#define XB_TMO 128
#define XB_XCNT(j) (256 + 64 * (j))
#define XB_XSUB(j) (1280 + 64 * (j))
#define XB_XGEN(j) (2304 + 64 * (j))
#define XB_TOP 3328
#define XB_TOPGEN 3392
#define XB_SPIN_CAP (1u << 22)
DI unsigned xb_ld(unsigned* p) { return __hip_atomic_load(p, __ATOMIC_RELAXED, __HIP_MEMORY_SCOPE_AGENT); }
DI unsigned xb_add(unsigned* p, unsigned v) { return __hip_atomic_fetch_add(p, v, __ATOMIC_RELAXED, __HIP_MEMORY_SCOPE_AGENT); }
DI unsigned xb_xcc_id() { return (unsigned)__builtin_amdgcn_s_getreg((3 << 11) | 20) & 0xFu; }
#define XB_SPIN(cond, bar)                                          \
  do {                                                              \
    unsigned _sp = 0;                                               \
    while (cond) {                                                  \
      __builtin_amdgcn_s_sleep(1);                                  \
      if ((++_sp & 255u) == 0u) {                                   \
        if (xb_ld(&(bar)[XB_TMO])) break;                           \
        if (_sp > XB_SPIN_CAP) {                                    \
          atomicAdd(&(bar)[XB_TMO], 1u);                            \
          break;                                                    \
        }                                                           \
      }                                                             \
    }                                                               \
  } while (0)
struct XcdBarrier {
  unsigned* bar;
  unsigned x;
  volatile unsigned* st;
};
DI void xcd_barrier_complete(unsigned* bar, unsigned x, unsigned& nloc, unsigned& nx) {
  const unsigned G = gridDim.x;
  unsigned sum, cnt, mine, sp = 0u;
  for (;;) {
    sum = 0u; cnt = 0u; mine = 0u;
#pragma unroll
    for (unsigned j = 0; j < 16; ++j) {
      const unsigned c = xb_ld(&bar[XB_XCNT(j)]);
      sum += c;
      cnt += (c > 0u) ? 1u : 0u;
      mine = (j == x) ? c : mine;
    }
    if (sum == G) break;
    __builtin_amdgcn_s_sleep(1);
    if ((++sp & 255u) == 0u) {
      if (xb_ld(&bar[XB_TMO])) break;
      if (sp > XB_SPIN_CAP) { atomicAdd(&bar[XB_TMO], 1u); break; }
    }
  }
  nloc = mine > 0u ? mine : 1u;
  nx = cnt > 0u ? cnt : 1u;
}
DI void xcd_barrier(char* ws, volatile unsigned* st) {
  asm volatile("" : "+s"(ws));
  XcdBarrier b;
  b.bar = (unsigned*)(ws + OFF_BAR);
  b.x = xb_xcc_id();
  b.st = st;
  asm volatile("s_waitcnt vmcnt(0)" ::: "memory");
  __syncthreads();
  if (threadIdx.x == 0) {
    unsigned* bar = b.bar;
    __builtin_amdgcn_s_waitcnt(0);
    unsigned nloc = b.st[0], nx = b.st[1];
    if (nloc == 0u) {
      xcd_barrier_complete(bar, b.x, nloc, nx);
      b.st[0] = nloc;
      b.st[1] = nx;
    }
    const unsigned old = xb_add(&bar[XB_XSUB(b.x)], 1u);
    const unsigned gen = old / nloc;
    if (old + 1u == (gen + 1u) * nloc) {
      __builtin_amdgcn_fence(__ATOMIC_RELEASE, "agent");
      asm volatile("s_waitcnt vmcnt(0)" ::: "memory");
      const unsigned og = xb_add(&bar[XB_TOP], 1u);
      const unsigned tg = og / nx;
      if (og + 1u == (tg + 1u) * nx) xb_add(&bar[XB_TOPGEN], 1u);
      else XB_SPIN(xb_ld(&bar[XB_TOPGEN]) == tg, bar);
      __builtin_amdgcn_fence(__ATOMIC_ACQUIRE, "agent");
      xb_add(&bar[XB_XGEN(b.x)], 1u);
      asm volatile("s_waitcnt vmcnt(0)" ::: "memory");
    } else {
      XB_SPIN(xb_ld(&bar[XB_XGEN(b.x)]) == gen, bar);
      __builtin_amdgcn_fence(__ATOMIC_ACQUIRE, "agent");
      asm volatile("s_waitcnt vmcnt(0)" ::: "memory");
    }
  }
  __syncthreads();
}

__global__ void __launch_bounds__(512) mega(Params p) {
  __shared__ __attribute__((aligned(16))) char smem[SMEM_BYTES];
  __shared__ __attribute__((aligned(16))) unsigned xb_words[4];
  __shared__ int s_item;
  cg::grid_group grid = cg::this_grid();
  if (threadIdx.x == 0) { xb_words[0] = 0u; xb_words[1] = 0u; xb_words[2] = 0u; xb_words[3] = 0u; }
  __syncthreads();
  if (threadIdx.x == 0) (void)xb_add(&((unsigned*)(p.ws + OFF_BAR))[XB_XCNT(xb_xcc_id())], 1u);
  phase0(p, smem);
  grid.sync();
#pragma unroll 1
  for (int layer = 0; layer < DEPTH; ++layer) {
#pragma unroll 1
    for (int grp = 0; grp < 2; ++grp) {
      int ly = layer, gp = grp;
      asm volatile("" : "+s"(ly), "+s"(gp));
      p1a(p, ly, gp, smem);
      xcd_barrier(p.ws, xb_words);
      asm volatile("" : "+s"(ly), "+s"(gp));
      p1b(p, ly, gp, smem);
      xcd_barrier(p.ws, xb_words);
      asm volatile("" : "+s"(ly), "+s"(gp));
      p2(p, ly, gp, smem, &s_item);
      xcd_barrier(p.ws, xb_words);
      asm volatile("" : "+s"(ly), "+s"(gp));
      p3a(p, ly, gp, smem);
      xcd_barrier(p.ws, xb_words);
      asm volatile("" : "+s"(ly), "+s"(gp));
      p3b(p, ly, gp, smem);
      xcd_barrier(p.ws, xb_words);
    }
  }
  final_norm(p);
}

extern "C" void kernel_launch(void* const* d_in, const int* in_sizes, int n_in, void* d_out, int out_size, void* d_ws,
                              size_t ws_size, hipStream_t stream) {
  static int grid_blocks = 0;
  if (!grid_blocks) {
    int dev = 0, cus = 0, per_cu = 0;
    hipGetDevice(&dev);
    hipDeviceGetAttribute(&cus, hipDeviceAttributeMultiprocessorCount, dev);
    hipOccupancyMaxActiveBlocksPerMultiprocessor(&per_cu, mega, 512, 0);
    if (per_cu < 1) per_cu = 1;
    if (per_cu > 1) per_cu = 1;
    grid_blocks = cus * per_cu;
  }
  Params p{};
  const float** pp = (const float**)&p;
  for (int i = 0; i < 27; ++i) pp[i] = (const float*)d_in[i];
  p.out = (float*)d_out;
  p.ws = (char*)d_ws;
  if (ws_size < WS_NEEDED) fprintf(stderr, "workspace too small: %zu < %zu\n", ws_size, (size_t)WS_NEEDED);
  hipMemsetAsync(d_ws, 0, ZERO_BYTES, stream);
  void* args[] = {&p};
  hipError_t e = hipLaunchCooperativeKernel((void*)mega, dim3(grid_blocks), dim3(512), args, 0, stream);
  if (e != hipSuccess) fprintf(stderr, "cooperative launch failed: %s (grid %d)\n", hipGetErrorString(e), grid_blocks);
}
```

```cpp
#include <hip/hip_runtime.h>
#include <hip/hip_cooperative_groups.h>
#include <cstdio>
namespace cg = cooperative_groups;

#define DI __device__ __forceinline__
typedef unsigned short bf16;
typedef __attribute__((ext_vector_type(8))) short bf16x8;
typedef __attribute__((ext_vector_type(4))) short bf16x4;
typedef __attribute__((ext_vector_type(16))) float f32x16;
typedef __attribute__((ext_vector_type(4))) unsigned u32x4;
typedef __attribute__((ext_vector_type(4))) float f32x4v;
#define MFMA(a, b, c) __builtin_amdgcn_mfma_f32_32x32x16_bf16((a), (b), (c), 0, 0, 0)

constexpr int DM = 1024;
constexpr int DEPTH = 4;
constexpr int T_CTX = 8192;
constexpr int T_ALL = 40960;
constexpr int TG = 24576;
constexpr int IN_DIM = 5376;
constexpr float LOG2E = 1.4426950408889634f;

constexpr size_t OFF_MODS = 0;
constexpr size_t OFF_FSUM = 458752;
constexpr size_t OFF_CTR = 491520;
constexpr size_t OFF_BAR = 495616;
constexpr size_t ZERO_BYTES = 524288;
constexpr size_t OFF_ROPE = ZERO_BYTES;
constexpr size_t OFF_W = OFF_ROPE + 1048576;
constexpr size_t W_IN = 0, W_MG = 5505024, W_A = 8650752, W_B = 9175040, W_C = 9699328, W_O = 10223616, W_LAYER = 11272192;
constexpr size_t OFF_GL = OFF_W + W_LAYER * 2 * 4;
constexpr size_t OFF_GC = OFF_GL + 33554432;
constexpr size_t OFF_H = OFF_GC + 2097152;
constexpr size_t OFF_HYT = OFF_H + (size_t)TG * 2048;
constexpr size_t OFF_AQ = OFF_HYT + (size_t)TG * 4096;
constexpr size_t OFF_AK = OFF_AQ + (size_t)TG * 1024;
constexpr size_t OFF_AV = OFF_AK + (size_t)TG * 256;
constexpr size_t OFF_AG = OFF_AV + (size_t)TG * 256;
constexpr size_t OFF_RQ = OFF_AG + (size_t)TG * 1024;
constexpr size_t OFF_RK = OFF_RQ + (size_t)TG * 1024;
constexpr size_t OFF_RV = OFF_RK + (size_t)TG * 1024;
constexpr size_t OFF_RG = OFF_RV + (size_t)TG * 1024;
constexpr size_t OFF_YA = OFF_RG + (size_t)TG * 1024;
constexpr size_t OFF_OFB = OFF_YA + (size_t)TG * 1024;
constexpr size_t WS_NEEDED = OFF_OFB + (size_t)TG * 1024;
constexpr size_t OFF_MERGED = OFF_RQ;

constexpr size_t OUT_CK = 41943040, OUT_CV = 46137344, OUT_ST = 50331648;

constexpr int SMEM_BYTES = 135168;

struct Params {
  const float *x_prompt, *x_sample, *c, *cache_k, *cache_v, *state_ret, *c_ctx, *norm_w, *w_mod, *b_mod, *w_in, *hy_conv,
      *hy_w1, *hy_b1, *hy_freq, *hy_w2, *hy_skip, *attn_sink, *ret_theta, *ret_gn, *w_a, *w_b, *w_c, *w_merge, *b_merge,
      *w_out, *final_w;
  float* out;
  char* ws;
};

DI bf16 f2bf(float x) {
  __bf16 b = (__bf16)x;
  return __builtin_bit_cast(unsigned short, b);
}
DI float bf2f(bf16 u) { return __uint_as_float(((unsigned)u) << 16); }
DI int crow(int reg, int h) { return (reg & 3) + 8 * (reg >> 2) + 4 * h; }
DI float siluf(float x) { return x / (1.f + __expf(-x)); }
DI float sigmf(float x) { return 1.f / (1.f + __expf(-x)); }
DI bf16x8 pack8(const f32x16& x, int s) {
  bf16x8 r;
#pragma unroll
  for (int j = 0; j < 8; ++j) r[j] = (short)f2bf(x[8 * s + j]);
  return r;
}
DI f32x16 zero16() {
  f32x16 z;
#pragma unroll
  for (int i = 0; i < 16; ++i) z[i] = 0.f;
  return z;
}
DI const float* launder(const float* q) {
  asm volatile("" : "+s"(q));
  return q;
}
DI int otid() {
  int t = threadIdx.x;
  asm volatile("" : "+v"(t));
  return t;
}
DI int cond_of(int tg) { return tg < T_CTX ? 0 : 1 + ((tg - T_CTX) >> 12); }

DI void lds_barrier() { asm volatile("s_waitcnt lgkmcnt(0)\n\ts_barrier" ::: "memory"); }

struct GemmSrc {
  const bf16* A;
  const bf16* B;
  int lda, ldb, atr;
};
DI GemmSrc mksrc(const bf16* A, int lda, const bf16* B, int ldb, int atr) {
  GemmSrc g;
  g.A = A; g.B = B; g.lda = lda; g.ldb = ldb; g.atr = atr;
  return g;
}
template <int NI>
DI void gemm_issue(const GemmSrc& g, int kt, int tid, u32x4 (&ra)[4], u32x4 (&rb)[NI]) {
  const int lrow = tid >> 3, lkc = (tid & 7) * 8;
  const bf16* ab = g.atr ? g.A + (size_t)((tid & 63) + kt * 64) * g.lda + (tid >> 6) * 8
                         : g.A + (size_t)lrow * g.lda + lkc + kt * 64;
  const size_t astep = g.atr ? (size_t)64 : (size_t)64 * g.lda;
#pragma unroll
  for (int i = 0; i < 4; ++i) ra[i] = *(const u32x4*)(ab + astep * i);
  const bf16* bb = g.B + (size_t)lrow * g.ldb + lkc + kt * 64;
#pragma unroll
  for (int i = 0; i < NI; ++i) rb[i] = *(const u32x4*)(bb + (size_t)(64 * i) * g.ldb);
}
template <int NI, bool ATR>
DI void gemm_stage(bf16* As, bf16* Bs, int tid, const u32x4 (&ra)[4], const u32x4 (&rb)[NI]) {
  constexpr int PITCH = 72;
  const int lrow = tid >> 3, lkc = (tid & 7) * 8;
#pragma unroll
  for (int i = 0; i < 4; ++i) {
    if (ATR) {
      bf16* d = As + (((tid >> 6) + 8 * i) * 8) * PITCH + (tid & 63);
      const bf16x8 v = __builtin_bit_cast(bf16x8, ra[i]);
#pragma unroll
      for (int e = 0; e < 8; ++e) d[e * PITCH] = (bf16)v[e];
    } else {
      *(u32x4*)(As + (lrow + 64 * i) * PITCH + lkc) = ra[i];
    }
  }
#pragma unroll
  for (int i = 0; i < NI; ++i) *(u32x4*)(Bs + (lrow + 64 * i) * PITCH + lkc) = rb[i];
}

template <int NI, bool ATR>
DI void gemm_stage_part(bf16* As, bf16* Bs, int tid, const u32x4 (&ra)[4], const u32x4 (&rb)[NI], int part) {
  constexpr int PITCH = 72;
  const int lrow = tid >> 3, lkc = (tid & 7) * 8;
#pragma unroll
  for (int i = 0; i < 4; ++i) {
    if (i != part) continue;
    if (ATR) {
      bf16* d = As + (((tid >> 6) + 8 * i) * 8) * PITCH + (tid & 63);
      const bf16x8 v = __builtin_bit_cast(bf16x8, ra[i]);
#pragma unroll
      for (int e = 0; e < 8; ++e) d[e * PITCH] = (bf16)v[e];
    } else {
      *(u32x4*)(As + (lrow + 64 * i) * PITCH + lkc) = ra[i];
    }
  }
#pragma unroll
  for (int i = 0; i < NI; ++i)
    if (2 * i == part) *(u32x4*)(Bs + (lrow + 64 * i) * PITCH + lkc) = rb[i];
}

template <int NI, bool ATR>
DI void gemm_main(const GemmSrc& cur, int K, f32x16 (&acc)[2][NI], char* smem, u32x4 (&ra)[2][4], u32x4 (&rb)[2][NI],
                  bool preloaded, const GemmSrc& nxt, bool has_next) {
  constexpr int BN = 64 * NI;
  constexpr int PITCH = 72;
  bf16* As = (bf16*)smem;
  bf16* Bs = As + 2 * 256 * PITCH;
  const int tid = otid(), lane = tid & 63, wave = tid >> 6;
  const int wm = wave >> 1, wn = wave & 1, r = lane & 31, h = lane >> 5;
  const int nk = K / 64;
  if (!preloaded) {
    gemm_issue<NI>(cur, 0, tid, ra[0], rb[0]);
    gemm_issue<NI>(cur, 1, tid, ra[1], rb[1]);
  }
  lds_barrier();
  gemm_stage<NI, ATR>(As, Bs, tid, ra[0], rb[0]);
  lds_barrier();
#pragma unroll 1
  for (int kt = 0; kt < nk; kt += 2) {
#pragma unroll
    for (int u = 0; u < 2; ++u) {
      const int k = kt + u;
      {
        const bool inr = k + 2 < nk;
        GemmSrc g = (inr || !has_next) ? cur : nxt;
        const int kk = inr ? k + 2 : (has_next ? k + 2 - nk : nk - 1);
        gemm_issue<NI>(g, kk, tid, ra[u], rb[u]);
      }
      const bf16* Ab = As + u * 256 * PITCH + (wm * 64 + r) * PITCH + h * 8;
      const bf16* Bb = Bs + u * BN * PITCH + (wn * 32 * NI + r) * PITCH + h * 8;
#pragma unroll
      for (int ks = 0; ks < 4; ++ks) {
        bf16x8 a[2], b[NI];
#pragma unroll
        for (int mi = 0; mi < 2; ++mi) a[mi] = *(const bf16x8*)(Ab + mi * 32 * PITCH + ks * 16);
#pragma unroll
        for (int ni = 0; ni < NI; ++ni) b[ni] = *(const bf16x8*)(Bb + ni * 32 * PITCH + ks * 16);
#pragma unroll
        for (int mi = 0; mi < 2; ++mi)
#pragma unroll
          for (int ni = 0; ni < NI; ++ni) acc[mi][ni] = MFMA(a[mi], b[ni], acc[mi][ni]);
        gemm_stage_part<NI, ATR>(As + (u ^ 1) * 256 * PITCH, Bs + (u ^ 1) * BN * PITCH, tid, ra[u ^ 1], rb[u ^ 1], ks);
      }
      lds_barrier();
    }
  }
}

DI void p0_mod_item(const Params& p, int item, char* smem) {
  const int tid = otid();
  const int l = item / 48, rem = item % 48, nch = rem / 8, ks = rem % 8;
  float* sc = (float*)smem;
  __syncthreads();
  for (int idx = tid; idx < 9 * 128; idx += 512) {
    const int cnd = idx >> 7, k = ks * 128 + (idx & 127);
    const float *qcc = launder(p.c_ctx), *qc = launder(p.c);
    const float v = cnd == 0 ? qcc[k] : qc[(cnd - 1) * 1024 + k];
    sc[idx] = v / (1.f + expf(-v));
  }
  __syncthreads();
  const int n = nch * 512 + tid;
  float acc[9];
#pragma unroll
  for (int i = 0; i < 9; ++i) acc[i] = 0.f;
  const float* w = p.w_mod + ((size_t)l * 1024 + ks * 128) * 3072 + n;
#pragma unroll 4
  for (int kk = 0; kk < 128; ++kk) {
    const float wv = w[(size_t)kk * 3072];
#pragma unroll
    for (int i = 0; i < 9; ++i) acc[i] += sc[i * 128 + kk] * wv;
  }
  float* mods = (float*)(p.ws + OFF_MODS);
  const float bias = ks == 0 ? p.b_mod[l * 3072 + n] : 0.f;
#pragma unroll
  for (int i = 0; i < 9; ++i) atomicAdd(&mods[(l * 9 + i) * 3072 + n], acc[i] + bias);
}

DI void transpose_tile(const float* __restrict__ src, int ldn, bf16* __restrict__ dst, int ldk, int k0, int n0, char* smem) {
  float* T = (float*)smem;
  const int tid = otid();
  __syncthreads();
  {
    const int k = tid >> 3, nc = (tid & 7) * 8;
    const float* s = src + (size_t)(k0 + k) * ldn + n0 + nc;
    const float4 a = *(const float4*)s, b = *(const float4*)(s + 4);
    float* t = T + k * 65 + nc;
    t[0] = a.x; t[1] = a.y; t[2] = a.z; t[3] = a.w; t[4] = b.x; t[5] = b.y; t[6] = b.z; t[7] = b.w;
  }
  __syncthreads();
  {
    const int n = tid >> 3, kc = (tid & 7) * 8;
    bf16x8 v;
#pragma unroll
    for (int j = 0; j < 8; ++j) v[j] = (short)f2bf(T[(kc + j) * 65 + n]);
    *(bf16x8*)(dst + (size_t)(n0 + n) * ldk + k0 + kc) = v;
  }
}

DI void p0_transpose_item(const Params& p, int item, char* smem) {
  const int l = item / 2752;
  int rem = item % 2752;
  bf16* wl = (bf16*)(p.ws + OFF_W) + (size_t)l * W_LAYER;
  if (rem < 1344) {
    const int kt = rem / 84, nt = rem % 84;
    transpose_tile(p.w_in + (size_t)l * 1024 * IN_DIM, IN_DIM, wl + W_IN, 1024, kt * 64, nt * 64, smem);
    return;
  }
  rem -= 1344;
  if (rem < 768) {
    const int kt = rem / 48, nt = rem % 48;
    transpose_tile(p.w_merge + (size_t)l * 1024 * 3072, 3072, wl + W_MG, 1024, kt * 64, nt * 64, smem);
    return;
  }
  rem -= 768;
  if (rem < 384) {
    const int br = rem / 128, r2 = rem % 128, kt = r2 / 16, nt = r2 % 16;
    const float *qa = launder(p.w_a), *qb = launder(p.w_b), *qc = launder(p.w_c);
    const float* src = (br == 0 ? qa : br == 1 ? qb : qc) + (size_t)l * 512 * 1024;
    transpose_tile(src, 1024, wl + (br == 0 ? W_A : br == 1 ? W_B : W_C), 512, kt * 64, nt * 64, smem);
    return;
  }
  rem -= 384;
  {
    const int kt = rem / 16, nt = rem % 16;
    transpose_tile(p.w_out + (size_t)l * 1024 * 1024, 1024, wl + W_O, 1024, kt * 64, nt * 64, smem);
  }
}

DI void p0_rope_item(const Params& p, int item) {
  const int idx = item * 512 + otid();
  const int t = idx >> 5, f = idx & 31;
  const float inv = powf(10000.f, -(float)(f & 15) / 16.f);
  const float ang = (float)(f < 16 ? (t >> 6) : (t & 63)) * inv;
  float2 cs;
  cs.x = cosf(ang);
  cs.y = sinf(ang);
  ((float2*)(p.ws + OFF_ROPE))[idx] = cs;
}

DI void phase0(const Params& p, char* smem) {
  const int n_mod = 192, n_tr = 11008, n_rope = 256;
  for (int it = blockIdx.x; it < n_mod + n_tr + n_rope; it += gridDim.x) {
    if (it < n_mod) p0_mod_item(p, it, smem);
    else if (it < n_mod + n_tr) p0_transpose_item(p, it - n_mod, smem);
    else p0_rope_item(p, it - n_mod - n_tr);
  }
}

DI void filter_item(const Params& p, int layer, int item, char* smem) {
  const int tid = otid();
  int var, pc, cc, L;
  if (item < 512) { var = 0; pc = item >> 3; cc = item & 7; L = 4096; }
  else { var = 1; pc = (item - 512) >> 3; cc = (item - 512) & 7; L = 256; }
  float* z = (float*)smem;
  float* hid = z + 64 * 17;
  float* w2s = hid + 64 * 65;
  __syncthreads();
  {
    const int pos = tid >> 3, band = tid & 7;
    const int pa = pc * 64 + pos;
    const float w = 6.283185307179586f * (float)pa / (float)L;
    const float f = 1e-4f + (float)band * ((7.f - 1e-4f) / 7.f);
    z[pos * 17 + 1 + band] = cosf(f * w);
    z[pos * 17 + 9 + band] = -sinf(f * w);
    if (band == 0) z[pos * 17] = (float)pa / (float)(L - 1);
  }
  __syncthreads();
  {
    const int pos = tid >> 3, j0 = (tid & 7) * 8;
    const float* w1 = p.hy_w1 + layer * 17 * 64;
#pragma unroll
    for (int jj = 0; jj < 8; ++jj) {
      const int j = j0 + jj;
      float pre = p.hy_b1[layer * 64 + j];
      for (int f = 0; f < 17; ++f) pre += z[pos * 17 + f] * w1[f * 64 + j];
      hid[pos * 65 + j] = sinf(p.hy_freq[layer * 64 + j] * pre);
    }
    const float* w2 = p.hy_w2 + (size_t)layer * 64 * 2048 + cc * 256;
    for (int idx = tid; idx < 64 * 256; idx += 512) w2s[idx] = w2[(idx >> 8) * 2048 + (idx & 255)];
  }
  __syncthreads();
  {
    const int lane = tid & 63, wave = tid >> 6, r = lane & 31, hh = lane >> 5;
    f32x16 acc[2];
    acc[0] = zero16();
    acc[1] = zero16();
#pragma unroll 4
    for (int ks = 0; ks < 32; ++ks) {
      const float bv = w2s[(2 * ks + hh) * 256 + wave * 32 + r];
#pragma unroll
      for (int mi = 0; mi < 2; ++mi) {
        const float av = hid[(mi * 32 + r) * 65 + 2 * ks + hh];
        acc[mi] = __builtin_amdgcn_mfma_f32_32x32x2f32(av, bv, acc[mi], 0, 0, 0);
      }
    }
    const int n = cc * 256 + wave * 32 + r;
    const int o = n >> 10, dir = (n >> 9) & 1, c = n & 511;
    const float min_d = -3.0701134573253945f, max_d = -15.350567286626973f;
    const float ad = fabsf(min_d + (float)c * ((max_d - min_d) / 511.f));
    float* g = (float*)(p.ws + (var == 0 ? OFF_GL : OFF_GC)) + ((size_t)(o * 512 + c)) * (2 * L);
    float asum = 0.f;
#pragma unroll
    for (int mi = 0; mi < 2; ++mi)
#pragma unroll
      for (int i = 0; i < 16; ++i) {
        const int pa = pc * 64 + mi * 32 + crow(i, hh);
        const float t = (float)pa / (float)(L - 1);
        const float v = acc[mi][i] * expf(-t * ad);
        asum += fabsf(v);
        int y;
        if (dir == 0) y = L - pa;
        else y = (pa == 0) ? 0 : L + pa;
        g[y] = v;
      }
    atomicAdd((float*)(p.ws + OFF_FSUM) + ((layer * 2 + var) * 2 + o) * 512 + c, asum);
  }
}

DI void p1a(const Params& p, int layer, int grp, char* smem) {
  const int g0 = grp ? TG : 0, tgn = grp ? 16384 : TG;
  const int nfilt = grp ? 0 : 544;
  const int nrow_items = tgn / 8;
  const int tid_ = otid();
  const int lane = tid_ & 63, wave = tid_ >> 6;
  bf16* H = (bf16*)(p.ws + OFF_H);
  const float* mods = (const float*)(p.ws + OFF_MODS);
  for (int it = blockIdx.x; it < nfilt + nrow_items; it += gridDim.x) {
    if (it < nfilt) { filter_item(p, layer, it, smem); continue; }
    const int tl = (it - nfilt) * 8 + wave, tg = g0 + tl;
    const float *qxp = launder(p.x_prompt), *qxs = launder(p.x_sample), *qo = launder(p.out);
    const float* x = layer == 0 ? (tg < T_CTX ? qxp + (size_t)tg * DM : qxs + (size_t)(tg - T_CTX) * DM) : qo + (size_t)tg * DM;
    float4 v[4];
    float ss = 0.f;
#pragma unroll
    for (int i = 0; i < 4; ++i) {
      v[i] = *(const float4*)(x + (lane + 64 * i) * 4);
      ss += v[i].x * v[i].x + v[i].y * v[i].y + v[i].z * v[i].z + v[i].w * v[i].w;
    }
#pragma unroll
    for (int o = 32; o > 0; o >>= 1) ss += __shfl_xor(ss, o);
    const float rstd = rsqrtf(ss * (1.f / 1024.f) + 1e-6f);
    const float* md = mods + (layer * 9 + cond_of(tg)) * 3072;
    const float* nw = p.norm_w + layer * 1024;
#pragma unroll
    for (int i = 0; i < 4; ++i) {
      const int col = (lane + 64 * i) * 4;
      const float4 sh = *(const float4*)(md + col), sc = *(const float4*)(md + 1024 + col), w = *(const float4*)(nw + col);
      bf16x4 o;
      o[0] = (short)f2bf(v[i].x * rstd * w.x * (1.f + sc.x) + sh.x);
      o[1] = (short)f2bf(v[i].y * rstd * w.y * (1.f + sc.y) + sh.y);
      o[2] = (short)f2bf(v[i].z * rstd * w.z * (1.f + sc.z) + sh.z);
      o[3] = (short)f2bf(v[i].w * rstd * w.w * (1.f + sc.w) + sh.w);
      *(bf16x4*)(H + (size_t)tl * 1024 + col) = o;
    }
  }
}

DI void p1b(const Params& p, int layer, int grp, char* smem) {
  const int g0 = grp ? TG : 0, tgn = grp ? 16384 : TG;
  const int mtiles = tgn / 256, ntot = mtiles * 42;
  const int tid = otid(), lane = tid & 63, wave = tid >> 6;
  const int wm = wave >> 1, wn = wave & 1, r = lane & 31, h = lane >> 5;
  const bf16* H = (const bf16*)(p.ws + OFF_H);
  const bf16* WinT = (const bf16*)(p.ws + OFF_W) + (size_t)layer * W_LAYER + W_IN;
  float* S = (float*)smem;
  u32x4 ra[2][4], rb[2][2];
  bool pre = false;
  for (int id = blockIdx.x; id < ntot; id += gridDim.x) {
    const int band = id / (16 * 42), rem = id % (16 * 42);
    const int mt = band * 16 + (rem & 15), nt = rem >> 4;
    const int idn = id + gridDim.x;
    const bool hn = idn < ntot;
    const int bandn = idn / (16 * 42), remn = idn % (16 * 42);
    const int mtn = bandn * 16 + (remn & 15), ntn = remn >> 4;
    f32x16 acc[2][2];
#pragma unroll
    for (int a = 0; a < 2; ++a)
#pragma unroll
      for (int b = 0; b < 2; ++b) acc[a][b] = zero16();
    gemm_main<2, false>(mksrc(H + (size_t)mt * 256 * 1024, 1024, WinT + (size_t)nt * 128 * 1024, 1024, 0), 1024, acc, smem, ra, rb, pre,
                        mksrc(H + (size_t)mtn * 256 * 1024, 1024, WinT + (size_t)ntn * 128 * 1024, 1024, 0), hn);
    pre = true;
    const int m0 = mt * 256, tg0 = g0 + m0;
    const bool lat = tg0 >= T_CTX;
    if (nt < 16) {
#pragma unroll
      for (int mi = 0; mi < 2; ++mi)
#pragma unroll
        for (int ni = 0; ni < 2; ++ni)
#pragma unroll
          for (int g4 = 0; g4 < 4; ++g4) {
            f32x4v v;
#pragma unroll
            for (int j = 0; j < 4; ++j) v[j] = acc[mi][ni][4 * g4 + j];
            *(f32x4v*)(S + (wn * 64 + ni * 32 + r) * 260 + wm * 64 + mi * 32 + 8 * g4 + 4 * h) = v;
          }
      __syncthreads();
      const int part = nt >> 2;
#pragma unroll 2
      for (int it = 0; it < 8; ++it) {
        const int pid = tid + 512 * it, cl = pid >> 5, q = pid & 31;
        const f32x4v a = *(const f32x4v*)(S + cl * 260 + q * 8), b = *(const f32x4v*)(S + cl * 260 + q * 8 + 4);
        bf16x8 v;
#pragma unroll
        for (int j = 0; j < 4; ++j) {
          v[j] = (short)f2bf(a[j]);
          v[4 + j] = (short)f2bf(b[j]);
        }
        *(bf16x8*)((bf16*)(p.ws + OFF_HYT) + ((size_t)(part * 512 + (nt & 3) * 128 + cl)) * TG + m0 + q * 8) = v;
      }
    } else {
#pragma unroll
      for (int mi = 0; mi < 2; ++mi)
#pragma unroll
        for (int ni = 0; ni < 2; ++ni)
#pragma unroll
          for (int i = 0; i < 16; ++i) S[(wm * 64 + mi * 32 + crow(i, h)) * 132 + wn * 64 + ni * 32 + r] = acc[mi][ni][i];
      __syncthreads();
      size_t off; int pitch, coloff; bool rope = false; int cache = 0;
      if (nt < 20) { off = OFF_AQ; pitch = 512; coloff = (nt - 16) * 128; rope = lat; }
      else if (nt == 20) { off = OFF_AK; pitch = 128; coloff = 0; rope = lat; cache = lat ? 0 : 1; }
      else if (nt == 21) { off = OFF_AV; pitch = 128; coloff = 0; cache = lat ? 0 : 2; }
      else if (nt < 26) { off = OFF_AG; pitch = 512; coloff = (nt - 22) * 128; }
      else if (nt < 30) { off = OFF_RQ; pitch = 512; coloff = (nt - 26) * 128; rope = lat; }
      else if (nt < 34) { off = OFF_RK; pitch = 512; coloff = (nt - 30) * 128; rope = lat; }
      else if (nt < 38) { off = OFF_RV; pitch = 512; coloff = (nt - 34) * 128; }
      else { off = OFF_RG; pitch = 512; coloff = (nt - 38) * 128; }
      bf16* dst = (bf16*)(p.ws + off);
      const float2* rt = (const float2*)(p.ws + OFF_ROPE);
#pragma unroll 2
      for (int it = 0; it < 8; ++it) {
        const int cid = tid + 512 * it, row = cid >> 4, cc = cid & 15;
        const float* sp = S + row * 132 + cc * 8;
        float v[8];
#pragma unroll
        for (int j = 0; j < 8; ++j) v[j] = sp[j];
        if (cache) {
          float* co = p.out + (cache == 1 ? OUT_CK : OUT_CV) + ((size_t)((tg0 >> 8) * 4 + layer) * 256 + row) * 128 + cc * 8;
          *(float4*)co = make_float4(v[0], v[1], v[2], v[3]);
          *(float4*)(co + 4) = make_float4(v[4], v[5], v[6], v[7]);
        }
        if (rope) {
          const int hd0 = (cc * 8) & 63, q = hd0 >> 4;
          const int tpos = (tg0 - T_CTX + row) & 4095;
          const float2* tb = rt + tpos * 32 + (q >> 1) * 16 + (hd0 & 15);
          const float* pp = sp + ((q & 1) ? -16 : 16);
          const float sg = (q & 1) ? 1.f : -1.f;
#pragma unroll
          for (int j = 0; j < 8; ++j) {
            const float2 cs = tb[j];
            v[j] = v[j] * cs.x + sg * pp[j] * cs.y;
          }
        }
        bf16x8 o;
#pragma unroll
        for (int j = 0; j < 8; ++j) o[j] = (short)f2bf(v[j]);
        *(bf16x8*)(dst + (size_t)(m0 + row) * pitch + coloff + cc * 8) = o;
      }
    }
  }
}

template <int NBT, int L>
DI void hyena_item(const Params& p, int layer, int var, int tlbase, int c, char* smem) {
  constexpr int NP = 32 / NBT, NT = (L / 8) / (32 * NP), UP = L + 8;
  bf16* U = (bf16*)smem;
  bf16* X1 = U + NBT * UP;
  bf16* X2 = X1 + NBT * UP;
  bf16* GR = X2 + NBT * UP;
  bf16* GR1 = GR + 2 * L + 8;
  const int tid = otid(), lane = tid & 63, wave = tid >> 6;
  const int n = lane & 31, hh = lane >> 5, b = n & (NBT - 1), pp = n / NBT;
  const bf16* hyT = (const bf16*)(p.ws + OFF_HYT);
  const float* fs = (const float*)(p.ws + OFF_FSUM) + (layer * 2 + var) * 1024;
  const float* gsrc = (const float*)(p.ws + (var == 0 ? OFF_GL : OFF_GC));
  __syncthreads();
#pragma unroll 1
  for (int part = 0; part < 3; ++part) {
    const bf16* src = hyT + ((size_t)(part * 512 + c)) * TG + tlbase;
    bf16* dstb = part == 0 ? U : part == 1 ? X1 : X2;
    const float w0 = p.hy_conv[(layer * 3 + 0) * 1536 + part * 512 + c];
    const float w1 = p.hy_conv[(layer * 3 + 1) * 1536 + part * 512 + c];
    const float w2 = p.hy_conv[(layer * 3 + 2) * 1536 + part * 512 + c];
#pragma unroll
    for (int it = 0; it < NBT * L / 8 / 512; ++it) {
      const int id = tid + 512 * it;
      const int bb = id / (L / 8), t8 = (id % (L / 8)) * 8;
      const bf16* s = src + bb * L + t8;
      const bf16x8 xv = *(const bf16x8*)s;
      float x[10];
      x[0] = t8 > 0 ? bf2f(s[-1]) : 0.f;
      x[9] = t8 + 8 < L ? bf2f(s[8]) : 0.f;
#pragma unroll
      for (int j = 0; j < 8; ++j) x[j + 1] = bf2f((bf16)xv[j]);
      bf16x8 o;
#pragma unroll
      for (int j = 0; j < 8; ++j) o[j] = (short)f2bf(w0 * x[j] + w1 * x[j + 1] + w2 * x[j + 2]);
      *(bf16x8*)(dstb + bb * UP + t8) = o;
    }
  }
  const int wbase = wave * (L / 8);
  const int dmin = -(wbase + (NT - 1) * 32 * NP + 32 * (NP - 1)), dmax = L - 16 - wbase;
  f32x16 acc[NT];
#pragma unroll 1
  for (int o = 0; o < 2; ++o) {
    {
      const float inv = 1.f / fs[o * 512 + c];
      const float* gs = gsrc + ((size_t)(o * 512 + c)) * (2 * L);
      const float skip = p.hy_skip[(layer * 2 + o) * 512 + c];
#pragma unroll 8
      for (int y = tid; y < 2 * L; y += 512) {
        float v = gs[y] * inv;
        if (y == L) v = (gs[L] + gs[0]) * inv + skip;
        if (y == 0) v = 0.f;
        const bf16 bv = f2bf(v);
        GR[y] = bv;
        if (y > 0) GR1[y - 1] = bv;
      }
      if (tid == 0) GR1[2 * L - 1] = 0;
    }
    __syncthreads();
#pragma unroll
    for (int q = 0; q < NT; ++q) acc[q] = zero16();
#pragma unroll 1
    for (int d = dmin; d <= dmax; d += 16) {
      const unsigned* gp = (const unsigned*)(((n & 1) ? GR1 - 1 : GR) + (L - n + d + 8 * hh));
      typedef __attribute__((ext_vector_type(4))) unsigned u4;
      u4 aw;
#pragma unroll
      for (int j = 0; j < 4; ++j) aw[j] = gp[j];
      const bf16x8 a = __builtin_bit_cast(bf16x8, aw);
#pragma unroll
      for (int q = 0; q < NT; ++q) {
        const int s0 = wbase + q * 32 * NP + 32 * pp + d;
        bf16x8 bb;
#pragma unroll
        for (int j = 0; j < 8; ++j) bb[j] = 0;
        if (s0 >= 0 && s0 <= L - 16) bb = *(const bf16x8*)(U + b * UP + s0 + 8 * hh);
        acc[q] = MFMA(a, bb, acc[q]);
      }
    }
    __syncthreads();
    if (o == 0) {
#pragma unroll
      for (int q = 0; q < NT; ++q)
#pragma unroll
        for (int i = 0; i < 16; ++i) {
          const int t = wbase + q * 32 * NP + 32 * pp + crow(i, hh);
          U[b * UP + t] = f2bf(bf2f(X1[b * UP + t]) * acc[q][i]);
        }
    } else {
      const bf16* gate = hyT + ((size_t)(3 * 512 + c)) * TG + tlbase;
#pragma unroll
      for (int q = 0; q < NT; ++q)
#pragma unroll
        for (int g4 = 0; g4 < 4; ++g4) {
          const int t = wbase + q * 32 * NP + 32 * pp + 8 * g4 + 4 * hh;
          const bf16x4 gv = *(const bf16x4*)(gate + b * L + t);
          bf16x4 ov;
#pragma unroll
          for (int j = 0; j < 4; ++j)
            ov[j] = (short)f2bf(bf2f(X2[b * UP + t + j]) * acc[q][4 * g4 + j] * siluf(bf2f((bf16)gv[j])));
          *(bf16x4*)(U + b * UP + t) = ov;
        }
      __syncthreads();
      bf16* yat = (bf16*)(p.ws + OFF_YA) + (size_t)c * TG + tlbase;
      for (int id = tid; id < NBT * L / 8; id += 512) {
        const int bb = id / (L / 8), t8 = (id % (L / 8)) * 8;
        *(bf16x8*)(yat + bb * L + t8) = *(const bf16x8*)(U + bb * UP + t8);
      }
    }
  }
}

DI void attn_item(const Params& p, int layer, bool lat, int tlbase, int bglob, int kvh, int qblk, char* smem) {
  bf16* Ks = (bf16*)smem;
  bf16* VT = Ks + 64 * 72;
  const int tid = otid(), lane = tid & 63, wave = tid >> 6;
  const int r = lane & 31, hh = lane >> 5;
  const int head = kvh * 4 + (wave >> 1);
  const int qi = qblk * 64 + (wave & 1) * 32 + r;
  const int tlq = tlbase + qi;
  const bf16* aq = (const bf16*)(p.ws + OFF_AQ);
  const bf16* ak = (const bf16*)(p.ws + OFF_AK);
  const bf16* av = (const bf16*)(p.ws + OFF_AV);
  bf16* ag = (bf16*)(p.ws + OFF_AG);
  bf16x8 bq[4];
#pragma unroll
  for (int ks = 0; ks < 4; ++ks) bq[ks] = *(const bf16x8*)(aq + (size_t)tlq * 512 + head * 64 + ks * 16 + hh * 8);
  const float sink2 = p.attn_sink[layer * 8 + head] * LOG2E;
  const float SC = 0.125f * LOG2E;
  float m = sink2, lsum = 0.f;
  f32x16 O[2];
  O[0] = zero16();
  O[1] = zero16();
  const int t_lo = lat ? (2 - qblk > 0 ? 2 - qblk : 0) : 0;
  const int t_hi = lat ? (65 - qblk < 4 ? 65 - qblk : 4) : 3;
  const int nw = t_hi - t_lo + 1;
  const int ntot = lat ? nw + 8 : nw;
  const int lj = tid >> 3, lkc = (tid & 7) * 8;
  u32x4 pr0, pr1, pr2, pr3;
  pr2 = u32x4{0, 0, 0, 0};
  pr3 = u32x4{0, 0, 0, 0};
  {
    const int kp = lat ? qblk * 64 - 128 + t_lo * 64 : 0;
    const size_t o = (size_t)(tlbase + kp + lj) * 128 + kvh * 64 + lkc;
    pr0 = *(const u32x4*)(ak + o);
    pr1 = *(const u32x4*)(av + o);
  }
#pragma unroll 1
  for (int n = 0; n < ntot; ++n) {
    const bool from_cache = lat && n >= nw;
    const bool window = lat && n < nw;
    const int kpos0 = from_cache ? (n - nw) * 64 : (lat ? qblk * 64 - 128 + (t_lo + n) * 64 : n * 64);
    lds_barrier();
    {
      bf16x8 kv, vv;
      if (from_cache) {
        const f32x4v k0 = __builtin_bit_cast(f32x4v, pr0), k1 = __builtin_bit_cast(f32x4v, pr1);
        const f32x4v v0 = __builtin_bit_cast(f32x4v, pr2), v1 = __builtin_bit_cast(f32x4v, pr3);
#pragma unroll
        for (int e = 0; e < 4; ++e) {
          kv[e] = (short)f2bf(k0[e]);
          kv[4 + e] = (short)f2bf(k1[e]);
          vv[e] = (short)f2bf(v0[e]);
          vv[4 + e] = (short)f2bf(v1[e]);
        }
      } else {
        kv = __builtin_bit_cast(bf16x8, pr0);
        vv = __builtin_bit_cast(bf16x8, pr1);
      }
      *(bf16x8*)(Ks + lj * 72 + lkc) = kv;
#pragma unroll
      for (int jj = 0; jj < 8; ++jj) VT[(lkc + jj) * 68 + lj] = (bf16)vv[jj];
    }
    lds_barrier();
    {
      const int nn = n + 1 < ntot ? n + 1 : n;
      if (lat && nn >= nw) {
        const size_t o = ((((size_t)bglob * 4 + layer) * 512 + (nn - nw) * 64 + lj) * 2 + kvh) * 64 + lkc;
        pr0 = *(const u32x4*)(p.cache_k + o);
        pr1 = *(const u32x4*)(p.cache_k + o + 4);
        pr2 = *(const u32x4*)(p.cache_v + o);
        pr3 = *(const u32x4*)(p.cache_v + o + 4);
      } else {
        const int kp = lat ? qblk * 64 - 128 + (t_lo + nn) * 64 : nn * 64;
        const size_t o = (size_t)(tlbase + kp + lj) * 128 + kvh * 64 + lkc;
        pr0 = *(const u32x4*)(ak + o);
        pr1 = *(const u32x4*)(av + o);
      }
    }
    f32x16 sc[2];
#pragma unroll
    for (int sub = 0; sub < 2; ++sub) {
      sc[sub] = zero16();
#pragma unroll
      for (int ks = 0; ks < 4; ++ks) {
        const bf16x8 a = *(const bf16x8*)(Ks + (sub * 32 + r) * 72 + ks * 16 + hh * 8);
        sc[sub] = MFMA(a, bq[ks], sc[sub]);
      }
    }
    float mx = -3.0e38f;
#pragma unroll
    for (int sub = 0; sub < 2; ++sub)
#pragma unroll
      for (int i = 0; i < 16; ++i) {
        float sv = sc[sub][i] * SC;
        if (window) {
          const int diff = qi - (kpos0 + sub * 32 + crow(i, hh));
          if (diff > 128 || diff < -128) sv = -1e30f;
        }
        sc[sub][i] = sv;
        mx = fmaxf(mx, sv);
      }
    mx = fmaxf(mx, __shfl_xor(mx, 32));
    const float mnew = fmaxf(m, mx);
    const float alpha = __builtin_amdgcn_exp2f(m - mnew);
    m = mnew;
    float ps = 0.f;
#pragma unroll
    for (int sub = 0; sub < 2; ++sub)
#pragma unroll
      for (int i = 0; i < 16; ++i) {
        sc[sub][i] = __builtin_amdgcn_exp2f(sc[sub][i] - m);
        ps += sc[sub][i];
      }
    lsum = lsum * alpha + ps;
    if (__builtin_amdgcn_ballot_w64(alpha != 1.f) != 0) {
#pragma unroll
      for (int i = 0; i < 16; ++i) {
        O[0][i] *= alpha;
        O[1][i] *= alpha;
      }
    }
#pragma unroll
    for (int sub = 0; sub < 2; ++sub)
#pragma unroll
      for (int st = 0; st < 2; ++st) {
        const bf16x8 pf = pack8(sc[sub], st);
#pragma unroll
        for (int mi = 0; mi < 2; ++mi) {
          const bf16* vp = VT + (mi * 32 + r) * 68 + sub * 32 + 16 * st + 4 * hh;
          const bf16x4 lo = *(const bf16x4*)vp, hi = *(const bf16x4*)(vp + 8);
          const bf16x8 va = __builtin_shufflevector(lo, hi, 0, 1, 2, 3, 4, 5, 6, 7);
          O[mi] = MFMA(va, pf, O[mi]);
        }
      }
  }
  const float ltot = lsum + __shfl_xor(lsum, 32) + exp2f(sink2 - m);
  const float inv = 1.f / ltot;
#pragma unroll
  for (int mi = 0; mi < 2; ++mi)
#pragma unroll
    for (int g4 = 0; g4 < 4; ++g4) {
      bf16* gp = ag + (size_t)tlq * 512 + head * 64 + mi * 32 + 8 * g4 + 4 * hh;
      const bf16x4 gv = *(const bf16x4*)gp;
      bf16x4 o;
#pragma unroll
      for (int j = 0; j < 4; ++j) o[j] = (short)f2bf(O[mi][4 * g4 + j] * inv * siluf(bf2f((bf16)gv[j])));
      *(bf16x4*)gp = o;
    }
}

DI void ret_item(const Params& p, int layer, bool lat, int NC, int tlbase, int bglob, int hd, char* smem) {
  const int tid = otid(), lane = tid & 63, wave = tid >> 6;
  const int dir = wave >> 2, w4 = wave & 3, r = lane & 31, hh = lane >> 5, dt = tid & 255;
  bf16* Ks = (bf16*)smem + dir * 31232;
  bf16* KdT = Ks + 128 * 72;
  bf16* VT = KdT + 64 * 136;
  bf16* ST = VT + 64 * 136;
  const bf16* rq = (const bf16*)(p.ws + OFF_RQ);
  const bf16* rk = (const bf16*)(p.ws + OFF_RK);
  const bf16* rv = (const bf16*)(p.ws + OFF_RV);
  bf16* rg = (bf16*)(p.ws + OFF_RG);
  bf16* ofb = (bf16*)(p.ws + OFF_OFB);
  const float theta = p.ret_theta[(layer * 2 + dir) * 8 + hd];
  const float lg2 = -log1pf(expf(-theta)) * LOG2E;
  const float cdec = exp2f(lg2 * 128.f);
  const int etile = w4 >> 1, dtile = w4 & 1;
  f32x16 Sacc;
  if (lat) {
    const float* s0 = p.state_ret + ((((size_t)bglob * 4 + layer) * 2 + dir) * 8 + hd) * 4096;
#pragma unroll
    for (int i = 0; i < 16; ++i) Sacc[i] = s0[(dtile * 32 + r) * 64 + etile * 32 + crow(i, hh)];
  } else {
    Sacc = zero16();
  }
  __syncthreads();
#pragma unroll
  for (int i = 0; i < 16; ++i) ST[(etile * 32 + crow(i, hh)) * 72 + dtile * 32 + r] = f2bf(Sacc[i]);
#pragma unroll 1
  for (int step = 0; step < NC; ++step) {
    const int ch = dir ? NC - 1 - step : step;
    const int tl0 = tlbase + ch * 128;
    const int iq = w4 * 32 + r, tlq = tl0 + iq;
    const bool second = step >= NC / 2;
    bf16x8 kv[4], vv[4], bq[4];
    bf16x4 pp[8], pg[8];
    const int jrow = dt & 127;
#pragma unroll
    for (int i = 0; i < 4; ++i) {
      const int kc = ((dt >> 7) + 2 * i) * 8;
      const size_t o = (size_t)(tl0 + jrow) * 512 + hd * 64 + kc;
      kv[i] = *(const bf16x8*)(rk + o);
      vv[i] = *(const bf16x8*)(rv + o);
    }
#pragma unroll
    for (int ks = 0; ks < 4; ++ks) bq[ks] = *(const bf16x8*)(rq + (size_t)tlq * 512 + hd * 64 + ks * 16 + hh * 8);
    if (second) {
#pragma unroll
      for (int mi = 0; mi < 2; ++mi)
#pragma unroll
        for (int g4 = 0; g4 < 4; ++g4) {
          const size_t o = (size_t)tlq * 512 + hd * 64 + mi * 32 + 8 * g4 + 4 * hh;
          pp[mi * 4 + g4] = *(const bf16x4*)(ofb + o);
          pg[mi * 4 + g4] = *(const bf16x4*)(rg + o);
        }
    } else {
#pragma unroll
      for (int i = 0; i < 8; ++i) {
        pp[i] = bf16x4{0, 0, 0, 0};
        pg[i] = bf16x4{0, 0, 0, 0};
      }
    }
    {
      const float kd = exp2f(lg2 * (float)(dir ? jrow : 127 - jrow)) * 0.125f;
#pragma unroll
      for (int i = 0; i < 4; ++i) {
        const int kc = ((dt >> 7) + 2 * i) * 8;
        *(bf16x8*)(Ks + jrow * 72 + kc) = kv[i];
#pragma unroll
        for (int jj = 0; jj < 8; ++jj) {
          KdT[(kc + jj) * 136 + jrow] = f2bf(bf2f((bf16)kv[i][jj]) * kd);
          VT[(kc + jj) * 136 + jrow] = (bf16)vv[i][jj];
        }
      }
    }
    __syncthreads();
    f32x16 O[2];
    {
      const float qd = exp2f(lg2 * (float)(dir ? 128 - iq : iq + 1));
#pragma unroll
      for (int mi = 0; mi < 2; ++mi) {
        f32x16 oc = zero16();
#pragma unroll
        for (int ks = 0; ks < 4; ++ks) {
          const bf16x8 a = *(const bf16x8*)(ST + (mi * 32 + r) * 72 + ks * 16 + hh * 8);
          oc = MFMA(a, bq[ks], oc);
        }
#pragma unroll
        for (int i = 0; i < 16; ++i) O[mi][i] = oc[i] * qd;
      }
    }
#pragma unroll 1
    for (int jt = 0; jt < 4; ++jt) {
      if (dir == 0 ? (jt <= w4) : (jt >= w4)) {
        f32x16 s = zero16();
#pragma unroll
        for (int ks = 0; ks < 4; ++ks) {
          const bf16x8 a = *(const bf16x8*)(Ks + (jt * 32 + r) * 72 + ks * 16 + hh * 8);
          s = MFMA(a, bq[ks], s);
        }
#pragma unroll
        for (int i = 0; i < 16; ++i) {
          const int j = jt * 32 + crow(i, hh);
          const int diff = dir ? j - iq : iq - j;
          s[i] = diff >= 0 ? s[i] * 0.125f * __builtin_amdgcn_exp2f(lg2 * (float)diff) : 0.f;
        }
#pragma unroll
        for (int st = 0; st < 2; ++st) {
          const bf16x8 pf = pack8(s, st);
#pragma unroll
          for (int mi = 0; mi < 2; ++mi) {
            const bf16* vp = VT + (mi * 32 + r) * 136 + jt * 32 + 16 * st + 4 * hh;
            const bf16x4 lo = *(const bf16x4*)vp, hi = *(const bf16x4*)(vp + 8);
            const bf16x8 va = __builtin_shufflevector(lo, hi, 0, 1, 2, 3, 4, 5, 6, 7);
            O[mi] = MFMA(va, pf, O[mi]);
          }
        }
      }
    }
#pragma unroll
    for (int i = 0; i < 16; ++i) Sacc[i] *= cdec;
#pragma unroll 2
    for (int jk = 0; jk < 8; ++jk) {
      const bf16x8 a = *(const bf16x8*)(VT + (etile * 32 + r) * 136 + jk * 16 + hh * 8);
      const bf16x8 bb = *(const bf16x8*)(KdT + (dtile * 32 + r) * 136 + jk * 16 + hh * 8);
      Sacc = MFMA(a, bb, Sacc);
    }
    if (!second) {
#pragma unroll
      for (int mi = 0; mi < 2; ++mi)
#pragma unroll
        for (int g4 = 0; g4 < 4; ++g4) {
          bf16x4 o;
#pragma unroll
          for (int j = 0; j < 4; ++j) o[j] = (short)f2bf(O[mi][4 * g4 + j]);
          *(bf16x4*)(ofb + (size_t)tlq * 512 + hd * 64 + mi * 32 + 8 * g4 + 4 * hh) = o;
        }
    } else {
      float ss = 0.f;
#pragma unroll
      for (int mi = 0; mi < 2; ++mi)
#pragma unroll
        for (int g4 = 0; g4 < 4; ++g4) {
          const bf16x4 pv = pp[mi * 4 + g4];
#pragma unroll
          for (int j = 0; j < 4; ++j) {
            const float v = O[mi][4 * g4 + j] + bf2f((bf16)pv[j]);
            O[mi][4 * g4 + j] = v;
            ss += v * v;
          }
        }
      ss += __shfl_xor(ss, 32);
      const float rn = rsqrtf(ss * (1.f / 64.f) + 1e-6f);
#pragma unroll
      for (int mi = 0; mi < 2; ++mi)
#pragma unroll
        for (int g4 = 0; g4 < 4; ++g4) {
          const int e0 = hd * 64 + mi * 32 + 8 * g4 + 4 * hh;
          bf16* gp = rg + (size_t)tlq * 512 + e0;
          const bf16x4 gv = pg[mi * 4 + g4];
          const float4 gn = *(const float4*)(p.ret_gn + layer * 512 + e0);
          bf16x4 o;
          o[0] = (short)f2bf(O[mi][4 * g4 + 0] * rn * gn.x * siluf(bf2f((bf16)gv[0])));
          o[1] = (short)f2bf(O[mi][4 * g4 + 1] * rn * gn.y * siluf(bf2f((bf16)gv[1])));
          o[2] = (short)f2bf(O[mi][4 * g4 + 2] * rn * gn.z * siluf(bf2f((bf16)gv[2])));
          o[3] = (short)f2bf(O[mi][4 * g4 + 3] * rn * gn.w * siluf(bf2f((bf16)gv[3])));
          *(bf16x4*)gp = o;
        }
    }
    __builtin_amdgcn_fence(__ATOMIC_SEQ_CST, "workgroup");
    __syncthreads();
#pragma unroll
    for (int i = 0; i < 16; ++i) ST[(etile * 32 + crow(i, hh)) * 72 + dtile * 32 + r] = f2bf(Sacc[i]);
  }
  if (!lat) {
    float* so = p.out + OUT_ST + ((((size_t)bglob * 4 + layer) * 2 + dir) * 8 + hd) * 4096;
#pragma unroll
    for (int i = 0; i < 16; ++i) so[(dtile * 32 + r) * 64 + etile * 32 + crow(i, hh)] = Sacc[i];
  }
}

DI void p2(const Params& p, int layer, int grp, char* smem, int* s_item) {
  int* ctr = (int*)(p.ws + OFF_CTR) + layer * 2 + grp;
  const int n_rl = 32, n_hl = 512, n_al = 512;
  const int n_hc = grp ? 0 : 512, n_rc = grp ? 0 : 256, n_ac = grp ? 0 : 256;
  const int total = n_rl + n_hl + n_al + n_hc + n_rc + n_ac;
  const int latbase = grp ? 0 : T_CTX;
  const int latb0 = grp ? 4 : 0;
  for (;;) {
    __syncthreads();
    if (threadIdx.x == 0) *s_item = atomicAdd(ctr, 1);
    __syncthreads();
    int it = *s_item;
    if (it >= total) break;
    if (it < n_rl) {
      const int b = it >> 3, hd = it & 7;
      ret_item(p, layer, true, 32, latbase + b * 4096, latb0 + b, hd, smem);
      continue;
    }
    it -= n_rl;
    if (it < n_hl) { hyena_item<4, 4096>(p, layer, 0, latbase, it, smem); continue; }
    it -= n_hl;
    if (it < n_al) {
      const int b = it >> 7, kvh = (it >> 6) & 1, qb = it & 63;
      attn_item(p, layer, true, latbase + b * 4096, latb0 + b, kvh, qb, smem);
      continue;
    }
    it -= n_al;
    if (it < n_hc) { hyena_item<32, 256>(p, layer, 1, 0, it, smem); continue; }
    it -= n_hc;
    if (it < n_rc) {
      const int b = it >> 3, hd = it & 7;
      ret_item(p, layer, false, 2, b * 256, b, hd, smem);
      continue;
    }
    it -= n_rc;
    {
      const int b = it >> 3, kvh = (it >> 2) & 1, qb = it & 3;
      attn_item(p, layer, false, b * 256, b, kvh, qb, smem);
    }
  }
}

DI unsigned pk2(float a, float b) { return (unsigned)f2bf(a) | ((unsigned)f2bf(b) << 16); }
DI float pklo(unsigned u) { return __uint_as_float(u << 16); }
DI float pkhi(unsigned u) { return __uint_as_float(u & 0xffff0000u); }
DI void p3a(const Params& p, int layer, int grp, char* smem) {
  const int tgn = grp ? 16384 : TG;
  const int mtiles = tgn / 256, ntot = mtiles * 8;
  const int tid = otid(), lane = tid & 63, wave = tid >> 6;
  const int wm = wave >> 1, wn = wave & 1, r = lane & 31, h = lane >> 5;
  const bf16* H = (const bf16*)(p.ws + OFF_H);
  const bf16* wl = (const bf16*)(p.ws + OFF_W) + (size_t)layer * W_LAYER;
  bf16* MG = (bf16*)(p.ws + OFF_MERGED);
  u32x4 ra[2][4], rb[2][2];
  bool pre = false;
  const bf16* YaT = (const bf16*)(p.ws + OFF_YA);
  for (int id = blockIdx.x; id < ntot; id += gridDim.x) {
    const int m0 = ((id >> 7) * 16 + (id & 15)) * 256, n0 = ((id & 127) >> 4) * 128;
    const int idn = id + gridDim.x;
    const bool hn = idn < ntot;
    const int m0n = ((idn >> 7) * 16 + (idn & 15)) * 256, n0n = ((idn & 127) >> 4) * 128;
    unsigned mgp[2][2][8];
#pragma unroll
    for (int a = 0; a < 2; ++a)
#pragma unroll
      for (int b = 0; b < 2; ++b)
#pragma unroll
        for (int i = 0; i < 8; ++i) mgp[a][b][i] = 0u;
#pragma unroll 1
    for (int br = 0; br < 3; ++br) {
      const GemmSrc gate = mksrc(H + (size_t)m0 * 1024, 1024, wl + W_MG + (size_t)(br * 1024 + n0) * 1024, 1024, 0);
      const bf16* WB = wl + (br == 0 ? W_A : br == 1 ? W_B : W_C);
      const GemmSrc bsrc = br == 0 ? mksrc(YaT + m0, TG, WB + (size_t)n0 * 512, 512, 1)
                                   : mksrc((const bf16*)(p.ws + (br == 1 ? OFF_AG : OFF_RG)) + (size_t)m0 * 512, 512, WB + (size_t)n0 * 512, 512, 0);
      const GemmSrc after = br < 2 ? mksrc(H + (size_t)m0 * 1024, 1024, wl + W_MG + (size_t)((br + 1) * 1024 + n0) * 1024, 1024, 0)
                                   : mksrc(H + (size_t)m0n * 1024, 1024, wl + W_MG + (size_t)n0n * 1024, 1024, 0);
      unsigned sg[2][2][8];
      {
        f32x16 ag[2][2];
#pragma unroll
        for (int a = 0; a < 2; ++a)
#pragma unroll
          for (int b = 0; b < 2; ++b) ag[a][b] = zero16();
        gemm_main<2, false>(gate, 1024, ag, smem, ra, rb, false, bsrc, false);
#pragma unroll
        for (int ni = 0; ni < 2; ++ni) {
          const float bias = p.b_merge[layer * 3072 + br * 1024 + n0 + wn * 64 + ni * 32 + r];
#pragma unroll
          for (int mi = 0; mi < 2; ++mi) {
#pragma unroll
            for (int i = 0; i < 8; ++i)
              sg[mi][ni][i] = pk2(sigmf(ag[mi][ni][2 * i] + bias), sigmf(ag[mi][ni][2 * i + 1] + bias));
            __builtin_amdgcn_sched_barrier(0);
          }
        }
      }
      f32x16 ay[2][2];
#pragma unroll
      for (int a = 0; a < 2; ++a)
#pragma unroll
        for (int b = 0; b < 2; ++b) ay[a][b] = zero16();
      if (br == 0) gemm_main<2, true>(bsrc, 512, ay, smem, ra, rb, false, after, false);
      else gemm_main<2, false>(bsrc, 512, ay, smem, ra, rb, false, after, false);
#pragma unroll
      for (int mi = 0; mi < 2; ++mi)
#pragma unroll
        for (int ni = 0; ni < 2; ++ni) {
#pragma unroll
          for (int i = 0; i < 8; ++i) {
            const float lo = pklo(mgp[mi][ni][i]) + pklo(sg[mi][ni][i]) * ay[mi][ni][2 * i];
            const float hi = pkhi(mgp[mi][ni][i]) + pkhi(sg[mi][ni][i]) * ay[mi][ni][2 * i + 1];
            mgp[mi][ni][i] = pk2(lo, hi);
          }
          __builtin_amdgcn_sched_barrier(0);
        }
    }
#pragma unroll
    for (int mi = 0; mi < 2; ++mi)
#pragma unroll
      for (int ni = 0; ni < 2; ++ni)
#pragma unroll
        for (int i = 0; i < 8; ++i) {
          bf16* d = MG + (size_t)(m0 + wm * 64 + mi * 32) * 1024 + n0 + wn * 64 + ni * 32 + r;
          d[(size_t)crow(2 * i, h) * 1024] = (bf16)(mgp[mi][ni][i] & 0xffffu);
          d[(size_t)crow(2 * i + 1, h) * 1024] = (bf16)(mgp[mi][ni][i] >> 16);
        }
  }
}

DI void p3b(const Params& p, int layer, int grp, char* smem) {
  const int g0 = grp ? TG : 0, tgn = grp ? 16384 : TG;
  const int mtiles = tgn / 256, ntot = mtiles * 8;
  const int tid = otid(), lane = tid & 63, wave = tid >> 6;
  const int wm = wave >> 1, wn = wave & 1, r = lane & 31, h = lane >> 5;
  const bf16* MG = (const bf16*)(p.ws + OFF_MERGED);
  const bf16* WoT = (const bf16*)(p.ws + OFF_W) + (size_t)layer * W_LAYER + W_O;
  const float* mods = (const float*)(p.ws + OFF_MODS);
  u32x4 ra[2][4], rb[2][2];
  bool pre = false;
  for (int id = blockIdx.x; id < ntot; id += gridDim.x) {
    const int band = id >> 7, rem = id & 127;
    const int mt = band * 16 + (rem & 15), nt = rem >> 4;
    const int m0 = mt * 256, n0 = nt * 128;
    const int idn = id + gridDim.x;
    const bool hn = idn < ntot;
    const int m0n = ((idn >> 7) * 16 + (idn & 15)) * 256, n0n = ((idn & 127) >> 4) * 128;
    f32x16 acc[2][2];
#pragma unroll
    for (int a = 0; a < 2; ++a)
#pragma unroll
      for (int b = 0; b < 2; ++b) acc[a][b] = zero16();
    gemm_main<2, false>(mksrc(MG + (size_t)m0 * 1024, 1024, WoT + (size_t)n0 * 1024, 1024, 0), 1024, acc, smem, ra, rb, pre,
                        mksrc(MG + (size_t)m0n * 1024, 1024, WoT + (size_t)n0n * 1024, 1024, 0), hn);
    pre = true;
    const int tg0 = g0 + m0;
    const float* gate = mods + (layer * 9 + cond_of(tg0)) * 3072 + 2048;
    const float *qxp = launder(p.x_prompt), *qxs = launder(p.x_sample), *qo = launder(p.out);
    const float* xsb = layer == 0 ? (tg0 < T_CTX ? qxp + (size_t)tg0 * DM : qxs + (size_t)(tg0 - T_CTX) * DM) : qo + (size_t)tg0 * DM;
    float* xdb = p.out + (size_t)tg0 * DM;
#pragma unroll
    for (int ni = 0; ni < 2; ++ni) {
      const int col = n0 + wn * 64 + ni * 32 + r;
      const float gt = gate[col];
#pragma unroll
      for (int mi = 0; mi < 2; ++mi)
#pragma unroll
        for (int i = 0; i < 16; ++i) {
          const int ro = (wm * 64 + mi * 32 + crow(i, h)) * DM + col;
          xdb[ro] = xsb[ro] + gt * acc[mi][ni][i];
        }
    }
  }
}

DI void final_norm(const Params& p) {
  const int tid_ = otid();
  const int lane = tid_ & 63, wave = tid_ >> 6;
  for (int it = blockIdx.x; it < T_ALL / 8; it += gridDim.x) {
    const int tg = it * 8 + wave;
    float* x = p.out + (size_t)tg * DM;
    float4 v[4];
    float ss = 0.f;
#pragma unroll
    for (int i = 0; i < 4; ++i) {
      v[i] = *(const float4*)(x + (lane + 64 * i) * 4);
      ss += v[i].x * v[i].x + v[i].y * v[i].y + v[i].z * v[i].z + v[i].w * v[i].w;
    }
#pragma unroll
    for (int o = 32; o > 0; o >>= 1) ss += __shfl_xor(ss, o);
    const float rstd = rsqrtf(ss * (1.f / 1024.f) + 1e-6f);
#pragma unroll
    for (int i = 0; i < 4; ++i) {
      const int col = (lane + 64 * i) * 4;
      const float4 w = *(const float4*)(p.final_w + col);
      *(float4*)(x + col) = make_float4(v[i].x * rstd * w.x, v[i].y * rstd * w.y, v[i].z * rstd * w.z, v[i].w * rstd * w.w);
    }
  }
}


#define XB_TMO 128
#define XB_XCNT(j) (256 + 64 * (j))
#define XB_XSUB(j) (1280 + 64 * (j))
#define XB_XGEN(j) (2304 + 64 * (j))
#define XB_TOP 3328
#define XB_TOPGEN 3392
#define XB_SPIN_CAP (1u << 22)
DI unsigned xb_ld(unsigned* p) { return __hip_atomic_load(p, __ATOMIC_RELAXED, __HIP_MEMORY_SCOPE_AGENT); }
DI unsigned xb_add(unsigned* p, unsigned v) { return __hip_atomic_fetch_add(p, v, __ATOMIC_RELAXED, __HIP_MEMORY_SCOPE_AGENT); }
DI unsigned xb_xcc_id() { return (unsigned)__builtin_amdgcn_s_getreg((3 << 11) | 20) & 0xFu; }
#define XB_SPIN(cond, bar)                                          \
  do {                                                              \
    unsigned _sp = 0;                                               \
    while (cond) {                                                  \
      __builtin_amdgcn_s_sleep(1);                                  \
      if ((++_sp & 255u) == 0u) {                                   \
        if (xb_ld(&(bar)[XB_TMO])) break;                           \
        if (_sp > XB_SPIN_CAP) {                                    \
          atomicAdd(&(bar)[XB_TMO], 1u);                            \
          break;                                                    \
        }                                                           \
      }                                                             \
    }                                                               \
  } while (0)
struct XcdBarrier {
  unsigned* bar;
  unsigned x;
  volatile unsigned* st;
};
DI void xcd_barrier_complete(unsigned* bar, unsigned x, unsigned& nloc, unsigned& nx) {
  const unsigned G = gridDim.x;
  unsigned sum, cnt, mine, sp = 0u;
  for (;;) {
    sum = 0u; cnt = 0u; mine = 0u;
#pragma unroll
    for (unsigned j = 0; j < 16; ++j) {
      const unsigned c = xb_ld(&bar[XB_XCNT(j)]);
      sum += c;
      cnt += (c > 0u) ? 1u : 0u;
      mine = (j == x) ? c : mine;
    }
    if (sum == G) break;
    __builtin_amdgcn_s_sleep(1);
    if ((++sp & 255u) == 0u) {
      if (xb_ld(&bar[XB_TMO])) break;
      if (sp > XB_SPIN_CAP) { atomicAdd(&bar[XB_TMO], 1u); break; }
    }
  }
  nloc = mine > 0u ? mine : 1u;
  nx = cnt > 0u ? cnt : 1u;
}
DI void xcd_barrier(char* ws, volatile unsigned* st) {
  asm volatile("" : "+s"(ws));
  XcdBarrier b;
  b.bar = (unsigned*)(ws + OFF_BAR);
  b.x = xb_xcc_id();
  b.st = st;
  asm volatile("s_waitcnt vmcnt(0)" ::: "memory");
  __syncthreads();
  if (threadIdx.x == 0) {
    unsigned* bar = b.bar;
    __builtin_amdgcn_s_waitcnt(0);
    unsigned nloc = b.st[0], nx = b.st[1];
    if (nloc == 0u) {
      xcd_barrier_complete(bar, b.x, nloc, nx);
      b.st[0] = nloc;
      b.st[1] = nx;
    }
    const unsigned old = xb_add(&bar[XB_XSUB(b.x)], 1u);
    const unsigned gen = old / nloc;
    if (old + 1u == (gen + 1u) * nloc) {
      __builtin_amdgcn_fence(__ATOMIC_RELEASE, "agent");
      asm volatile("s_waitcnt vmcnt(0)" ::: "memory");
      const unsigned og = xb_add(&bar[XB_TOP], 1u);
      const unsigned tg = og / nx;
      if (og + 1u == (tg + 1u) * nx) xb_add(&bar[XB_TOPGEN], 1u);
      else XB_SPIN(xb_ld(&bar[XB_TOPGEN]) == tg, bar);
      __builtin_amdgcn_fence(__ATOMIC_ACQUIRE, "agent");
      xb_add(&bar[XB_XGEN(b.x)], 1u);
      asm volatile("s_waitcnt vmcnt(0)" ::: "memory");
    } else {
      XB_SPIN(xb_ld(&bar[XB_XGEN(b.x)]) == gen, bar);
      __builtin_amdgcn_fence(__ATOMIC_ACQUIRE, "agent");
      asm volatile("s_waitcnt vmcnt(0)" ::: "memory");
    }
  }
  __syncthreads();
}

__global__ void __launch_bounds__(512) mega(Params p) {
  __shared__ __attribute__((aligned(16))) char smem[SMEM_BYTES];
  __shared__ __attribute__((aligned(16))) unsigned xb_words[4];
  __shared__ int s_item;
  cg::grid_group grid = cg::this_grid();
  if (threadIdx.x == 0) { xb_words[0] = 0u; xb_words[1] = 0u; xb_words[2] = 0u; xb_words[3] = 0u; }
  __syncthreads();
  if (threadIdx.x == 0) (void)xb_add(&((unsigned*)(p.ws + OFF_BAR))[XB_XCNT(xb_xcc_id())], 1u);
  phase0(p, smem);
  grid.sync();
#pragma unroll 1
  for (int layer = 0; layer < DEPTH; ++layer) {
#pragma unroll 1
    for (int grp = 0; grp < 2; ++grp) {
      int ly = layer, gp = grp;
      asm volatile("" : "+s"(ly), "+s"(gp));
      p1a(p, ly, gp, smem);
      xcd_barrier(p.ws, xb_words);
      asm volatile("" : "+s"(ly), "+s"(gp));
      p1b(p, ly, gp, smem);
      xcd_barrier(p.ws, xb_words);
      asm volatile("" : "+s"(ly), "+s"(gp));
      p2(p, ly, gp, smem, &s_item);
      xcd_barrier(p.ws, xb_words);
      asm volatile("" : "+s"(ly), "+s"(gp));
      p3a(p, ly, gp, smem);
      xcd_barrier(p.ws, xb_words);
      asm volatile("" : "+s"(ly), "+s"(gp));
      p3b(p, ly, gp, smem);
      xcd_barrier(p.ws, xb_words);
    }
  }
  final_norm(p);
}

extern "C" void kernel_launch(void* const* d_in, const int* in_sizes, int n_in, void* d_out, int out_size, void* d_ws,
                              size_t ws_size, hipStream_t stream) {
  static int grid_blocks = 0;
  if (!grid_blocks) {
    int dev = 0, cus = 0, per_cu = 0;
    hipGetDevice(&dev);
    hipDeviceGetAttribute(&cus, hipDeviceAttributeMultiprocessorCount, dev);
    hipOccupancyMaxActiveBlocksPerMultiprocessor(&per_cu, mega, 512, 0);
    if (per_cu < 1) per_cu = 1;
    if (per_cu > 1) per_cu = 1;
    grid_blocks = cus * per_cu;
  }
  Params p{};
  const float** pp = (const float**)&p;
  for (int i = 0; i < 27; ++i) pp[i] = (const float*)d_in[i];
  p.out = (float*)d_out;
  p.ws = (char*)d_ws;
  if (ws_size < WS_NEEDED) fprintf(stderr, "workspace too small: %zu < %zu\n", ws_size, (size_t)WS_NEEDED);
  hipMemsetAsync(d_ws, 0, ZERO_BYTES, stream);
  void* args[] = {&p};
  hipError_t e = hipLaunchCooperativeKernel((void*)mega, dim3(grid_blocks), dim3(512), args, 0, stream);
  if (e != hipSuccess) fprintf(stderr, "cooperative launch failed: %s (grid %d)\n", hipGetErrorString(e), grid_blocks);
}
```

```cpp
#include <hip/hip_runtime.h>
#include <hip/hip_cooperative_groups.h>
#include <cstdio>
namespace cg = cooperative_groups;

#define DI __device__ __forceinline__
typedef unsigned short bf16;
typedef __attribute__((ext_vector_type(8))) short bf16x8;
typedef __attribute__((ext_vector_type(4))) short bf16x4;
typedef __attribute__((ext_vector_type(16))) float f32x16;
typedef __attribute__((ext_vector_type(4))) unsigned u32x4;
typedef __attribute__((ext_vector_type(4))) float f32x4v;
#define MFMA(a, b, c) __builtin_amdgcn_mfma_f32_32x32x16_bf16((a), (b), (c), 0, 0, 0)

constexpr int DM = 1024;
constexpr int DEPTH = 4;
constexpr int T_CTX = 8192;
constexpr int T_ALL = 40960;
constexpr int TG = 24576;
constexpr int IN_DIM = 5376;
constexpr float LOG2E = 1.4426950408889634f;

constexpr size_t OFF_MODS = 0;
constexpr size_t OFF_FSUM = 458752;
constexpr size_t OFF_CTR = 491520;
constexpr size_t OFF_BAR = 495616;
constexpr size_t ZERO_BYTES = 524288;
constexpr size_t OFF_ROPE = ZERO_BYTES;
constexpr size_t OFF_W = OFF_ROPE + 1048576;
constexpr size_t W_IN = 0, W_MG = 5505024, W_A = 8650752, W_B = 9175040, W_C = 9699328, W_O = 10223616, W_LAYER = 11272192;
constexpr size_t OFF_GL = OFF_W + W_LAYER * 2 * 4;
constexpr size_t OFF_GC = OFF_GL + 33554432;
constexpr size_t OFF_H = OFF_GC + 2097152;
constexpr size_t OFF_HYT = OFF_H + (size_t)TG * 2048;
constexpr size_t OFF_AQ = OFF_HYT + (size_t)TG * 4096;
constexpr size_t OFF_AK = OFF_AQ + (size_t)TG * 1024;
constexpr size_t OFF_AV = OFF_AK + (size_t)TG * 256;
constexpr size_t OFF_AG = OFF_AV + (size_t)TG * 256;
constexpr size_t OFF_RQ = OFF_AG + (size_t)TG * 1024;
constexpr size_t OFF_RK = OFF_RQ + (size_t)TG * 1024;
constexpr size_t OFF_RV = OFF_RK + (size_t)TG * 1024;
constexpr size_t OFF_RG = OFF_RV + (size_t)TG * 1024;
constexpr size_t OFF_YA = OFF_RG + (size_t)TG * 1024;
constexpr size_t OFF_OFB = OFF_YA + (size_t)TG * 1024;
constexpr size_t WS_NEEDED = OFF_OFB + (size_t)TG * 1024;
constexpr size_t OFF_MERGED = OFF_RQ;

constexpr size_t OUT_CK = 41943040, OUT_CV = 46137344, OUT_ST = 50331648;

constexpr int SMEM_BYTES = 135168;

struct Params {
  const float *x_prompt, *x_sample, *c, *cache_k, *cache_v, *state_ret, *c_ctx, *norm_w, *w_mod, *b_mod, *w_in, *hy_conv,
      *hy_w1, *hy_b1, *hy_freq, *hy_w2, *hy_skip, *attn_sink, *ret_theta, *ret_gn, *w_a, *w_b, *w_c, *w_merge, *b_merge,
      *w_out, *final_w;
  float* out;
  char* ws;
};

DI bf16 f2bf(float x) {
  __bf16 b = (__bf16)x;
  return __builtin_bit_cast(unsigned short, b);
}
DI float bf2f(bf16 u) { return __uint_as_float(((unsigned)u) << 16); }
DI int crow(int reg, int h) { return (reg & 3) + 8 * (reg >> 2) + 4 * h; }
DI float siluf(float x) { return x / (1.f + __expf(-x)); }
DI float sigmf(float x) { return 1.f / (1.f + __expf(-x)); }
DI bf16x8 pack8(const f32x16& x, int s) {
  bf16x8 r;
#pragma unroll
  for (int j = 0; j < 8; ++j) r[j] = (short)f2bf(x[8 * s + j]);
  return r;
}
DI f32x16 zero16() {
  f32x16 z;
#pragma unroll
  for (int i = 0; i < 16; ++i) z[i] = 0.f;
  return z;
}
DI const float* launder(const float* q) {
  asm volatile("" : "+s"(q));
  return q;
}
DI int otid() {
  int t = threadIdx.x;
  asm volatile("" : "+v"(t));
  return t;
}
DI int cond_of(int tg) { return tg < T_CTX ? 0 : 1 + ((tg - T_CTX) >> 12); }

DI void lds_barrier() { asm volatile("s_waitcnt lgkmcnt(0)\n\ts_barrier" ::: "memory"); }

struct GemmSrc {
  const bf16* A;
  const bf16* B;
  int lda, ldb, atr;
};
DI GemmSrc mksrc(const bf16* A, int lda, const bf16* B, int ldb, int atr) {
  GemmSrc g;
  g.A = A; g.B = B; g.lda = lda; g.ldb = ldb; g.atr = atr;
  return g;
}
template <int NI>
DI void gemm_issue(const GemmSrc& g, int kt, int tid, u32x4 (&ra)[4], u32x4 (&rb)[NI]) {
  const int lrow = tid >> 3, lkc = (tid & 7) * 8;
  const bf16* ab = g.atr ? g.A + (size_t)((tid & 63) + kt * 64) * g.lda + (tid >> 6) * 8
                         : g.A + (size_t)lrow * g.lda + lkc + kt * 64;
  const size_t astep = g.atr ? (size_t)64 : (size_t)64 * g.lda;
#pragma unroll
  for (int i = 0; i < 4; ++i) ra[i] = *(const u32x4*)(ab + astep * i);
  const bf16* bb = g.B + (size_t)lrow * g.ldb + lkc + kt * 64;
#pragma unroll
  for (int i = 0; i < NI; ++i) rb[i] = *(const u32x4*)(bb + (size_t)(64 * i) * g.ldb);
}
template <int NI, bool ATR>
DI void gemm_stage(bf16* As, bf16* Bs, int tid, const u32x4 (&ra)[4], const u32x4 (&rb)[NI]) {
  constexpr int PITCH = 72;
  const int lrow = tid >> 3, lkc = (tid & 7) * 8;
#pragma unroll
  for (int i = 0; i < 4; ++i) {
    if (ATR) {
      bf16* d = As + (((tid >> 6) + 8 * i) * 8) * PITCH + (tid & 63);
      const bf16x8 v = __builtin_bit_cast(bf16x8, ra[i]);
#pragma unroll
      for (int e = 0; e < 8; ++e) d[e * PITCH] = (bf16)v[e];
    } else {
      *(u32x4*)(As + (lrow + 64 * i) * PITCH + lkc) = ra[i];
    }
  }
#pragma unroll
  for (int i = 0; i < NI; ++i) *(u32x4*)(Bs + (lrow + 64 * i) * PITCH + lkc) = rb[i];
}

template <int NI, bool ATR>
DI void gemm_stage_part(bf16* As, bf16* Bs, int tid, const u32x4 (&ra)[4], const u32x4 (&rb)[NI], int part) {
  constexpr int PITCH = 72;
  const int lrow = tid >> 3, lkc = (tid & 7) * 8;
#pragma unroll
  for (int i = 0; i < 4; ++i) {
    if (i != part) continue;
    if (ATR) {
      bf16* d = As + (((tid >> 6) + 8 * i) * 8) * PITCH + (tid & 63);
      const bf16x8 v = __builtin_bit_cast(bf16x8, ra[i]);
#pragma unroll
      for (int e = 0; e < 8; ++e) d[e * PITCH] = (bf16)v[e];
    } else {
      *(u32x4*)(As + (lrow + 64 * i) * PITCH + lkc) = ra[i];
    }
  }
#pragma unroll
  for (int i = 0; i < NI; ++i)
    if (2 * i == part) *(u32x4*)(Bs + (lrow + 64 * i) * PITCH + lkc) = rb[i];
}

template <int NI, bool ATR>
DI void gemm_main(const GemmSrc& cur, int K, f32x16 (&acc)[2][NI], char* smem, u32x4 (&ra)[2][4], u32x4 (&rb)[2][NI],
                  bool preloaded, const GemmSrc& nxt, bool has_next) {
  constexpr int BN = 64 * NI;
  constexpr int PITCH = 72;
  bf16* As = (bf16*)smem;
  bf16* Bs = As + 2 * 256 * PITCH;
  const int tid = otid(), lane = tid & 63, wave = tid >> 6;
  const int wm = wave >> 1, wn = wave & 1, r = lane & 31, h = lane >> 5;
  const int nk = K / 64;
  if (!preloaded) {
    gemm_issue<NI>(cur, 0, tid, ra[0], rb[0]);
    gemm_issue<NI>(cur, 1, tid, ra[1], rb[1]);
  }
  lds_barrier();
  gemm_stage<NI, ATR>(As, Bs, tid, ra[0], rb[0]);
  lds_barrier();
#pragma unroll 1
  for (int kt = 0; kt < nk; kt += 2) {
#pragma unroll
    for (int u = 0; u < 2; ++u) {
      const int k = kt + u;
      {
        const bool inr = k + 2 < nk;
        GemmSrc g = (inr || !has_next) ? cur : nxt;
        const int kk = inr ? k + 2 : (has_next ? k + 2 - nk : nk - 1);
        gemm_issue<NI>(g, kk, tid, ra[u], rb[u]);
      }
      const bf16* Ab = As + u * 256 * PITCH + (wm * 64 + r) * PITCH + h * 8;
      const bf16* Bb = Bs + u * BN * PITCH + (wn * 32 * NI + r) * PITCH + h * 8;
#pragma unroll
      for (int ks = 0; ks < 4; ++ks) {
        bf16x8 a[2], b[NI];
#pragma unroll
        for (int mi = 0; mi < 2; ++mi) a[mi] = *(const bf16x8*)(Ab + mi * 32 * PITCH + ks * 16);
#pragma unroll
        for (int ni = 0; ni < NI; ++ni) b[ni] = *(const bf16x8*)(Bb + ni * 32 * PITCH + ks * 16);
#pragma unroll
        for (int mi = 0; mi < 2; ++mi)
#pragma unroll
          for (int ni = 0; ni < NI; ++ni) acc[mi][ni] = MFMA(a[mi], b[ni], acc[mi][ni]);
        gemm_stage_part<NI, ATR>(As + (u ^ 1) * 256 * PITCH, Bs + (u ^ 1) * BN * PITCH, tid, ra[u ^ 1], rb[u ^ 1], ks);
      }
      lds_barrier();
    }
  }
}

DI void p0_mod_item(const Params& p, int item, char* smem) {
  const int tid = otid();
  const int l = item / 48, rem = item % 48, nch = rem / 8, ks = rem % 8;
  float* sc = (float*)smem;
  __syncthreads();
  for (int idx = tid; idx < 9 * 128; idx += 512) {
    const int cnd = idx >> 7, k = ks * 128 + (idx & 127);
    const float *qcc = launder(p.c_ctx), *qc = launder(p.c);
    const float v = cnd == 0 ? qcc[k] : qc[(cnd - 1) * 1024 + k];
    sc[idx] = v / (1.f + expf(-v));
  }
  __syncthreads();
  const int n = nch * 512 + tid;
  float acc[9];
#pragma unroll
  for (int i = 0; i < 9; ++i) acc[i] = 0.f;
  const float* w = p.w_mod + ((size_t)l * 1024 + ks * 128) * 3072 + n;
#pragma unroll 16
  for (int kk = 0; kk < 128; ++kk) {
    const float wv = w[(size_t)kk * 3072];
#pragma unroll
    for (int i = 0; i < 9; ++i) acc[i] += sc[i * 128 + kk] * wv;
  }
  float* mods = (float*)(p.ws + OFF_MODS);
  const float bias = ks == 0 ? p.b_mod[l * 3072 + n] : 0.f;
#pragma unroll
  for (int i = 0; i < 9; ++i) atomicAdd(&mods[(l * 9 + i) * 3072 + n], acc[i] + bias);
}

DI void transpose_tile(const float* __restrict__ src, int ldn, bf16* __restrict__ dst, int ldk, int k0, int n0, char* smem) {
  float* T = (float*)smem;
  const int tid = otid();
  __syncthreads();
  {
    const int k = tid >> 3, nc = (tid & 7) * 8;
    const float* s = src + (size_t)(k0 + k) * ldn + n0 + nc;
    const float4 a = *(const float4*)s, b = *(const float4*)(s + 4);
    float* t = T + k * 65 + nc;
    t[0] = a.x; t[1] = a.y; t[2] = a.z; t[3] = a.w; t[4] = b.x; t[5] = b.y; t[6] = b.z; t[7] = b.w;
  }
  __syncthreads();
  {
    const int n = tid >> 3, kc = (tid & 7) * 8;
    bf16x8 v;
#pragma unroll
    for (int j = 0; j < 8; ++j) v[j] = (short)f2bf(T[(kc + j) * 65 + n]);
    *(bf16x8*)(dst + (size_t)(n0 + n) * ldk + k0 + kc) = v;
  }
}

DI void p0_transpose_item(const Params& p, int item, char* smem) {
  const int l = item / 2752;
  int rem = item % 2752;
  bf16* wl = (bf16*)(p.ws + OFF_W) + (size_t)l * W_LAYER;
  if (rem < 1344) {
    const int kt = rem / 84, nt = rem % 84;
    transpose_tile(p.w_in + (size_t)l * 1024 * IN_DIM, IN_DIM, wl + W_IN, 1024, kt * 64, nt * 64, smem);
    return;
  }
  rem -= 1344;
  if (rem < 768) {
    const int kt = rem / 48, nt = rem % 48;
    transpose_tile(p.w_merge + (size_t)l * 1024 * 3072, 3072, wl + W_MG, 1024, kt * 64, nt * 64, smem);
    return;
  }
  rem -= 768;
  if (rem < 384) {
    const int br = rem / 128, r2 = rem % 128, kt = r2 / 16, nt = r2 % 16;
    const float *qa = launder(p.w_a), *qb = launder(p.w_b), *qc = launder(p.w_c);
    const float* src = (br == 0 ? qa : br == 1 ? qb : qc) + (size_t)l * 512 * 1024;
    transpose_tile(src, 1024, wl + (br == 0 ? W_A : br == 1 ? W_B : W_C), 512, kt * 64, nt * 64, smem);
    return;
  }
  rem -= 384;
  {
    const int kt = rem / 16, nt = rem % 16;
    transpose_tile(p.w_out + (size_t)l * 1024 * 1024, 1024, wl + W_O, 1024, kt * 64, nt * 64, smem);
  }
}

DI void p0_rope_item(const Params& p, int item) {
  const int idx = item * 512 + otid();
  const int t = idx >> 5, f = idx & 31;
  const float inv = powf(10000.f, -(float)(f & 15) / 16.f);
  const float ang = (float)(f < 16 ? (t >> 6) : (t & 63)) * inv;
  float2 cs;
  cs.x = cosf(ang);
  cs.y = sinf(ang);
  ((float2*)(p.ws + OFF_ROPE))[idx] = cs;
}

DI void phase0(const Params& p, char* smem) {
  const int n_mod = 192, n_tr = 11008, n_rope = 256;
  for (int it = blockIdx.x; it < n_mod + n_tr + n_rope; it += gridDim.x) {
    if (it < n_mod) p0_mod_item(p, it, smem);
    else if (it < n_mod + n_tr) p0_transpose_item(p, it - n_mod, smem);
    else p0_rope_item(p, it - n_mod - n_tr);
  }
}

DI void filter_item(const Params& p, int layer, int item, char* smem) {
  const int tid = otid();
  int var, pc, cc, L;
  if (item < 512) { var = 0; pc = item >> 3; cc = item & 7; L = 4096; }
  else { var = 1; pc = (item - 512) >> 3; cc = (item - 512) & 7; L = 256; }
  float* z = (float*)smem;
  float* hid = z + 64 * 17;
  float* w2s = hid + 64 * 65;
  __syncthreads();
  {
    const int pos = tid >> 3, band = tid & 7;
    const int pa = pc * 64 + pos;
    const float w = 6.283185307179586f * (float)pa / (float)L;
    const float f = 1e-4f + (float)band * ((7.f - 1e-4f) / 7.f);
    z[pos * 17 + 1 + band] = cosf(f * w);
    z[pos * 17 + 9 + band] = -sinf(f * w);
    if (band == 0) z[pos * 17] = (float)pa / (float)(L - 1);
  }
  __syncthreads();
  {
    const int pos = tid >> 3, j0 = (tid & 7) * 8;
    const float* w1 = p.hy_w1 + layer * 17 * 64;
#pragma unroll
    for (int jj = 0; jj < 8; ++jj) {
      const int j = j0 + jj;
      float pre = p.hy_b1[layer * 64 + j];
      for (int f = 0; f < 17; ++f) pre += z[pos * 17 + f] * w1[f * 64 + j];
      hid[pos * 65 + j] = sinf(p.hy_freq[layer * 64 + j] * pre);
    }
    const float* w2 = p.hy_w2 + (size_t)layer * 64 * 2048 + cc * 256;
    for (int idx = tid; idx < 64 * 256; idx += 512) w2s[idx] = w2[(idx >> 8) * 2048 + (idx & 255)];
  }
  __syncthreads();
  {
    const int lane = tid & 63, wave = tid >> 6, r = lane & 31, hh = lane >> 5;
    f32x16 acc[2];
    acc[0] = zero16();
    acc[1] = zero16();
#pragma unroll 4
    for (int ks = 0; ks < 32; ++ks) {
      const float bv = w2s[(2 * ks + hh) * 256 + wave * 32 + r];
#pragma unroll
      for (int mi = 0; mi < 2; ++mi) {
        const float av = hid[(mi * 32 + r) * 65 + 2 * ks + hh];
        acc[mi] = __builtin_amdgcn_mfma_f32_32x32x2f32(av, bv, acc[mi], 0, 0, 0);
      }
    }
    const int n = cc * 256 + wave * 32 + r;
    const int o = n >> 10, dir = (n >> 9) & 1, c = n & 511;
    const float min_d = -3.0701134573253945f, max_d = -15.350567286626973f;
    const float ad = fabsf(min_d + (float)c * ((max_d - min_d) / 511.f));
    float* g = (float*)(p.ws + (var == 0 ? OFF_GL : OFF_GC)) + ((size_t)(o * 512 + c)) * (2 * L);
    float asum = 0.f;
#pragma unroll
    for (int mi = 0; mi < 2; ++mi)
#pragma unroll
      for (int i = 0; i < 16; ++i) {
        const int pa = pc * 64 + mi * 32 + crow(i, hh);
        const float t = (float)pa / (float)(L - 1);
        const float v = acc[mi][i] * expf(-t * ad);
        asum += fabsf(v);
        int y;
        if (dir == 0) y = L - pa;
        else y = (pa == 0) ? 0 : L + pa;
        g[y] = v;
      }
    atomicAdd((float*)(p.ws + OFF_FSUM) + ((layer * 2 + var) * 2 + o) * 512 + c, asum);
  }
}

DI void p1a(const Params& p, int layer, int grp, char* smem) {
  const int g0 = grp ? TG : 0, tgn = grp ? 16384 : TG;
  const int nfilt = grp ? 0 : 544;
  const int nrow_items = tgn / 8;
  const int tid_ = otid();
  const int lane = tid_ & 63, wave = tid_ >> 6;
  bf16* H = (bf16*)(p.ws + OFF_H);
  const float* mods = (const float*)(p.ws + OFF_MODS);
  for (int it = blockIdx.x; it < nfilt + nrow_items; it += gridDim.x) {
    if (it < nfilt) { filter_item(p, layer, it, smem); continue; }
    const int tl = (it - nfilt) * 8 + wave, tg = g0 + tl;
    const float *qxp = launder(p.x_prompt), *qxs = launder(p.x_sample), *qo = launder(p.out);
    const float* x = layer == 0 ? (tg < T_CTX ? qxp + (size_t)tg * DM : qxs + (size_t)(tg - T_CTX) * DM) : qo + (size_t)tg * DM;
    float4 v[4];
    float ss = 0.f;
#pragma unroll
    for (int i = 0; i < 4; ++i) {
      v[i] = *(const float4*)(x + (lane + 64 * i) * 4);
      ss += v[i].x * v[i].x + v[i].y * v[i].y + v[i].z * v[i].z + v[i].w * v[i].w;
    }
#pragma unroll
    for (int o = 32; o > 0; o >>= 1) ss += __shfl_xor(ss, o);
    const float rstd = rsqrtf(ss * (1.f / 1024.f) + 1e-6f);
    const float* md = mods + (layer * 9 + cond_of(tg)) * 3072;
    const float* nw = p.norm_w + layer * 1024;
#pragma unroll
    for (int i = 0; i < 4; ++i) {
      const int col = (lane + 64 * i) * 4;
      const float4 sh = *(const float4*)(md + col), sc = *(const float4*)(md + 1024 + col), w = *(const float4*)(nw + col);
      bf16x4 o;
      o[0] = (short)f2bf(v[i].x * rstd * w.x * (1.f + sc.x) + sh.x);
      o[1] = (short)f2bf(v[i].y * rstd * w.y * (1.f + sc.y) + sh.y);
      o[2] = (short)f2bf(v[i].z * rstd * w.z * (1.f + sc.z) + sh.z);
      o[3] = (short)f2bf(v[i].w * rstd * w.w * (1.f + sc.w) + sh.w);
      *(bf16x4*)(H + (size_t)tl * 1024 + col) = o;
    }
  }
}

DI void p1b(const Params& p, int layer, int grp, char* smem) {
  const int g0 = grp ? TG : 0, tgn = grp ? 16384 : TG;
  const int mtiles = tgn / 256, ntot = mtiles * 42;
  const int tid = otid(), lane = tid & 63, wave = tid >> 6;
  const int wm = wave >> 1, wn = wave & 1, r = lane & 31, h = lane >> 5;
  const bf16* H = (const bf16*)(p.ws + OFF_H);
  const bf16* WinT = (const bf16*)(p.ws + OFF_W) + (size_t)layer * W_LAYER + W_IN;
  float* S = (float*)smem;
  u32x4 ra[2][4], rb[2][2];
  bool pre = false;
  for (int id = blockIdx.x; id < ntot; id += gridDim.x) {
    const int band = id / (16 * 42), rem = id % (16 * 42);
    const int mt = band * 16 + (rem & 15), nt = rem >> 4;
    const int idn = id + gridDim.x;
    const bool hn = idn < ntot;
    const int bandn = idn / (16 * 42), remn = idn % (16 * 42);
    const int mtn = bandn * 16 + (remn & 15), ntn = remn >> 4;
    f32x16 acc[2][2];
#pragma unroll
    for (int a = 0; a < 2; ++a)
#pragma unroll
      for (int b = 0; b < 2; ++b) acc[a][b] = zero16();
    gemm_main<2, false>(mksrc(H + (size_t)mt * 256 * 1024, 1024, WinT + (size_t)nt * 128 * 1024, 1024, 0), 1024, acc, smem, ra, rb, pre,
                        mksrc(H + (size_t)mtn * 256 * 1024, 1024, WinT + (size_t)ntn * 128 * 1024, 1024, 0), hn);
    pre = true;
    const int m0 = mt * 256, tg0 = g0 + m0;
    const bool lat = tg0 >= T_CTX;
    if (nt < 16) {
#pragma unroll
      for (int mi = 0; mi < 2; ++mi)
#pragma unroll
        for (int ni = 0; ni < 2; ++ni)
#pragma unroll
          for (int g4 = 0; g4 < 4; ++g4) {
            f32x4v v;
#pragma unroll
            for (int j = 0; j < 4; ++j) v[j] = acc[mi][ni][4 * g4 + j];
            *(f32x4v*)(S + (wn * 64 + ni * 32 + r) * 260 + wm * 64 + mi * 32 + 8 * g4 + 4 * h) = v;
          }
      __syncthreads();
      const int part = nt >> 2;
#pragma unroll 2
      for (int it = 0; it < 8; ++it) {
        const int pid = tid + 512 * it, cl = pid >> 5, q = pid & 31;
        const f32x4v a = *(const f32x4v*)(S + cl * 260 + q * 8), b = *(const f32x4v*)(S + cl * 260 + q * 8 + 4);
        bf16x8 v;
#pragma unroll
        for (int j = 0; j < 4; ++j) {
          v[j] = (short)f2bf(a[j]);
          v[4 + j] = (short)f2bf(b[j]);
        }
        *(bf16x8*)((bf16*)(p.ws + OFF_HYT) + ((size_t)(part * 512 + (nt & 3) * 128 + cl)) * TG + m0 + q * 8) = v;
      }
    } else {
#pragma unroll
      for (int mi = 0; mi < 2; ++mi)
#pragma unroll
        for (int ni = 0; ni < 2; ++ni)
#pragma unroll
          for (int i = 0; i < 16; ++i) S[(wm * 64 + mi * 32 + crow(i, h)) * 132 + wn * 64 + ni * 32 + r] = acc[mi][ni][i];
      __syncthreads();
      size_t off; int pitch, coloff; bool rope = false; int cache = 0;
      if (nt < 20) { off = OFF_AQ; pitch = 512; coloff = (nt - 16) * 128; rope = lat; }
      else if (nt == 20) { off = OFF_AK; pitch = 128; coloff = 0; rope = lat; cache = lat ? 0 : 1; }
      else if (nt == 21) { off = OFF_AV; pitch = 128; coloff = 0; cache = lat ? 0 : 2; }
      else if (nt < 26) { off = OFF_AG; pitch = 512; coloff = (nt - 22) * 128; }
      else if (nt < 30) { off = OFF_RQ; pitch = 512; coloff = (nt - 26) * 128; rope = lat; }
      else if (nt < 34) { off = OFF_RK; pitch = 512; coloff = (nt - 30) * 128; rope = lat; }
      else if (nt < 38) { off = OFF_RV; pitch = 512; coloff = (nt - 34) * 128; }
      else { off = OFF_RG; pitch = 512; coloff = (nt - 38) * 128; }
      bf16* dst = (bf16*)(p.ws + off);
      const float2* rt = (const float2*)(p.ws + OFF_ROPE);
#pragma unroll 2
      for (int it = 0; it < 8; ++it) {
        const int cid = tid + 512 * it, row = cid >> 4, cc = cid & 15;
        const float* sp = S + row * 132 + cc * 8;
        float v[8];
#pragma unroll
        for (int j = 0; j < 8; ++j) v[j] = sp[j];
        if (cache) {
          float* co = p.out + (cache == 1 ? OUT_CK : OUT_CV) + ((size_t)((tg0 >> 8) * 4 + layer) * 256 + row) * 128 + cc * 8;
          *(float4*)co = make_float4(v[0], v[1], v[2], v[3]);
          *(float4*)(co + 4) = make_float4(v[4], v[5], v[6], v[7]);
        }
        if (rope) {
          const int hd0 = (cc * 8) & 63, q = hd0 >> 4;
          const int tpos = (tg0 - T_CTX + row) & 4095;
          const float2* tb = rt + tpos * 32 + (q >> 1) * 16 + (hd0 & 15);
          const float* pp = sp + ((q & 1) ? -16 : 16);
          const float sg = (q & 1) ? 1.f : -1.f;
#pragma unroll
          for (int j = 0; j < 8; ++j) {
            const float2 cs = tb[j];
            v[j] = v[j] * cs.x + sg * pp[j] * cs.y;
          }
        }
        bf16x8 o;
#pragma unroll
        for (int j = 0; j < 8; ++j) o[j] = (short)f2bf(v[j]);
        *(bf16x8*)(dst + (size_t)(m0 + row) * pitch + coloff + cc * 8) = o;
      }
    }
  }
}

template <int NBT, int L>
DI void hyena_item(const Params& p, int layer, int var, int tlbase, int c, char* smem) {
  constexpr int NP = 32 / NBT, NT = (L / 8) / (32 * NP), UP = L + 8;
  bf16* U = (bf16*)smem;
  bf16* X1 = U + NBT * UP;
  bf16* X2 = X1 + NBT * UP;
  bf16* GR = X2 + NBT * UP;
  bf16* GR1 = GR + 2 * L + 8;
  const int tid = otid(), lane = tid & 63, wave = tid >> 6;
  const int n = lane & 31, hh = lane >> 5, b = n & (NBT - 1), pp = n / NBT;
  const bf16* hyT = (const bf16*)(p.ws + OFF_HYT);
  const float* fs = (const float*)(p.ws + OFF_FSUM) + (layer * 2 + var) * 1024;
  const float* gsrc = (const float*)(p.ws + (var == 0 ? OFF_GL : OFF_GC));
  __syncthreads();
#pragma unroll 1
  for (int part = 0; part < 3; ++part) {
    const bf16* src = hyT + ((size_t)(part * 512 + c)) * TG + tlbase;
    bf16* dstb = part == 0 ? U : part == 1 ? X1 : X2;
    const float w0 = p.hy_conv[(layer * 3 + 0) * 1536 + part * 512 + c];
    const float w1 = p.hy_conv[(layer * 3 + 1) * 1536 + part * 512 + c];
    const float w2 = p.hy_conv[(layer * 3 + 2) * 1536 + part * 512 + c];
#pragma unroll
    for (int it = 0; it < NBT * L / 8 / 512; ++it) {
      const int id = tid + 512 * it;
      const int bb = id / (L / 8), t8 = (id % (L / 8)) * 8;
      const bf16* s = src + bb * L + t8;
      const bf16x8 xv = *(const bf16x8*)s;
      float x[10];
      x[0] = t8 > 0 ? bf2f(s[-1]) : 0.f;
      x[9] = t8 + 8 < L ? bf2f(s[8]) : 0.f;
#pragma unroll
      for (int j = 0; j < 8; ++j) x[j + 1] = bf2f((bf16)xv[j]);
      bf16x8 o;
#pragma unroll
      for (int j = 0; j < 8; ++j) o[j] = (short)f2bf(w0 * x[j] + w1 * x[j + 1] + w2 * x[j + 2]);
      *(bf16x8*)(dstb + bb * UP + t8) = o;
    }
  }
  const int wbase = wave * (L / 8);
  const int dmin = -(wbase + (NT - 1) * 32 * NP + 32 * (NP - 1)), dmax = L - 16 - wbase;
  f32x16 acc[NT];
#pragma unroll 1
  for (int o = 0; o < 2; ++o) {
    {
      const float inv = 1.f / fs[o * 512 + c];
      const float* gs = gsrc + ((size_t)(o * 512 + c)) * (2 * L);
      const float skip = p.hy_skip[(layer * 2 + o) * 512 + c];
#pragma unroll 8
      for (int y = tid; y < 2 * L; y += 512) {
        float v = gs[y] * inv;
        if (y == L) v = (gs[L] + gs[0]) * inv + skip;
        if (y == 0) v = 0.f;
        const bf16 bv = f2bf(v);
        GR[y] = bv;
        if (y > 0) GR1[y - 1] = bv;
      }
      if (tid == 0) GR1[2 * L - 1] = 0;
    }
    __syncthreads();
#pragma unroll
    for (int q = 0; q < NT; ++q) acc[q] = zero16();
#pragma unroll 1
    for (int d = dmin; d <= dmax; d += 16) {
      const unsigned* gp = (const unsigned*)(((n & 1) ? GR1 - 1 : GR) + (L - n + d + 8 * hh));
      typedef __attribute__((ext_vector_type(4))) unsigned u4;
      u4 aw;
#pragma unroll
      for (int j = 0; j < 4; ++j) aw[j] = gp[j];
      const bf16x8 a = __builtin_bit_cast(bf16x8, aw);
#pragma unroll
      for (int q = 0; q < NT; ++q) {
        const int s0 = wbase + q * 32 * NP + 32 * pp + d;
        bf16x8 bb;
#pragma unroll
        for (int j = 0; j < 8; ++j) bb[j] = 0;
        if (s0 >= 0 && s0 <= L - 16) bb = *(const bf16x8*)(U + b * UP + s0 + 8 * hh);
        acc[q] = MFMA(a, bb, acc[q]);
      }
    }
    __syncthreads();
    if (o == 0) {
#pragma unroll
      for (int q = 0; q < NT; ++q)
#pragma unroll
        for (int i = 0; i < 16; ++i) {
          const int t = wbase + q * 32 * NP + 32 * pp + crow(i, hh);
          U[b * UP + t] = f2bf(bf2f(X1[b * UP + t]) * acc[q][i]);
        }
    } else {
      const bf16* gate = hyT + ((size_t)(3 * 512 + c)) * TG + tlbase;
#pragma unroll
      for (int q = 0; q < NT; ++q)
#pragma unroll
        for (int g4 = 0; g4 < 4; ++g4) {
          const int t = wbase + q * 32 * NP + 32 * pp + 8 * g4 + 4 * hh;
          const bf16x4 gv = *(const bf16x4*)(gate + b * L + t);
          bf16x4 ov;
#pragma unroll
          for (int j = 0; j < 4; ++j)
            ov[j] = (short)f2bf(bf2f(X2[b * UP + t + j]) * acc[q][4 * g4 + j] * siluf(bf2f((bf16)gv[j])));
          *(bf16x4*)(U + b * UP + t) = ov;
        }
      __syncthreads();
      bf16* yat = (bf16*)(p.ws + OFF_YA) + (size_t)c * TG + tlbase;
      for (int id = tid; id < NBT * L / 8; id += 512) {
        const int bb = id / (L / 8), t8 = (id % (L / 8)) * 8;
        *(bf16x8*)(yat + bb * L + t8) = *(const bf16x8*)(U + bb * UP + t8);
      }
    }
  }
}

DI void attn_item(const Params& p, int layer, bool lat, int tlbase, int bglob, int kvh, int qblk, char* smem) {
  bf16* Ks = (bf16*)smem;
  bf16* VT = Ks + 64 * 72;
  const int tid = otid(), lane = tid & 63, wave = tid >> 6;
  const int r = lane & 31, hh = lane >> 5;
  const int head = kvh * 4 + (wave >> 1);
  const int qi = qblk * 64 + (wave & 1) * 32 + r;
  const int tlq = tlbase + qi;
  const bf16* aq = (const bf16*)(p.ws + OFF_AQ);
  const bf16* ak = (const bf16*)(p.ws + OFF_AK);
  const bf16* av = (const bf16*)(p.ws + OFF_AV);
  bf16* ag = (bf16*)(p.ws + OFF_AG);
  bf16x8 bq[4];
#pragma unroll
  for (int ks = 0; ks < 4; ++ks) bq[ks] = *(const bf16x8*)(aq + (size_t)tlq * 512 + head * 64 + ks * 16 + hh * 8);
  const float sink2 = p.attn_sink[layer * 8 + head] * LOG2E;
  const float SC = 0.125f * LOG2E;
  float m = sink2, lsum = 0.f;
  f32x16 O[2];
  O[0] = zero16();
  O[1] = zero16();
  const int t_lo = lat ? (2 - qblk > 0 ? 2 - qblk : 0) : 0;
  const int t_hi = lat ? (65 - qblk < 4 ? 65 - qblk : 4) : 3;
  const int nw = t_hi - t_lo + 1;
  const int ntot = lat ? nw + 8 : nw;
  const int lj = tid >> 3, lkc = (tid & 7) * 8;
  u32x4 pr0, pr1, pr2, pr3;
  pr2 = u32x4{0, 0, 0, 0};
  pr3 = u32x4{0, 0, 0, 0};
  {
    const int kp = lat ? qblk * 64 - 128 + t_lo * 64 : 0;
    const size_t o = (size_t)(tlbase + kp + lj) * 128 + kvh * 64 + lkc;
    pr0 = *(const u32x4*)(ak + o);
    pr1 = *(const u32x4*)(av + o);
  }
#pragma unroll 1
  for (int n = 0; n < ntot; ++n) {
    const bool from_cache = lat && n >= nw;
    const bool window = lat && n < nw;
    const int kpos0 = from_cache ? (n - nw) * 64 : (lat ? qblk * 64 - 128 + (t_lo + n) * 64 : n * 64);
    lds_barrier();
    {
      bf16x8 kv, vv;
      if (from_cache) {
        const f32x4v k0 = __builtin_bit_cast(f32x4v, pr0), k1 = __builtin_bit_cast(f32x4v, pr1);
        const f32x4v v0 = __builtin_bit_cast(f32x4v, pr2), v1 = __builtin_bit_cast(f32x4v, pr3);
#pragma unroll
        for (int e = 0; e < 4; ++e) {
          kv[e] = (short)f2bf(k0[e]);
          kv[4 + e] = (short)f2bf(k1[e]);
          vv[e] = (short)f2bf(v0[e]);
          vv[4 + e] = (short)f2bf(v1[e]);
        }
      } else {
        kv = __builtin_bit_cast(bf16x8, pr0);
        vv = __builtin_bit_cast(bf16x8, pr1);
      }
      *(bf16x8*)(Ks + lj * 72 + lkc) = kv;
#pragma unroll
      for (int jj = 0; jj < 8; ++jj) VT[(lkc + jj) * 68 + lj] = (bf16)vv[jj];
    }
    lds_barrier();
    {
      const int nn = n + 1 < ntot ? n + 1 : n;
      if (lat && nn >= nw) {
        const size_t o = ((((size_t)bglob * 4 + layer) * 512 + (nn - nw) * 64 + lj) * 2 + kvh) * 64 + lkc;
        pr0 = *(const u32x4*)(p.cache_k + o);
        pr1 = *(const u32x4*)(p.cache_k + o + 4);
        pr2 = *(const u32x4*)(p.cache_v + o);
        pr3 = *(const u32x4*)(p.cache_v + o + 4);
      } else {
        const int kp = lat ? qblk * 64 - 128 + (t_lo + nn) * 64 : nn * 64;
        const size_t o = (size_t)(tlbase + kp + lj) * 128 + kvh * 64 + lkc;
        pr0 = *(const u32x4*)(ak + o);
        pr1 = *(const u32x4*)(av + o);
      }
    }
    f32x16 sc[2];
#pragma unroll
    for (int sub = 0; sub < 2; ++sub) {
      sc[sub] = zero16();
#pragma unroll
      for (int ks = 0; ks < 4; ++ks) {
        const bf16x8 a = *(const bf16x8*)(Ks + (sub * 32 + r) * 72 + ks * 16 + hh * 8);
        sc[sub] = MFMA(a, bq[ks], sc[sub]);
      }
    }
    float mx = -3.0e38f;
#pragma unroll
    for (int sub = 0; sub < 2; ++sub)
#pragma unroll
      for (int i = 0; i < 16; ++i) {
        float sv = sc[sub][i] * SC;
        if (window) {
          const int diff = qi - (kpos0 + sub * 32 + crow(i, hh));
          if (diff > 128 || diff < -128) sv = -1e30f;
        }
        sc[sub][i] = sv;
        mx = fmaxf(mx, sv);
      }
    mx = fmaxf(mx, __shfl_xor(mx, 32));
    const float mnew = fmaxf(m, mx);
    const float alpha = __builtin_amdgcn_exp2f(m - mnew);
    m = mnew;
    float ps = 0.f;
#pragma unroll
    for (int sub = 0; sub < 2; ++sub)
#pragma unroll
      for (int i = 0; i < 16; ++i) {
        sc[sub][i] = __builtin_amdgcn_exp2f(sc[sub][i] - m);
        ps += sc[sub][i];
      }
    lsum = lsum * alpha + ps;
    if (__builtin_amdgcn_ballot_w64(alpha != 1.f) != 0) {
#pragma unroll
      for (int i = 0; i < 16; ++i) {
        O[0][i] *= alpha;
        O[1][i] *= alpha;
      }
    }
#pragma unroll
    for (int sub = 0; sub < 2; ++sub)
#pragma unroll
      for (int st = 0; st < 2; ++st) {
        const bf16x8 pf = pack8(sc[sub], st);
#pragma unroll
        for (int mi = 0; mi < 2; ++mi) {
          const bf16* vp = VT + (mi * 32 + r) * 68 + sub * 32 + 16 * st + 4 * hh;
          const bf16x4 lo = *(const bf16x4*)vp, hi = *(const bf16x4*)(vp + 8);
          const bf16x8 va = __builtin_shufflevector(lo, hi, 0, 1, 2, 3, 4, 5, 6, 7);
          O[mi] = MFMA(va, pf, O[mi]);
        }
      }
  }
  const float ltot = lsum + __shfl_xor(lsum, 32) + exp2f(sink2 - m);
  const float inv = 1.f / ltot;
#pragma unroll
  for (int mi = 0; mi < 2; ++mi)
#pragma unroll
    for (int g4 = 0; g4 < 4; ++g4) {
      bf16* gp = ag + (size_t)tlq * 512 + head * 64 + mi * 32 + 8 * g4 + 4 * hh;
      const bf16x4 gv = *(const bf16x4*)gp;
      bf16x4 o;
#pragma unroll
      for (int j = 0; j < 4; ++j) o[j] = (short)f2bf(O[mi][4 * g4 + j] * inv * siluf(bf2f((bf16)gv[j])));
      *(bf16x4*)gp = o;
    }
}

DI void ret_item(const Params& p, int layer, bool lat, int NC, int tlbase, int bglob, int hd, char* smem) {
  const int tid = otid(), lane = tid & 63, wave = tid >> 6;
  const int dir = wave >> 2, w4 = wave & 3, r = lane & 31, hh = lane >> 5, dt = tid & 255;
  bf16* Ks = (bf16*)smem + dir * 31232;
  bf16* KdT = Ks + 128 * 72;
  bf16* VT = KdT + 64 * 136;
  bf16* ST = VT + 64 * 136;
  const bf16* rq = (const bf16*)(p.ws + OFF_RQ);
  const bf16* rk = (const bf16*)(p.ws + OFF_RK);
  const bf16* rv = (const bf16*)(p.ws + OFF_RV);
  bf16* rg = (bf16*)(p.ws + OFF_RG);
  bf16* ofb = (bf16*)(p.ws + OFF_OFB);
  const float theta = p.ret_theta[(layer * 2 + dir) * 8 + hd];
  const float lg2 = -log1pf(expf(-theta)) * LOG2E;
  const float cdec = exp2f(lg2 * 128.f);
  const int etile = w4 >> 1, dtile = w4 & 1;
  f32x16 Sacc;
  if (lat) {
    const float* s0 = p.state_ret + ((((size_t)bglob * 4 + layer) * 2 + dir) * 8 + hd) * 4096;
#pragma unroll
    for (int i = 0; i < 16; ++i) Sacc[i] = s0[(dtile * 32 + r) * 64 + etile * 32 + crow(i, hh)];
  } else {
    Sacc = zero16();
  }
  __syncthreads();
#pragma unroll
  for (int i = 0; i < 16; ++i) ST[(etile * 32 + crow(i, hh)) * 72 + dtile * 32 + r] = f2bf(Sacc[i]);
#pragma unroll 1
  for (int step = 0; step < NC; ++step) {
    const int ch = dir ? NC - 1 - step : step;
    const int tl0 = tlbase + ch * 128;
    const int iq = w4 * 32 + r, tlq = tl0 + iq;
    const bool second = step >= NC / 2;
    bf16x8 kv[4], vv[4], bq[4];
    bf16x4 pp[8], pg[8];
    const int jrow = dt & 127;
#pragma unroll
    for (int i = 0; i < 4; ++i) {
      const int kc = ((dt >> 7) + 2 * i) * 8;
      const size_t o = (size_t)(tl0 + jrow) * 512 + hd * 64 + kc;
      kv[i] = *(const bf16x8*)(rk + o);
      vv[i] = *(const bf16x8*)(rv + o);
    }
#pragma unroll
    for (int ks = 0; ks < 4; ++ks) bq[ks] = *(const bf16x8*)(rq + (size_t)tlq * 512 + hd * 64 + ks * 16 + hh * 8);
    if (second) {
#pragma unroll
      for (int mi = 0; mi < 2; ++mi)
#pragma unroll
        for (int g4 = 0; g4 < 4; ++g4) {
          const size_t o = (size_t)tlq * 512 + hd * 64 + mi * 32 + 8 * g4 + 4 * hh;
          pp[mi * 4 + g4] = *(const bf16x4*)(ofb + o);
          pg[mi * 4 + g4] = *(const bf16x4*)(rg + o);
        }
    } else {
#pragma unroll
      for (int i = 0; i < 8; ++i) {
        pp[i] = bf16x4{0, 0, 0, 0};
        pg[i] = bf16x4{0, 0, 0, 0};
      }
    }
    {
      const float kd = exp2f(lg2 * (float)(dir ? jrow : 127 - jrow)) * 0.125f;
#pragma unroll
      for (int i = 0; i < 4; ++i) {
        const int kc = ((dt >> 7) + 2 * i) * 8;
        *(bf16x8*)(Ks + jrow * 72 + kc) = kv[i];
#pragma unroll
        for (int jj = 0; jj < 8; ++jj) {
          KdT[(kc + jj) * 136 + jrow] = f2bf(bf2f((bf16)kv[i][jj]) * kd);
          VT[(kc + jj) * 136 + jrow] = (bf16)vv[i][jj];
        }
      }
    }
    __syncthreads();
    f32x16 O[2];
    {
      const float qd = exp2f(lg2 * (float)(dir ? 128 - iq : iq + 1));
#pragma unroll
      for (int mi = 0; mi < 2; ++mi) {
        f32x16 oc = zero16();
#pragma unroll
        for (int ks = 0; ks < 4; ++ks) {
          const bf16x8 a = *(const bf16x8*)(ST + (mi * 32 + r) * 72 + ks * 16 + hh * 8);
          oc = MFMA(a, bq[ks], oc);
        }
#pragma unroll
        for (int i = 0; i < 16; ++i) O[mi][i] = oc[i] * qd;
      }
    }
#pragma unroll 1
    for (int jt = 0; jt < 4; ++jt) {
      if (dir == 0 ? (jt <= w4) : (jt >= w4)) {
        f32x16 s = zero16();
#pragma unroll
        for (int ks = 0; ks < 4; ++ks) {
          const bf16x8 a = *(const bf16x8*)(Ks + (jt * 32 + r) * 72 + ks * 16 + hh * 8);
          s = MFMA(a, bq[ks], s);
        }
#pragma unroll
        for (int i = 0; i < 16; ++i) {
          const int j = jt * 32 + crow(i, hh);
          const int diff = dir ? j - iq : iq - j;
          s[i] = diff >= 0 ? s[i] * 0.125f * __builtin_amdgcn_exp2f(lg2 * (float)diff) : 0.f;
        }
#pragma unroll
        for (int st = 0; st < 2; ++st) {
          const bf16x8 pf = pack8(s, st);
#pragma unroll
          for (int mi = 0; mi < 2; ++mi) {
            const bf16* vp = VT + (mi * 32 + r) * 136 + jt * 32 + 16 * st + 4 * hh;
            const bf16x4 lo = *(const bf16x4*)vp, hi = *(const bf16x4*)(vp + 8);
            const bf16x8 va = __builtin_shufflevector(lo, hi, 0, 1, 2, 3, 4, 5, 6, 7);
            O[mi] = MFMA(va, pf, O[mi]);
          }
        }
      }
    }
#pragma unroll
    for (int i = 0; i < 16; ++i) Sacc[i] *= cdec;
#pragma unroll 2
    for (int jk = 0; jk < 8; ++jk) {
      const bf16x8 a = *(const bf16x8*)(VT + (etile * 32 + r) * 136 + jk * 16 + hh * 8);
      const bf16x8 bb = *(const bf16x8*)(KdT + (dtile * 32 + r) * 136 + jk * 16 + hh * 8);
      Sacc = MFMA(a, bb, Sacc);
    }
    if (!second) {
#pragma unroll
      for (int mi = 0; mi < 2; ++mi)
#pragma unroll
        for (int g4 = 0; g4 < 4; ++g4) {
          bf16x4 o;
#pragma unroll
          for (int j = 0; j < 4; ++j) o[j] = (short)f2bf(O[mi][4 * g4 + j]);
          *(bf16x4*)(ofb + (size_t)tlq * 512 + hd * 64 + mi * 32 + 8 * g4 + 4 * hh) = o;
        }
    } else {
      float ss = 0.f;
#pragma unroll
      for (int mi = 0; mi < 2; ++mi)
#pragma unroll
        for (int g4 = 0; g4 < 4; ++g4) {
          const bf16x4 pv = pp[mi * 4 + g4];
#pragma unroll
          for (int j = 0; j < 4; ++j) {
            const float v = O[mi][4 * g4 + j] + bf2f((bf16)pv[j]);
            O[mi][4 * g4 + j] = v;
            ss += v * v;
          }
        }
      ss += __shfl_xor(ss, 32);
      const float rn = rsqrtf(ss * (1.f / 64.f) + 1e-6f);
#pragma unroll
      for (int mi = 0; mi < 2; ++mi)
#pragma unroll
        for (int g4 = 0; g4 < 4; ++g4) {
          const int e0 = hd * 64 + mi * 32 + 8 * g4 + 4 * hh;
          bf16* gp = rg + (size_t)tlq * 512 + e0;
          const bf16x4 gv = pg[mi * 4 + g4];
          const float4 gn = *(const float4*)(p.ret_gn + layer * 512 + e0);
          bf16x4 o;
          o[0] = (short)f2bf(O[mi][4 * g4 + 0] * rn * gn.x * siluf(bf2f((bf16)gv[0])));
          o[1] = (short)f2bf(O[mi][4 * g4 + 1] * rn * gn.y * siluf(bf2f((bf16)gv[1])));
          o[2] = (short)f2bf(O[mi][4 * g4 + 2] * rn * gn.z * siluf(bf2f((bf16)gv[2])));
          o[3] = (short)f2bf(O[mi][4 * g4 + 3] * rn * gn.w * siluf(bf2f((bf16)gv[3])));
          *(bf16x4*)gp = o;
        }
    }
    __builtin_amdgcn_fence(__ATOMIC_SEQ_CST, "workgroup");
    __syncthreads();
#pragma unroll
    for (int i = 0; i < 16; ++i) ST[(etile * 32 + crow(i, hh)) * 72 + dtile * 32 + r] = f2bf(Sacc[i]);
  }
  if (!lat) {
    float* so = p.out + OUT_ST + ((((size_t)bglob * 4 + layer) * 2 + dir) * 8 + hd) * 4096;
#pragma unroll
    for (int i = 0; i < 16; ++i) so[(dtile * 32 + r) * 64 + etile * 32 + crow(i, hh)] = Sacc[i];
  }
}

DI void p2(const Params& p, int layer, int grp, char* smem, int* s_item) {
  int* ctr = (int*)(p.ws + OFF_CTR) + layer * 2 + grp;
  const int n_rl = 32, n_hl = 512, n_al = 512;
  const int n_hc = grp ? 0 : 512, n_rc = grp ? 0 : 256, n_ac = grp ? 0 : 256;
  const int total = n_rl + n_hl + n_al + n_hc + n_rc + n_ac;
  const int latbase = grp ? 0 : T_CTX;
  const int latb0 = grp ? 4 : 0;
  for (;;) {
    __syncthreads();
    if (threadIdx.x == 0) *s_item = atomicAdd(ctr, 1);
    __syncthreads();
    int it = *s_item;
    if (it >= total) break;
    if (it < n_rl) {
      const int b = it >> 3, hd = it & 7;
      ret_item(p, layer, true, 32, latbase + b * 4096, latb0 + b, hd, smem);
      continue;
    }
    it -= n_rl;
    if (it < n_hl) { hyena_item<4, 4096>(p, layer, 0, latbase, it, smem); continue; }
    it -= n_hl;
    if (it < n_al) {
      const int b = it >> 7, kvh = (it >> 6) & 1, qb = it & 63;
      attn_item(p, layer, true, latbase + b * 4096, latb0 + b, kvh, qb, smem);
      continue;
    }
    it -= n_al;
    if (it < n_hc) { hyena_item<32, 256>(p, layer, 1, 0, it, smem); continue; }
    it -= n_hc;
    if (it < n_rc) {
      const int b = it >> 3, hd = it & 7;
      ret_item(p, layer, false, 2, b * 256, b, hd, smem);
      continue;
    }
    it -= n_rc;
    {
      const int b = it >> 3, kvh = (it >> 2) & 1, qb = it & 3;
      attn_item(p, layer, false, b * 256, b, kvh, qb, smem);
    }
  }
}

DI unsigned pk2(float a, float b) { return (unsigned)f2bf(a) | ((unsigned)f2bf(b) << 16); }
DI float pklo(unsigned u) { return __uint_as_float(u << 16); }
DI float pkhi(unsigned u) { return __uint_as_float(u & 0xffff0000u); }
DI void p3a(const Params& p, int layer, int grp, char* smem) {
  const int tgn = grp ? 16384 : TG;
  const int mtiles = tgn / 256, ntot = mtiles * 8;
  const int tid = otid(), lane = tid & 63, wave = tid >> 6;
  const int wm = wave >> 1, wn = wave & 1, r = lane & 31, h = lane >> 5;
  const bf16* H = (const bf16*)(p.ws + OFF_H);
  const bf16* wl = (const bf16*)(p.ws + OFF_W) + (size_t)layer * W_LAYER;
  bf16* MG = (bf16*)(p.ws + OFF_MERGED);
  u32x4 ra[2][4], rb[2][2];
  bool pre = false;
  const bf16* YaT = (const bf16*)(p.ws + OFF_YA);
  for (int id = blockIdx.x; id < ntot; id += gridDim.x) {
    const int m0 = ((id >> 7) * 16 + (id & 15)) * 256, n0 = ((id & 127) >> 4) * 128;
    const int idn = id + gridDim.x;
    const bool hn = idn < ntot;
    const int m0n = ((idn >> 7) * 16 + (idn & 15)) * 256, n0n = ((idn & 127) >> 4) * 128;
    unsigned mgp[2][2][8];
#pragma unroll
    for (int a = 0; a < 2; ++a)
#pragma unroll
      for (int b = 0; b < 2; ++b)
#pragma unroll
        for (int i = 0; i < 8; ++i) mgp[a][b][i] = 0u;
#pragma unroll 1
    for (int br = 0; br < 3; ++br) {
      const GemmSrc gate = mksrc(H + (size_t)m0 * 1024, 1024, wl + W_MG + (size_t)(br * 1024 + n0) * 1024, 1024, 0);
      const bf16* WB = wl + (br == 0 ? W_A : br == 1 ? W_B : W_C);
      const GemmSrc bsrc = br == 0 ? mksrc(YaT + m0, TG, WB + (size_t)n0 * 512, 512, 1)
                                   : mksrc((const bf16*)(p.ws + (br == 1 ? OFF_AG : OFF_RG)) + (size_t)m0 * 512, 512, WB + (size_t)n0 * 512, 512, 0);
      const GemmSrc after = br < 2 ? mksrc(H + (size_t)m0 * 1024, 1024, wl + W_MG + (size_t)((br + 1) * 1024 + n0) * 1024, 1024, 0)
                                   : mksrc(H + (size_t)m0n * 1024, 1024, wl + W_MG + (size_t)n0n * 1024, 1024, 0);
      unsigned sg[2][2][8];
      {
        f32x16 ag[2][2];
#pragma unroll
        for (int a = 0; a < 2; ++a)
#pragma unroll
          for (int b = 0; b < 2; ++b) ag[a][b] = zero16();
        gemm_main<2, false>(gate, 1024, ag, smem, ra, rb, false, bsrc, false);
#pragma unroll
        for (int ni = 0; ni < 2; ++ni) {
          const float bias = p.b_merge[layer * 3072 + br * 1024 + n0 + wn * 64 + ni * 32 + r];
#pragma unroll
          for (int mi = 0; mi < 2; ++mi) {
#pragma unroll
            for (int i = 0; i < 8; ++i)
              sg[mi][ni][i] = pk2(sigmf(ag[mi][ni][2 * i] + bias), sigmf(ag[mi][ni][2 * i + 1] + bias));
            __builtin_amdgcn_sched_barrier(0);
          }
        }
      }
      f32x16 ay[2][2];
#pragma unroll
      for (int a = 0; a < 2; ++a)
#pragma unroll
        for (int b = 0; b < 2; ++b) ay[a][b] = zero16();
      if (br == 0) gemm_main<2, true>(bsrc, 512, ay, smem, ra, rb, false, after, false);
      else gemm_main<2, false>(bsrc, 512, ay, smem, ra, rb, false, after, false);
#pragma unroll
      for (int mi = 0; mi < 2; ++mi)
#pragma unroll
        for (int ni = 0; ni < 2; ++ni) {
#pragma unroll
          for (int i = 0; i < 8; ++i) {
            const float lo = pklo(mgp[mi][ni][i]) + pklo(sg[mi][ni][i]) * ay[mi][ni][2 * i];
            const float hi = pkhi(mgp[mi][ni][i]) + pkhi(sg[mi][ni][i]) * ay[mi][ni][2 * i + 1];
            mgp[mi][ni][i] = pk2(lo, hi);
          }
          __builtin_amdgcn_sched_barrier(0);
        }
    }
#pragma unroll
    for (int mi = 0; mi < 2; ++mi)
#pragma unroll
      for (int ni = 0; ni < 2; ++ni)
#pragma unroll
        for (int i = 0; i < 8; ++i) {
          bf16* d = MG + (size_t)(m0 + wm * 64 + mi * 32) * 1024 + n0 + wn * 64 + ni * 32 + r;
          d[(size_t)crow(2 * i, h) * 1024] = (bf16)(mgp[mi][ni][i] & 0xffffu);
          d[(size_t)crow(2 * i + 1, h) * 1024] = (bf16)(mgp[mi][ni][i] >> 16);
        }
  }
}

DI void p3b(const Params& p, int layer, int grp, char* smem) {
  const int g0 = grp ? TG : 0, tgn = grp ? 16384 : TG;
  const int mtiles = tgn / 256, ntot = mtiles * 8;
  const int tid = otid(), lane = tid & 63, wave = tid >> 6;
  const int wm = wave >> 1, wn = wave & 1, r = lane & 31, h = lane >> 5;
  const bf16* MG = (const bf16*)(p.ws + OFF_MERGED);
  const bf16* WoT = (const bf16*)(p.ws + OFF_W) + (size_t)layer * W_LAYER + W_O;
  const float* mods = (const float*)(p.ws + OFF_MODS);
  u32x4 ra[2][4], rb[2][2];
  bool pre = false;
  for (int id = blockIdx.x; id < ntot; id += gridDim.x) {
    const int band = id >> 7, rem = id & 127;
    const int mt = band * 16 + (rem & 15), nt = rem >> 4;
    const int m0 = mt * 256, n0 = nt * 128;
    const int idn = id + gridDim.x;
    const bool hn = idn < ntot;
    const int m0n = ((idn >> 7) * 16 + (idn & 15)) * 256, n0n = ((idn & 127) >> 4) * 128;
    f32x16 acc[2][2];
#pragma unroll
    for (int a = 0; a < 2; ++a)
#pragma unroll
      for (int b = 0; b < 2; ++b) acc[a][b] = zero16();
    gemm_main<2, false>(mksrc(MG + (size_t)m0 * 1024, 1024, WoT + (size_t)n0 * 1024, 1024, 0), 1024, acc, smem, ra, rb, pre,
                        mksrc(MG + (size_t)m0n * 1024, 1024, WoT + (size_t)n0n * 1024, 1024, 0), hn);
    pre = true;
    const int tg0 = g0 + m0;
    const float* gate = mods + (layer * 9 + cond_of(tg0)) * 3072 + 2048;
    const float *qxp = launder(p.x_prompt), *qxs = launder(p.x_sample), *qo = launder(p.out);
    const float* xsb = layer == 0 ? (tg0 < T_CTX ? qxp + (size_t)tg0 * DM : qxs + (size_t)(tg0 - T_CTX) * DM) : qo + (size_t)tg0 * DM;
    float* xdb = p.out + (size_t)tg0 * DM;
#pragma unroll
    for (int ni = 0; ni < 2; ++ni) {
      const int col = n0 + wn * 64 + ni * 32 + r;
      const float gt = gate[col];
#pragma unroll
      for (int mi = 0; mi < 2; ++mi)
#pragma unroll
        for (int i = 0; i < 16; ++i) {
          const int ro = (wm * 64 + mi * 32 + crow(i, h)) * DM + col;
          xdb[ro] = xsb[ro] + gt * acc[mi][ni][i];
        }
    }
  }
}

DI void final_norm(const Params& p) {
  const int tid_ = otid();
  const int lane = tid_ & 63, wave = tid_ >> 6;
  for (int it = blockIdx.x; it < T_ALL / 8; it += gridDim.x) {
    const int tg = it * 8 + wave;
    float* x = p.out + (size_t)tg * DM;
    float4 v[4];
    float ss = 0.f;
#pragma unroll
    for (int i = 0; i < 4; ++i) {
      v[i] = *(const float4*)(x + (lane + 64 * i) * 4);
      ss += v[i].x * v[i].x + v[i].y * v[i].y + v[i].z * v[i].z + v[i].w * v[i].w;
    }
#pragma unroll
    for (int o = 32; o > 0; o >>= 1) ss += __shfl_xor(ss, o);
    const float rstd = rsqrtf(ss * (1.f / 1024.f) + 1e-6f);
#pragma unroll
    for (int i = 0; i < 4; ++i) {
      const int col = (lane + 64 * i) * 4;
      const float4 w = *(const float4*)(p.final_w + col);
      *(float4*)(x + col) = make_float4(v[i].x * rstd * w.x, v[i].y * rstd * w.y, v[i].z * rstd * w.z, v[i].w * rstd * w.w);
    }
  }
}


#define XB_TMO 128
#define XB_XCNT(j) (256 + 64 * (j))
#define XB_XSUB(j) (1280 + 64 * (j))
#define XB_XGEN(j) (2304 + 64 * (j))
#define XB_TOP 3328
#define XB_TOPGEN 3392
#define XB_SPIN_CAP (1u << 22)
DI unsigned xb_ld(unsigned* p) { return __hip_atomic_load(p, __ATOMIC_RELAXED, __HIP_MEMORY_SCOPE_AGENT); }
DI unsigned xb_add(unsigned* p, unsigned v) { return __hip_atomic_fetch_add(p, v, __ATOMIC_RELAXED, __HIP_MEMORY_SCOPE_AGENT); }
DI unsigned xb_xcc_id() { return (unsigned)__builtin_amdgcn_s_getreg((3 << 11) | 20) & 0xFu; }
#define XB_SPIN(cond, bar)                                          \
  do {                                                              \
    unsigned _sp = 0;                                               \
    while (cond) {                                                  \
      __builtin_amdgcn_s_sleep(1);                                  \
      if ((++_sp & 255u) == 0u) {                                   \
        if (xb_ld(&(bar)[XB_TMO])) break;                           \
        if (_sp > XB_SPIN_CAP) {                                    \
          atomicAdd(&(bar)[XB_TMO], 1u);                            \
          break;                                                    \
        }                                                           \
      }                                                             \
    }                                                               \
  } while (0)
struct XcdBarrier {
  unsigned* bar;
  unsigned x;
  volatile unsigned* st;
};
DI void xcd_barrier_complete(unsigned* bar, unsigned x, unsigned& nloc, unsigned& nx) {
  const unsigned G = gridDim.x;
  unsigned sum, cnt, mine, sp = 0u;
  for (;;) {
    sum = 0u; cnt = 0u; mine = 0u;
#pragma unroll
    for (unsigned j = 0; j < 16; ++j) {
      const unsigned c = xb_ld(&bar[XB_XCNT(j)]);
      sum += c;
      cnt += (c > 0u) ? 1u : 0u;
      mine = (j == x) ? c : mine;
    }
    if (sum == G) break;
    __builtin_amdgcn_s_sleep(1);
    if ((++sp & 255u) == 0u) {
      if (xb_ld(&bar[XB_TMO])) break;
      if (sp > XB_SPIN_CAP) { atomicAdd(&bar[XB_TMO], 1u); break; }
    }
  }
  nloc = mine > 0u ? mine : 1u;
  nx = cnt > 0u ? cnt : 1u;
}
DI void xcd_barrier(char* ws, volatile unsigned* st) {
  asm volatile("" : "+s"(ws));
  XcdBarrier b;
  b.bar = (unsigned*)(ws + OFF_BAR);
  b.x = xb_xcc_id();
  b.st = st;
  asm volatile("s_waitcnt vmcnt(0)" ::: "memory");
  __syncthreads();
  if (threadIdx.x == 0) {
    unsigned* bar = b.bar;
    __builtin_amdgcn_s_waitcnt(0);
    unsigned nloc = b.st[0], nx = b.st[1];
    if (nloc == 0u) {
      xcd_barrier_complete(bar, b.x, nloc, nx);
      b.st[0] = nloc;
      b.st[1] = nx;
    }
    const unsigned old = xb_add(&bar[XB_XSUB(b.x)], 1u);
    const unsigned gen = old / nloc;
    if (old + 1u == (gen + 1u) * nloc) {
      __builtin_amdgcn_fence(__ATOMIC_RELEASE, "agent");
      asm volatile("s_waitcnt vmcnt(0)" ::: "memory");
      const unsigned og = xb_add(&bar[XB_TOP], 1u);
      const unsigned tg = og / nx;
      if (og + 1u == (tg + 1u) * nx) xb_add(&bar[XB_TOPGEN], 1u);
      else XB_SPIN(xb_ld(&bar[XB_TOPGEN]) == tg, bar);
      __builtin_amdgcn_fence(__ATOMIC_ACQUIRE, "agent");
      xb_add(&bar[XB_XGEN(b.x)], 1u);
      asm volatile("s_waitcnt vmcnt(0)" ::: "memory");
    } else {
      XB_SPIN(xb_ld(&bar[XB_XGEN(b.x)]) == gen, bar);
      __builtin_amdgcn_fence(__ATOMIC_ACQUIRE, "agent");
      asm volatile("s_waitcnt vmcnt(0)" ::: "memory");
    }
  }
  __syncthreads();
}

__global__ void __launch_bounds__(512) mega(Params p) {
  __shared__ __attribute__((aligned(16))) char smem[SMEM_BYTES];
  __shared__ __attribute__((aligned(16))) unsigned xb_words[4];
  __shared__ int s_item;
  cg::grid_group grid = cg::this_grid();
  if (threadIdx.x == 0) { xb_words[0] = 0u; xb_words[1] = 0u; xb_words[2] = 0u; xb_words[3] = 0u; }
  __syncthreads();
  if (threadIdx.x == 0) (void)xb_add(&((unsigned*)(p.ws + OFF_BAR))[XB_XCNT(xb_xcc_id())], 1u);
  phase0(p, smem);
  grid.sync();
#pragma unroll 1
  for (int layer = 0; layer < DEPTH; ++layer) {
#pragma unroll 1
    for (int grp = 0; grp < 2; ++grp) {
      int ly = layer, gp = grp;
      asm volatile("" : "+s"(ly), "+s"(gp));
      p1a(p, ly, gp, smem);
      xcd_barrier(p.ws, xb_words);
      asm volatile("" : "+s"(ly), "+s"(gp));
      p1b(p, ly, gp, smem);
      xcd_barrier(p.ws, xb_words);
      asm volatile("" : "+s"(ly), "+s"(gp));
      p2(p, ly, gp, smem, &s_item);
      xcd_barrier(p.ws, xb_words);
      asm volatile("" : "+s"(ly), "+s"(gp));
      p3a(p, ly, gp, smem);
      xcd_barrier(p.ws, xb_words);
      asm volatile("" : "+s"(ly), "+s"(gp));
      p3b(p, ly, gp, smem);
      xcd_barrier(p.ws, xb_words);
    }
  }
  final_norm(p);
}

extern "C" void kernel_launch(void* const* d_in, const int* in_sizes, int n_in, void* d_out, int out_size, void* d_ws,
                              size_t ws_size, hipStream_t stream) {
  static int grid_blocks = 0;
  if (!grid_blocks) {
    int dev = 0, cus = 0, per_cu = 0;
    hipGetDevice(&dev);
    hipDeviceGetAttribute(&cus, hipDeviceAttributeMultiprocessorCount, dev);
    hipOccupancyMaxActiveBlocksPerMultiprocessor(&per_cu, mega, 512, 0);
    if (per_cu < 1) per_cu = 1;
    if (per_cu > 1) per_cu = 1;
    grid_blocks = cus * per_cu;
  }
  Params p{};
  const float** pp = (const float**)&p;
  for (int i = 0; i < 27; ++i) pp[i] = (const float*)d_in[i];
  p.out = (float*)d_out;
  p.ws = (char*)d_ws;
  if (ws_size < WS_NEEDED) fprintf(stderr, "workspace too small: %zu < %zu\n", ws_size, (size_t)WS_NEEDED);
  hipMemsetAsync(d_ws, 0, ZERO_BYTES, stream);
  void* args[] = {&p};
  hipError_t e = hipLaunchCooperativeKernel((void*)mega, dim3(grid_blocks), dim3(512), args, 0, stream);
  if (e != hipSuccess) fprintf(stderr, "cooperative launch failed: %s (grid %d)\n", hipGetErrorString(e), grid_blocks);
}
```

```cpp
#include <hip/hip_runtime.h>
#include <hip/hip_cooperative_groups.h>
#include <cstdio>
namespace cg = cooperative_groups;

#define DI __device__ __forceinline__
typedef unsigned short bf16;
typedef __attribute__((ext_vector_type(8))) short bf16x8;
typedef __attribute__((ext_vector_type(4))) short bf16x4;
typedef __attribute__((ext_vector_type(16))) float f32x16;
typedef __attribute__((ext_vector_type(4))) unsigned u32x4;
typedef __attribute__((ext_vector_type(4))) float f32x4v;
#define MFMA(a, b, c) __builtin_amdgcn_mfma_f32_32x32x16_bf16((a), (b), (c), 0, 0, 0)

constexpr int DM = 1024;
constexpr int DEPTH = 4;
constexpr int T_CTX = 8192;
constexpr int T_ALL = 40960;
constexpr int TG = 24576;
constexpr int IN_DIM = 5376;
constexpr float LOG2E = 1.4426950408889634f;

constexpr size_t OFF_MODS = 0;
constexpr size_t OFF_FSUM = 458752;
constexpr size_t OFF_CTR = 491520;
constexpr size_t OFF_BAR = 495616;
constexpr size_t ZERO_BYTES = 524288;
constexpr size_t OFF_ROPE = ZERO_BYTES;
constexpr size_t OFF_W = OFF_ROPE + 1048576;
constexpr size_t W_IN = 0, W_MG = 5505024, W_A = 8650752, W_B = 9175040, W_C = 9699328, W_O = 10223616, W_LAYER = 11272192;
constexpr size_t OFF_GL = OFF_W + W_LAYER * 2 * 4;
constexpr size_t OFF_GC = OFF_GL + 33554432;
constexpr size_t OFF_H = OFF_GC + 2097152;
constexpr size_t OFF_HYT = OFF_H + (size_t)TG * 2048;
constexpr size_t OFF_AQ = OFF_HYT + (size_t)TG * 4096;
constexpr size_t OFF_AK = OFF_AQ + (size_t)TG * 1024;
constexpr size_t OFF_AV = OFF_AK + (size_t)TG * 256;
constexpr size_t OFF_AG = OFF_AV + (size_t)TG * 256;
constexpr size_t OFF_RQ = OFF_AG + (size_t)TG * 1024;
constexpr size_t OFF_RK = OFF_RQ + (size_t)TG * 1024;
constexpr size_t OFF_RV = OFF_RK + (size_t)TG * 1024;
constexpr size_t OFF_RG = OFF_RV + (size_t)TG * 1024;
constexpr size_t OFF_YA = OFF_RG + (size_t)TG * 1024;
constexpr size_t OFF_OFB = OFF_YA + (size_t)TG * 1024;
constexpr size_t WS_NEEDED = OFF_OFB + (size_t)TG * 1024;
constexpr size_t OFF_MERGED = OFF_RQ;

constexpr size_t OUT_CK = 41943040, OUT_CV = 46137344, OUT_ST = 50331648;

constexpr int SMEM_BYTES = 135168;

struct Params {
  const float *x_prompt, *x_sample, *c, *cache_k, *cache_v, *state_ret, *c_ctx, *norm_w, *w_mod, *b_mod, *w_in, *hy_conv,
      *hy_w1, *hy_b1, *hy_freq, *hy_w2, *hy_skip, *attn_sink, *ret_theta, *ret_gn, *w_a, *w_b, *w_c, *w_merge, *b_merge,
      *w_out, *final_w;
  float* out;
  char* ws;
};

DI bf16 f2bf(float x) {
  __bf16 b = (__bf16)x;
  return __builtin_bit_cast(unsigned short, b);
}
DI float bf2f(bf16 u) { return __uint_as_float(((unsigned)u) << 16); }
DI int crow(int reg, int h) { return (reg & 3) + 8 * (reg >> 2) + 4 * h; }
DI float siluf(float x) { return x / (1.f + __expf(-x)); }
DI float sigmf(float x) { return 1.f / (1.f + __expf(-x)); }
DI bf16x8 pack8(const f32x16& x, int s) {
  bf16x8 r;
#pragma unroll
  for (int j = 0; j < 8; ++j) r[j] = (short)f2bf(x[8 * s + j]);
  return r;
}
DI f32x16 zero16() {
  f32x16 z;
#pragma unroll
  for (int i = 0; i < 16; ++i) z[i] = 0.f;
  return z;
}
DI const float* launder(const float* q) {
  asm volatile("" : "+s"(q));
  return q;
}
DI int otid() {
  int t = threadIdx.x;
  asm volatile("" : "+v"(t));
  return t;
}
DI int cond_of(int tg) { return tg < T_CTX ? 0 : 1 + ((tg - T_CTX) >> 12); }

DI void lds_barrier() { asm volatile("s_waitcnt lgkmcnt(0)\n\ts_barrier" ::: "memory"); }

struct GemmSrc {
  const bf16* A;
  const bf16* B;
  int lda, ldb, atr;
};
DI GemmSrc mksrc(const bf16* A, int lda, const bf16* B, int ldb, int atr) {
  GemmSrc g;
  g.A = A; g.B = B; g.lda = lda; g.ldb = ldb; g.atr = atr;
  return g;
}
template <int NI>
DI void gemm_issue(const GemmSrc& g, int kt, int tid, u32x4 (&ra)[4], u32x4 (&rb)[NI]) {
  const int lrow = tid >> 3, lkc = (tid & 7) * 8;
  const bf16* ab = g.atr ? g.A + (size_t)(((tid >> 6) * 8 + ((tid >> 3) & 7)) + kt * 64) * g.lda + (tid & 7) * 8
                         : g.A + (size_t)lrow * g.lda + lkc + kt * 64;
  const size_t astep = g.atr ? (size_t)64 : (size_t)64 * g.lda;
#pragma unroll
  for (int i = 0; i < 4; ++i) ra[i] = *(const u32x4*)(ab + astep * i);
  const bf16* bb = g.B + (size_t)lrow * g.ldb + lkc + kt * 64;
#pragma unroll
  for (int i = 0; i < NI; ++i) rb[i] = *(const u32x4*)(bb + (size_t)(64 * i) * g.ldb);
}
template <int NI, bool ATR>
DI void gemm_stage(bf16* As, bf16* Bs, int tid, const u32x4 (&ra)[4], const u32x4 (&rb)[NI]) {
  constexpr int PITCH = 72;
  const int lrow = tid >> 3, lkc = (tid & 7) * 8;
#pragma unroll
  for (int i = 0; i < 4; ++i) {
    if (ATR) {
      const int kk = (tid >> 6) * 8 + ((tid >> 3) & 7), tc = (tid & 7) + 8 * i;
      bf16* d = As + (tc * 8) * PITCH + (kk ^ ((tid & 7) << 3));
      const bf16x8 v = __builtin_bit_cast(bf16x8, ra[i]);
#pragma unroll
      for (int e = 0; e < 8; ++e) d[e * PITCH] = (bf16)v[e];
    } else {
      *(u32x4*)(As + (lrow + 64 * i) * PITCH + lkc) = ra[i];
    }
  }
#pragma unroll
  for (int i = 0; i < NI; ++i) *(u32x4*)(Bs + (lrow + 64 * i) * PITCH + lkc) = rb[i];
}

template <int NI, bool ATR>
DI void gemm_stage_part(bf16* As, bf16* Bs, int tid, const u32x4 (&ra)[4], const u32x4 (&rb)[NI], int part) {
  constexpr int PITCH = 72;
  const int lrow = tid >> 3, lkc = (tid & 7) * 8;
#pragma unroll
  for (int i = 0; i < 4; ++i) {
    if (i != part) continue;
    if (ATR) {
      const int kk = (tid >> 6) * 8 + ((tid >> 3) & 7), tc = (tid & 7) + 8 * i;
      bf16* d = As + (tc * 8) * PITCH + (kk ^ ((tid & 7) << 3));
      const bf16x8 v = __builtin_bit_cast(bf16x8, ra[i]);
#pragma unroll
      for (int e = 0; e < 8; ++e) d[e * PITCH] = (bf16)v[e];
    } else {
      *(u32x4*)(As + (lrow + 64 * i) * PITCH + lkc) = ra[i];
    }
  }
#pragma unroll
  for (int i = 0; i < NI; ++i)
    if (2 * i == part) *(u32x4*)(Bs + (lrow + 64 * i) * PITCH + lkc) = rb[i];
}

template <int NI, bool ATR>
DI void gemm_main(const GemmSrc& cur, int K, f32x16 (&acc)[2][NI], char* smem, u32x4 (&ra)[2][4], u32x4 (&rb)[2][NI],
                  bool preloaded, const GemmSrc& nxt, bool has_next) {
  constexpr int BN = 64 * NI;
  constexpr int PITCH = 72;
  bf16* As = (bf16*)smem;
  bf16* Bs = As + 2 * 256 * PITCH;
  const int tid = otid(), lane = tid & 63, wave = tid >> 6;
  const int wm = wave >> 1, wn = wave & 1, r = lane & 31, h = lane >> 5;
  const int nk = K / 64;
  if (!preloaded) {
    gemm_issue<NI>(cur, 0, tid, ra[0], rb[0]);
    gemm_issue<NI>(cur, 1, tid, ra[1], rb[1]);
  }
  lds_barrier();
  gemm_stage<NI, ATR>(As, Bs, tid, ra[0], rb[0]);
  lds_barrier();
#pragma unroll 1
  for (int kt = 0; kt < nk; kt += 2) {
#pragma unroll
    for (int u = 0; u < 2; ++u) {
      const int k = kt + u;
      {
        const bool inr = k + 2 < nk;
        GemmSrc g = (inr || !has_next) ? cur : nxt;
        const int kk = inr ? k + 2 : (has_next ? k + 2 - nk : nk - 1);
        gemm_issue<NI>(g, kk, tid, ra[u], rb[u]);
      }
      const bf16* Ab = As + u * 256 * PITCH + (wm * 64 + r) * PITCH + h * 8;
      const bf16* Bb = Bs + u * BN * PITCH + (wn * 32 * NI + r) * PITCH + h * 8;
#pragma unroll
      for (int ks = 0; ks < 4; ++ks) {
        bf16x8 a[2], b[NI];
#pragma unroll
        for (int mi = 0; mi < 2; ++mi)
          a[mi] = ATR ? *(const bf16x8*)(Ab - h * 8 + mi * 32 * PITCH + ((ks * 16 + h * 8) ^ (((mi * 4 + (r >> 3)) & 7) << 3)))
                      : *(const bf16x8*)(Ab + mi * 32 * PITCH + ks * 16);
#pragma unroll
        for (int ni = 0; ni < NI; ++ni) b[ni] = *(const bf16x8*)(Bb + ni * 32 * PITCH + ks * 16);
#pragma unroll
        for (int mi = 0; mi < 2; ++mi)
#pragma unroll
          for (int ni = 0; ni < NI; ++ni) acc[mi][ni] = MFMA(a[mi], b[ni], acc[mi][ni]);
        gemm_stage_part<NI, ATR>(As + (u ^ 1) * 256 * PITCH, Bs + (u ^ 1) * BN * PITCH, tid, ra[u ^ 1], rb[u ^ 1], ks);
      }
      lds_barrier();
    }
  }
}

DI void p0_mod_item(const Params& p, int item, char* smem) {
  const int tid = otid();
  const int l = item / 48, rem = item % 48, nch = rem / 8, ks = rem % 8;
  float* sc = (float*)smem;
  __syncthreads();
  for (int idx = tid; idx < 9 * 128; idx += 512) {
    const int cnd = idx >> 7, k = ks * 128 + (idx & 127);
    const float *qcc = launder(p.c_ctx), *qc = launder(p.c);
    const float v = cnd == 0 ? qcc[k] : qc[(cnd - 1) * 1024 + k];
    sc[idx] = v / (1.f + expf(-v));
  }
  __syncthreads();
  const int n = nch * 512 + tid;
  float acc[9];
#pragma unroll
  for (int i = 0; i < 9; ++i) acc[i] = 0.f;
  const float* w = p.w_mod + ((size_t)l * 1024 + ks * 128) * 3072 + n;
#pragma unroll 16
  for (int kk = 0; kk < 128; ++kk) {
    const float wv = w[(size_t)kk * 3072];
#pragma unroll
    for (int i = 0; i < 9; ++i) acc[i] += sc[i * 128 + kk] * wv;
  }
  float* mods = (float*)(p.ws + OFF_MODS);
  const float bias = ks == 0 ? p.b_mod[l * 3072 + n] : 0.f;
#pragma unroll
  for (int i = 0; i < 9; ++i) atomicAdd(&mods[(l * 9 + i) * 3072 + n], acc[i] + bias);
}

DI void transpose_tile(const float* __restrict__ src, int ldn, bf16* __restrict__ dst, int ldk, int k0, int n0, char* smem) {
  float* T = (float*)smem;
  const int tid = otid();
  __syncthreads();
  {
    const int k = tid >> 3, nc = (tid & 7) * 8;
    const float* s = src + (size_t)(k0 + k) * ldn + n0 + nc;
    const float4 a = *(const float4*)s, b = *(const float4*)(s + 4);
    float* t = T + k * 65 + nc;
    t[0] = a.x; t[1] = a.y; t[2] = a.z; t[3] = a.w; t[4] = b.x; t[5] = b.y; t[6] = b.z; t[7] = b.w;
  }
  __syncthreads();
  {
    const int n = tid >> 3, kc = (tid & 7) * 8;
    bf16x8 v;
#pragma unroll
    for (int j = 0; j < 8; ++j) v[j] = (short)f2bf(T[(kc + j) * 65 + n]);
    *(bf16x8*)(dst + (size_t)(n0 + n) * ldk + k0 + kc) = v;
  }
}

DI void p0_transpose_item(const Params& p, int item, char* smem) {
  const int l = item / 2752;
  int rem = item % 2752;
  bf16* wl = (bf16*)(p.ws + OFF_W) + (size_t)l * W_LAYER;
  if (rem < 1344) {
    const int kt = rem / 84, nt = rem % 84;
    transpose_tile(p.w_in + (size_t)l * 1024 * IN_DIM, IN_DIM, wl + W_IN, 1024, kt * 64, nt * 64, smem);
    return;
  }
  rem -= 1344;
  if (rem < 768) {
    const int kt = rem / 48, nt = rem % 48;
    transpose_tile(p.w_merge + (size_t)l * 1024 * 3072, 3072, wl + W_MG, 1024, kt * 64, nt * 64, smem);
    return;
  }
  rem -= 768;
  if (rem < 384) {
    const int br = rem / 128, r2 = rem % 128, kt = r2 / 16, nt = r2 % 16;
    const float *qa = launder(p.w_a), *qb = launder(p.w_b), *qc = launder(p.w_c);
    const float* src = (br == 0 ? qa : br == 1 ? qb : qc) + (size_t)l * 512 * 1024;
    transpose_tile(src, 1024, wl + (br == 0 ? W_A : br == 1 ? W_B : W_C), 512, kt * 64, nt * 64, smem);
    return;
  }
  rem -= 384;
  {
    const int kt = rem / 16, nt = rem % 16;
    transpose_tile(p.w_out + (size_t)l * 1024 * 1024, 1024, wl + W_O, 1024, kt * 64, nt * 64, smem);
  }
}

DI void p0_rope_item(const Params& p, int item) {
  const int idx = item * 512 + otid();
  const int t = idx >> 5, f = idx & 31;
  const float inv = powf(10000.f, -(float)(f & 15) / 16.f);
  const float ang = (float)(f < 16 ? (t >> 6) : (t & 63)) * inv;
  float2 cs;
  cs.x = cosf(ang);
  cs.y = sinf(ang);
  ((float2*)(p.ws + OFF_ROPE))[idx] = cs;
}

DI void phase0(const Params& p, char* smem) {
  const int n_mod = 192, n_tr = 11008, n_rope = 256;
  for (int it = blockIdx.x; it < n_mod + n_tr + n_rope; it += gridDim.x) {
    if (it < n_mod) p0_mod_item(p, it, smem);
    else if (it < n_mod + n_tr) p0_transpose_item(p, it - n_mod, smem);
    else p0_rope_item(p, it - n_mod - n_tr);
  }
}

DI void filter_item(const Params& p, int layer, int item, char* smem) {
  const int tid = otid();
  int var, pc, cc, L;
  if (item < 512) { var = 0; pc = item >> 3; cc = item & 7; L = 4096; }
  else { var = 1; pc = (item - 512) >> 3; cc = (item - 512) & 7; L = 256; }
  float* z = (float*)smem;
  float* hid = z + 64 * 17;
  float* w2s = hid + 64 * 65;
  __syncthreads();
  {
    const int pos = tid >> 3, band = tid & 7;
    const int pa = pc * 64 + pos;
    const float w = 6.283185307179586f * (float)pa / (float)L;
    const float f = 1e-4f + (float)band * ((7.f - 1e-4f) / 7.f);
    z[pos * 17 + 1 + band] = cosf(f * w);
    z[pos * 17 + 9 + band] = -sinf(f * w);
    if (band == 0) z[pos * 17] = (float)pa / (float)(L - 1);
  }
  __syncthreads();
  {
    const int pos = tid >> 3, j0 = (tid & 7) * 8;
    const float* w1 = p.hy_w1 + layer * 17 * 64;
#pragma unroll
    for (int jj = 0; jj < 8; ++jj) {
      const int j = j0 + jj;
      float pre = p.hy_b1[layer * 64 + j];
      for (int f = 0; f < 17; ++f) pre += z[pos * 17 + f] * w1[f * 64 + j];
      hid[pos * 65 + j] = sinf(p.hy_freq[layer * 64 + j] * pre);
    }
    const float* w2 = p.hy_w2 + (size_t)layer * 64 * 2048 + cc * 256;
    for (int idx = tid; idx < 64 * 256; idx += 512) w2s[idx] = w2[(idx >> 8) * 2048 + (idx & 255)];
  }
  __syncthreads();
  {
    const int lane = tid & 63, wave = tid >> 6, r = lane & 31, hh = lane >> 5;
    f32x16 acc[2];
    acc[0] = zero16();
    acc[1] = zero16();
#pragma unroll 4
    for (int ks = 0; ks < 32; ++ks) {
      const float bv = w2s[(2 * ks + hh) * 256 + wave * 32 + r];
#pragma unroll
      for (int mi = 0; mi < 2; ++mi) {
        const float av = hid[(mi * 32 + r) * 65 + 2 * ks + hh];
        acc[mi] = __builtin_amdgcn_mfma_f32_32x32x2f32(av, bv, acc[mi], 0, 0, 0);
      }
    }
    const int n = cc * 256 + wave * 32 + r;
    const int o = n >> 10, dir = (n >> 9) & 1, c = n & 511;
    const float min_d = -3.0701134573253945f, max_d = -15.350567286626973f;
    const float ad = fabsf(min_d + (float)c * ((max_d - min_d) / 511.f));
    float* g = (float*)(p.ws + (var == 0 ? OFF_GL : OFF_GC)) + ((size_t)(o * 512 + c)) * (2 * L);
    float asum = 0.f;
#pragma unroll
    for (int mi = 0; mi < 2; ++mi)
#pragma unroll
      for (int i = 0; i < 16; ++i) {
        const int pa = pc * 64 + mi * 32 + crow(i, hh);
        const float t = (float)pa / (float)(L - 1);
        const float v = acc[mi][i] * expf(-t * ad);
        asum += fabsf(v);
        int y;
        if (dir == 0) y = L - pa;
        else y = (pa == 0) ? 0 : L + pa;
        g[y] = v;
      }
    atomicAdd((float*)(p.ws + OFF_FSUM) + ((layer * 2 + var) * 2 + o) * 512 + c, asum);
  }
}

DI void p1a(const Params& p, int layer, int grp, char* smem) {
  const int g0 = grp ? TG : 0, tgn = grp ? 16384 : TG;
  const int nfilt = grp ? 0 : 544;
  const int nrow_items = tgn / 8;
  const int tid_ = otid();
  const int lane = tid_ & 63, wave = tid_ >> 6;
  bf16* H = (bf16*)(p.ws + OFF_H);
  const float* mods = (const float*)(p.ws + OFF_MODS);
  for (int it = blockIdx.x; it < nfilt + nrow_items; it += gridDim.x) {
    if (it < nfilt) { filter_item(p, layer, it, smem); continue; }
    const int tl = (it - nfilt) * 8 + wave, tg = g0 + tl;
    const float *qxp = launder(p.x_prompt), *qxs = launder(p.x_sample), *qo = launder(p.out);
    const float* x = layer == 0 ? (tg < T_CTX ? qxp + (size_t)tg * DM : qxs + (size_t)(tg - T_CTX) * DM) : qo + (size_t)tg * DM;
    float4 v[4];
    float ss = 0.f;
#pragma unroll
    for (int i = 0; i < 4; ++i) {
      v[i] = *(const float4*)(x + (lane + 64 * i) * 4);
      ss += v[i].x * v[i].x + v[i].y * v[i].y + v[i].z * v[i].z + v[i].w * v[i].w;
    }
#pragma unroll
    for (int o = 32; o > 0; o >>= 1) ss += __shfl_xor(ss, o);
    const float rstd = rsqrtf(ss * (1.f / 1024.f) + 1e-6f);
    const float* md = mods + (layer * 9 + cond_of(tg)) * 3072;
    const float* nw = p.norm_w + layer * 1024;
#pragma unroll
    for (int i = 0; i < 4; ++i) {
      const int col = (lane + 64 * i) * 4;
      const float4 sh = *(const float4*)(md + col), sc = *(const float4*)(md + 1024 + col), w = *(const float4*)(nw + col);
      bf16x4 o;
      o[0] = (short)f2bf(v[i].x * rstd * w.x * (1.f + sc.x) + sh.x);
      o[1] = (short)f2bf(v[i].y * rstd * w.y * (1.f + sc.y) + sh.y);
      o[2] = (short)f2bf(v[i].z * rstd * w.z * (1.f + sc.z) + sh.z);
      o[3] = (short)f2bf(v[i].w * rstd * w.w * (1.f + sc.w) + sh.w);
      *(bf16x4*)(H + (size_t)tl * 1024 + col) = o;
    }
  }
}

DI void p1b(const Params& p, int layer, int grp, char* smem) {
  const int g0 = grp ? TG : 0, tgn = grp ? 16384 : TG;
  const int mtiles = tgn / 256, ntot = mtiles * 42;
  const int tid = otid(), lane = tid & 63, wave = tid >> 6;
  const int wm = wave >> 1, wn = wave & 1, r = lane & 31, h = lane >> 5;
  const bf16* H = (const bf16*)(p.ws + OFF_H);
  const bf16* WinT = (const bf16*)(p.ws + OFF_W) + (size_t)layer * W_LAYER + W_IN;
  float* S = (float*)smem;
  u32x4 ra[2][4], rb[2][2];
  bool pre = false;
  for (int id = blockIdx.x; id < ntot; id += gridDim.x) {
    const int band = id / (16 * 42), rem = id % (16 * 42);
    const int mt = band * 16 + (rem & 15), nt = rem >> 4;
    const int idn = id + gridDim.x;
    const bool hn = idn < ntot;
    const int bandn = idn / (16 * 42), remn = idn % (16 * 42);
    const int mtn = bandn * 16 + (remn & 15), ntn = remn >> 4;
    f32x16 acc[2][2];
#pragma unroll
    for (int a = 0; a < 2; ++a)
#pragma unroll
      for (int b = 0; b < 2; ++b) acc[a][b] = zero16();
    gemm_main<2, false>(mksrc(H + (size_t)mt * 256 * 1024, 1024, WinT + (size_t)nt * 128 * 1024, 1024, 0), 1024, acc, smem, ra, rb, pre,
                        mksrc(H + (size_t)mtn * 256 * 1024, 1024, WinT + (size_t)ntn * 128 * 1024, 1024, 0), hn);
    pre = true;
    const int m0 = mt * 256, tg0 = g0 + m0;
    const bool lat = tg0 >= T_CTX;
    if (nt < 16) {
#pragma unroll
      for (int mi = 0; mi < 2; ++mi)
#pragma unroll
        for (int ni = 0; ni < 2; ++ni)
#pragma unroll
          for (int g4 = 0; g4 < 4; ++g4) {
            f32x4v v;
#pragma unroll
            for (int j = 0; j < 4; ++j) v[j] = acc[mi][ni][4 * g4 + j];
            *(f32x4v*)(S + (wn * 64 + ni * 32 + r) * 260 + wm * 64 + mi * 32 + 8 * g4 + 4 * h) = v;
          }
      __syncthreads();
      const int part = nt >> 2;
#pragma unroll 2
      for (int it = 0; it < 8; ++it) {
        const int pid = tid + 512 * it, cl = pid >> 5, q = pid & 31;
        const f32x4v a = *(const f32x4v*)(S + cl * 260 + q * 8), b = *(const f32x4v*)(S + cl * 260 + q * 8 + 4);
        bf16x8 v;
#pragma unroll
        for (int j = 0; j < 4; ++j) {
          v[j] = (short)f2bf(a[j]);
          v[4 + j] = (short)f2bf(b[j]);
        }
        *(bf16x8*)((bf16*)(p.ws + OFF_HYT) + ((size_t)(part * 512 + (nt & 3) * 128 + cl)) * TG + m0 + q * 8) = v;
      }
    } else {
#pragma unroll
      for (int mi = 0; mi < 2; ++mi)
#pragma unroll
        for (int ni = 0; ni < 2; ++ni)
#pragma unroll
          for (int i = 0; i < 16; ++i) S[(wm * 64 + mi * 32 + crow(i, h)) * 132 + wn * 64 + ni * 32 + r] = acc[mi][ni][i];
      __syncthreads();
      size_t off; int pitch, coloff; bool rope = false; int cache = 0;
      if (nt < 20) { off = OFF_AQ; pitch = 512; coloff = (nt - 16) * 128; rope = lat; }
      else if (nt == 20) { off = OFF_AK; pitch = 128; coloff = 0; rope = lat; cache = lat ? 0 : 1; }
      else if (nt == 21) { off = OFF_AV; pitch = 128; coloff = 0; cache = lat ? 0 : 2; }
      else if (nt < 26) { off = OFF_AG; pitch = 512; coloff = (nt - 22) * 128; }
      else if (nt < 30) { off = OFF_RQ; pitch = 512; coloff = (nt - 26) * 128; rope = lat; }
      else if (nt < 34) { off = OFF_RK; pitch = 512; coloff = (nt - 30) * 128; rope = lat; }
      else if (nt < 38) { off = OFF_RV; pitch = 512; coloff = (nt - 34) * 128; }
      else { off = OFF_RG; pitch = 512; coloff = (nt - 38) * 128; }
      bf16* dst = (bf16*)(p.ws + off);
      const float2* rt = (const float2*)(p.ws + OFF_ROPE);
#pragma unroll 2
      for (int it = 0; it < 8; ++it) {
        const int cid = tid + 512 * it, row = cid >> 4, cc = cid & 15;
        const float* sp = S + row * 132 + cc * 8;
        float v[8];
#pragma unroll
        for (int j = 0; j < 8; ++j) v[j] = sp[j];
        if (cache) {
          float* co = p.out + (cache == 1 ? OUT_CK : OUT_CV) + ((size_t)((tg0 >> 8) * 4 + layer) * 256 + row) * 128 + cc * 8;
          *(float4*)co = make_float4(v[0], v[1], v[2], v[3]);
          *(float4*)(co + 4) = make_float4(v[4], v[5], v[6], v[7]);
        }
        if (rope) {
          const int hd0 = (cc * 8) & 63, q = hd0 >> 4;
          const int tpos = (tg0 - T_CTX + row) & 4095;
          const float2* tb = rt + tpos * 32 + (q >> 1) * 16 + (hd0 & 15);
          const float* pp = sp + ((q & 1) ? -16 : 16);
          const float sg = (q & 1) ? 1.f : -1.f;
#pragma unroll
          for (int j = 0; j < 8; ++j) {
            const float2 cs = tb[j];
            v[j] = v[j] * cs.x + sg * pp[j] * cs.y;
          }
        }
        bf16x8 o;
#pragma unroll
        for (int j = 0; j < 8; ++j) o[j] = (short)f2bf(v[j]);
        *(bf16x8*)(dst + (size_t)(m0 + row) * pitch + coloff + cc * 8) = o;
      }
    }
  }
}

template <int NBT, int L>
DI void hyena_item(const Params& p, int layer, int var, int tlbase, int c, char* smem) {
  constexpr int NP = 32 / NBT, NT = (L / 8) / (32 * NP), UP = L + 8;
  bf16* U = (bf16*)smem;
  bf16* X1 = U + NBT * UP;
  bf16* X2 = X1 + NBT * UP;
  bf16* GR = X2 + NBT * UP;
  bf16* GR1 = GR + 2 * L + 8;
  const int tid = otid(), lane = tid & 63, wave = tid >> 6;
  const int n = lane & 31, hh = lane >> 5, b = n & (NBT - 1), pp = n / NBT;
  const bf16* hyT = (const bf16*)(p.ws + OFF_HYT);
  const float* fs = (const float*)(p.ws + OFF_FSUM) + (layer * 2 + var) * 1024;
  const float* gsrc = (const float*)(p.ws + (var == 0 ? OFF_GL : OFF_GC));
  __syncthreads();
#pragma unroll 1
  for (int part = 0; part < 3; ++part) {
    const bf16* src = hyT + ((size_t)(part * 512 + c)) * TG + tlbase;
    bf16* dstb = part == 0 ? U : part == 1 ? X1 : X2;
    const float w0 = p.hy_conv[(layer * 3 + 0) * 1536 + part * 512 + c];
    const float w1 = p.hy_conv[(layer * 3 + 1) * 1536 + part * 512 + c];
    const float w2 = p.hy_conv[(layer * 3 + 2) * 1536 + part * 512 + c];
#pragma unroll
    for (int it = 0; it < NBT * L / 8 / 512; ++it) {
      const int id = tid + 512 * it;
      const int bb = id / (L / 8), t8 = (id % (L / 8)) * 8;
      const bf16* s = src + bb * L + t8;
      const bf16x8 xv = *(const bf16x8*)s;
      float x[10];
      x[0] = t8 > 0 ? bf2f(s[-1]) : 0.f;
      x[9] = t8 + 8 < L ? bf2f(s[8]) : 0.f;
#pragma unroll
      for (int j = 0; j < 8; ++j) x[j + 1] = bf2f((bf16)xv[j]);
      bf16x8 o;
#pragma unroll
      for (int j = 0; j < 8; ++j) o[j] = (short)f2bf(w0 * x[j] + w1 * x[j + 1] + w2 * x[j + 2]);
      *(bf16x8*)(dstb + bb * UP + t8) = o;
    }
  }
  const int wbase = wave * (L / 8);
  const int dmin = -(wbase + (NT - 1) * 32 * NP + 32 * (NP - 1)), dmax = L - 16 - wbase;
  f32x16 acc[NT];
#pragma unroll 1
  for (int o = 0; o < 2; ++o) {
    {
      const float inv = 1.f / fs[o * 512 + c];
      const float* gs = gsrc + ((size_t)(o * 512 + c)) * (2 * L);
      const float skip = p.hy_skip[(layer * 2 + o) * 512 + c];
#pragma unroll 8
      for (int y = tid; y < 2 * L; y += 512) {
        float v = gs[y] * inv;
        if (y == L) v = (gs[L] + gs[0]) * inv + skip;
        if (y == 0) v = 0.f;
        const bf16 bv = f2bf(v);
        GR[y] = bv;
        if (y > 0) GR1[y - 1] = bv;
      }
      if (tid == 0) GR1[2 * L - 1] = 0;
    }
    __syncthreads();
#pragma unroll
    for (int q = 0; q < NT; ++q) acc[q] = zero16();
#pragma unroll 1
    for (int d = dmin; d <= dmax; d += 16) {
      const unsigned* gp = (const unsigned*)(((n & 1) ? GR1 - 1 : GR) + (L - n + d + 8 * hh));
      typedef __attribute__((ext_vector_type(4))) unsigned u4;
      u4 aw;
#pragma unroll
      for (int j = 0; j < 4; ++j) aw[j] = gp[j];
      const bf16x8 a = __builtin_bit_cast(bf16x8, aw);
#pragma unroll
      for (int q = 0; q < NT; ++q) {
        const int s0 = wbase + q * 32 * NP + 32 * pp + d;
        bf16x8 bb;
#pragma unroll
        for (int j = 0; j < 8; ++j) bb[j] = 0;
        if (s0 >= 0 && s0 <= L - 16) bb = *(const bf16x8*)(U + b * UP + s0 + 8 * hh);
        acc[q] = MFMA(a, bb, acc[q]);
      }
    }
    __syncthreads();
    if (o == 0) {
#pragma unroll
      for (int q = 0; q < NT; ++q)
#pragma unroll
        for (int i = 0; i < 16; ++i) {
          const int t = wbase + q * 32 * NP + 32 * pp + crow(i, hh);
          U[b * UP + t] = f2bf(bf2f(X1[b * UP + t]) * acc[q][i]);
        }
    } else {
      const bf16* gate = hyT + ((size_t)(3 * 512 + c)) * TG + tlbase;
#pragma unroll
      for (int q = 0; q < NT; ++q)
#pragma unroll
        for (int g4 = 0; g4 < 4; ++g4) {
          const int t = wbase + q * 32 * NP + 32 * pp + 8 * g4 + 4 * hh;
          const bf16x4 gv = *(const bf16x4*)(gate + b * L + t);
          bf16x4 ov;
#pragma unroll
          for (int j = 0; j < 4; ++j)
            ov[j] = (short)f2bf(bf2f(X2[b * UP + t + j]) * acc[q][4 * g4 + j] * siluf(bf2f((bf16)gv[j])));
          *(bf16x4*)(U + b * UP + t) = ov;
        }
      __syncthreads();
      bf16* yat = (bf16*)(p.ws + OFF_YA) + (size_t)c * TG + tlbase;
      for (int id = tid; id < NBT * L / 8; id += 512) {
        const int bb = id / (L / 8), t8 = (id % (L / 8)) * 8;
        *(bf16x8*)(yat + bb * L + t8) = *(const bf16x8*)(U + bb * UP + t8);
      }
    }
  }
}

DI void attn_item(const Params& p, int layer, bool lat, int tlbase, int bglob, int kvh, int qblk, char* smem) {
  bf16* Ks = (bf16*)smem;
  bf16* VT = Ks + 64 * 72;
  const int tid = otid(), lane = tid & 63, wave = tid >> 6;
  const int r = lane & 31, hh = lane >> 5;
  const int head = kvh * 4 + (wave >> 1);
  const int qi = qblk * 64 + (wave & 1) * 32 + r;
  const int tlq = tlbase + qi;
  const bf16* aq = (const bf16*)(p.ws + OFF_AQ);
  const bf16* ak = (const bf16*)(p.ws + OFF_AK);
  const bf16* av = (const bf16*)(p.ws + OFF_AV);
  bf16* ag = (bf16*)(p.ws + OFF_AG);
  bf16x8 bq[4];
#pragma unroll
  for (int ks = 0; ks < 4; ++ks) bq[ks] = *(const bf16x8*)(aq + (size_t)tlq * 512 + head * 64 + ks * 16 + hh * 8);
  const float sink2 = p.attn_sink[layer * 8 + head] * LOG2E;
  const float SC = 0.125f * LOG2E;
  float m = sink2, lsum = 0.f;
  f32x16 O[2];
  O[0] = zero16();
  O[1] = zero16();
  const int t_lo = lat ? (2 - qblk > 0 ? 2 - qblk : 0) : 0;
  const int t_hi = lat ? (65 - qblk < 4 ? 65 - qblk : 4) : 3;
  const int nw = t_hi - t_lo + 1;
  const int ntot = lat ? nw + 8 : nw;
  const int lj = tid >> 3, lkc = (tid & 7) * 8;
  u32x4 pr0, pr1, pr2, pr3;
  pr2 = u32x4{0, 0, 0, 0};
  pr3 = u32x4{0, 0, 0, 0};
  {
    const int kp = lat ? qblk * 64 - 128 + t_lo * 64 : 0;
    const size_t o = (size_t)(tlbase + kp + lj) * 128 + kvh * 64 + lkc;
    pr0 = *(const u32x4*)(ak + o);
    pr1 = *(const u32x4*)(av + o);
  }
#pragma unroll 1
  for (int n = 0; n < ntot; ++n) {
    const bool from_cache = lat && n >= nw;
    const bool window = lat && n < nw;
    const int kpos0 = from_cache ? (n - nw) * 64 : (lat ? qblk * 64 - 128 + (t_lo + n) * 64 : n * 64);
    lds_barrier();
    {
      bf16x8 kv, vv;
      if (from_cache) {
        const f32x4v k0 = __builtin_bit_cast(f32x4v, pr0), k1 = __builtin_bit_cast(f32x4v, pr1);
        const f32x4v v0 = __builtin_bit_cast(f32x4v, pr2), v1 = __builtin_bit_cast(f32x4v, pr3);
#pragma unroll
        for (int e = 0; e < 4; ++e) {
          kv[e] = (short)f2bf(k0[e]);
          kv[4 + e] = (short)f2bf(k1[e]);
          vv[e] = (short)f2bf(v0[e]);
          vv[4 + e] = (short)f2bf(v1[e]);
        }
      } else {
        kv = __builtin_bit_cast(bf16x8, pr0);
        vv = __builtin_bit_cast(bf16x8, pr1);
      }
      *(bf16x8*)(Ks + lj * 72 + lkc) = kv;
#pragma unroll
      for (int jj = 0; jj < 8; ++jj) VT[(lkc + jj) * 68 + lj] = (bf16)vv[jj];
    }
    lds_barrier();
    {
      const int nn = n + 1 < ntot ? n + 1 : n;
      if (lat && nn >= nw) {
        const size_t o = ((((size_t)bglob * 4 + layer) * 512 + (nn - nw) * 64 + lj) * 2 + kvh) * 64 + lkc;
        pr0 = *(const u32x4*)(p.cache_k + o);
        pr1 = *(const u32x4*)(p.cache_k + o + 4);
        pr2 = *(const u32x4*)(p.cache_v + o);
        pr3 = *(const u32x4*)(p.cache_v + o + 4);
      } else {
        const int kp = lat ? qblk * 64 - 128 + (t_lo + nn) * 64 : nn * 64;
        const size_t o = (size_t)(tlbase + kp + lj) * 128 + kvh * 64 + lkc;
        pr0 = *(const u32x4*)(ak + o);
        pr1 = *(const u32x4*)(av + o);
      }
    }
    f32x16 sc[2];
#pragma unroll
    for (int sub = 0; sub < 2; ++sub) {
      sc[sub] = zero16();
#pragma unroll
      for (int ks = 0; ks < 4; ++ks) {
        const bf16x8 a = *(const bf16x8*)(Ks + (sub * 32 + r) * 72 + ks * 16 + hh * 8);
        sc[sub] = MFMA(a, bq[ks], sc[sub]);
      }
    }
    float mx = -3.0e38f;
#pragma unroll
    for (int sub = 0; sub < 2; ++sub)
#pragma unroll
      for (int i = 0; i < 16; ++i) {
        float sv = sc[sub][i] * SC;
        if (window) {
          const int diff = qi - (kpos0 + sub * 32 + crow(i, hh));
          if (diff > 128 || diff < -128) sv = -1e30f;
        }
        sc[sub][i] = sv;
        mx = fmaxf(mx, sv);
      }
    mx = fmaxf(mx, __shfl_xor(mx, 32));
    const float mnew = fmaxf(m, mx);
    const float alpha = __builtin_amdgcn_exp2f(m - mnew);
    m = mnew;
    float ps = 0.f;
#pragma unroll
    for (int sub = 0; sub < 2; ++sub)
#pragma unroll
      for (int i = 0; i < 16; ++i) {
        sc[sub][i] = __builtin_amdgcn_exp2f(sc[sub][i] - m);
        ps += sc[sub][i];
      }
    lsum = lsum * alpha + ps;
    if (__builtin_amdgcn_ballot_w64(alpha != 1.f) != 0) {
#pragma unroll
      for (int i = 0; i < 16; ++i) {
        O[0][i] *= alpha;
        O[1][i] *= alpha;
      }
    }
#pragma unroll
    for (int sub = 0; sub < 2; ++sub)
#pragma unroll
      for (int st = 0; st < 2; ++st) {
        const bf16x8 pf = pack8(sc[sub], st);
#pragma unroll
        for (int mi = 0; mi < 2; ++mi) {
          const bf16* vp = VT + (mi * 32 + r) * 68 + sub * 32 + 16 * st + 4 * hh;
          const bf16x4 lo = *(const bf16x4*)vp, hi = *(const bf16x4*)(vp + 8);
          const bf16x8 va = __builtin_shufflevector(lo, hi, 0, 1, 2, 3, 4, 5, 6, 7);
          O[mi] = MFMA(va, pf, O[mi]);
        }
      }
  }
  const float ltot = lsum + __shfl_xor(lsum, 32) + exp2f(sink2 - m);
  const float inv = 1.f / ltot;
#pragma unroll
  for (int mi = 0; mi < 2; ++mi)
#pragma unroll
    for (int g4 = 0; g4 < 4; ++g4) {
      bf16* gp = ag + (size_t)tlq * 512 + head * 64 + mi * 32 + 8 * g4 + 4 * hh;
      const bf16x4 gv = *(const bf16x4*)gp;
      bf16x4 o;
#pragma unroll
      for (int j = 0; j < 4; ++j) o[j] = (short)f2bf(O[mi][4 * g4 + j] * inv * siluf(bf2f((bf16)gv[j])));
      *(bf16x4*)gp = o;
    }
}

DI void ret_item(const Params& p, int layer, bool lat, int NC, int tlbase, int bglob, int hd, char* smem) {
  const int tid = otid(), lane = tid & 63, wave = tid >> 6;
  const int dir = wave >> 2, w4 = wave & 3, r = lane & 31, hh = lane >> 5, dt = tid & 255;
  bf16* Ks = (bf16*)smem + dir * 31232;
  bf16* KdT = Ks + 128 * 72;
  bf16* VT = KdT + 64 * 136;
  bf16* ST = VT + 64 * 136;
  const bf16* rq = (const bf16*)(p.ws + OFF_RQ);
  const bf16* rk = (const bf16*)(p.ws + OFF_RK);
  const bf16* rv = (const bf16*)(p.ws + OFF_RV);
  bf16* rg = (bf16*)(p.ws + OFF_RG);
  bf16* ofb = (bf16*)(p.ws + OFF_OFB);
  const float theta = p.ret_theta[(layer * 2 + dir) * 8 + hd];
  const float lg2 = -log1pf(expf(-theta)) * LOG2E;
  const float cdec = exp2f(lg2 * 128.f);
  const int etile = w4 >> 1, dtile = w4 & 1;
  f32x16 Sacc;
  if (lat) {
    const float* s0 = p.state_ret + ((((size_t)bglob * 4 + layer) * 2 + dir) * 8 + hd) * 4096;
#pragma unroll
    for (int i = 0; i < 16; ++i) Sacc[i] = s0[(dtile * 32 + r) * 64 + etile * 32 + crow(i, hh)];
  } else {
    Sacc = zero16();
  }
  __syncthreads();
#pragma unroll
  for (int i = 0; i < 16; ++i) ST[(etile * 32 + crow(i, hh)) * 72 + dtile * 32 + r] = f2bf(Sacc[i]);
#pragma unroll 1
  for (int step = 0; step < NC; ++step) {
    const int ch = dir ? NC - 1 - step : step;
    const int tl0 = tlbase + ch * 128;
    const int iq = w4 * 32 + r, tlq = tl0 + iq;
    const bool second = step >= NC / 2;
    bf16x8 kv[4], vv[4], bq[4];
    bf16x4 pp[8], pg[8];
    const int jrow = dt & 127;
#pragma unroll
    for (int i = 0; i < 4; ++i) {
      const int kc = ((dt >> 7) + 2 * i) * 8;
      const size_t o = (size_t)(tl0 + jrow) * 512 + hd * 64 + kc;
      kv[i] = *(const bf16x8*)(rk + o);
      vv[i] = *(const bf16x8*)(rv + o);
    }
#pragma unroll
    for (int ks = 0; ks < 4; ++ks) bq[ks] = *(const bf16x8*)(rq + (size_t)tlq * 512 + hd * 64 + ks * 16 + hh * 8);
    if (second) {
#pragma unroll
      for (int mi = 0; mi < 2; ++mi)
#pragma unroll
        for (int g4 = 0; g4 < 4; ++g4) {
          const size_t o = (size_t)tlq * 512 + hd * 64 + mi * 32 + 8 * g4 + 4 * hh;
          pp[mi * 4 + g4] = *(const bf16x4*)(ofb + o);
          pg[mi * 4 + g4] = *(const bf16x4*)(rg + o);
        }
    } else {
#pragma unroll
      for (int i = 0; i < 8; ++i) {
        pp[i] = bf16x4{0, 0, 0, 0};
        pg[i] = bf16x4{0, 0, 0, 0};
      }
    }
    {
      const float kd = exp2f(lg2 * (float)(dir ? jrow : 127 - jrow)) * 0.125f;
#pragma unroll
      for (int i = 0; i < 4; ++i) {
        const int kc = ((dt >> 7) + 2 * i) * 8;
        *(bf16x8*)(Ks + jrow * 72 + kc) = kv[i];
#pragma unroll
        for (int jj = 0; jj < 8; ++jj) {
          KdT[(kc + jj) * 136 + jrow] = f2bf(bf2f((bf16)kv[i][jj]) * kd);
          VT[(kc + jj) * 136 + jrow] = (bf16)vv[i][jj];
        }
      }
    }
    __syncthreads();
    f32x16 O[2];
    {
      const float qd = exp2f(lg2 * (float)(dir ? 128 - iq : iq + 1));
#pragma unroll
      for (int mi = 0; mi < 2; ++mi) {
        f32x16 oc = zero16();
#pragma unroll
        for (int ks = 0; ks < 4; ++ks) {
          const bf16x8 a = *(const bf16x8*)(ST + (mi * 32 + r) * 72 + ks * 16 + hh * 8);
          oc = MFMA(a, bq[ks], oc);
        }
#pragma unroll
        for (int i = 0; i < 16; ++i) O[mi][i] = oc[i] * qd;
      }
    }
#pragma unroll 1
    for (int jt = 0; jt < 4; ++jt) {
      if (dir == 0 ? (jt <= w4) : (jt >= w4)) {
        f32x16 s = zero16();
#pragma unroll
        for (int ks = 0; ks < 4; ++ks) {
          const bf16x8 a = *(const bf16x8*)(Ks + (jt * 32 + r) * 72 + ks * 16 + hh * 8);
          s = MFMA(a, bq[ks], s);
        }
#pragma unroll
        for (int i = 0; i < 16; ++i) {
          const int j = jt * 32 + crow(i, hh);
          const int diff = dir ? j - iq : iq - j;
          s[i] = diff >= 0 ? s[i] * 0.125f * __builtin_amdgcn_exp2f(lg2 * (float)diff) : 0.f;
        }
#pragma unroll
        for (int st = 0; st < 2; ++st) {
          const bf16x8 pf = pack8(s, st);
#pragma unroll
          for (int mi = 0; mi < 2; ++mi) {
            const bf16* vp = VT + (mi * 32 + r) * 136 + jt * 32 + 16 * st + 4 * hh;
            const bf16x4 lo = *(const bf16x4*)vp, hi = *(const bf16x4*)(vp + 8);
            const bf16x8 va = __builtin_shufflevector(lo, hi, 0, 1, 2, 3, 4, 5, 6, 7);
            O[mi] = MFMA(va, pf, O[mi]);
          }
        }
      }
    }
#pragma unroll
    for (int i = 0; i < 16; ++i) Sacc[i] *= cdec;
#pragma unroll 2
    for (int jk = 0; jk < 8; ++jk) {
      const bf16x8 a = *(const bf16x8*)(VT + (etile * 32 + r) * 136 + jk * 16 + hh * 8);
      const bf16x8 bb = *(const bf16x8*)(KdT + (dtile * 32 + r) * 136 + jk * 16 + hh * 8);
      Sacc = MFMA(a, bb, Sacc);
    }
    if (!second) {
#pragma unroll
      for (int mi = 0; mi < 2; ++mi)
#pragma unroll
        for (int g4 = 0; g4 < 4; ++g4) {
          bf16x4 o;
#pragma unroll
          for (int j = 0; j < 4; ++j) o[j] = (short)f2bf(O[mi][4 * g4 + j]);
          *(bf16x4*)(ofb + (size_t)tlq * 512 + hd * 64 + mi * 32 + 8 * g4 + 4 * hh) = o;
        }
    } else {
      float ss = 0.f;
#pragma unroll
      for (int mi = 0; mi < 2; ++mi)
#pragma unroll
        for (int g4 = 0; g4 < 4; ++g4) {
          const bf16x4 pv = pp[mi * 4 + g4];
#pragma unroll
          for (int j = 0; j < 4; ++j) {
            const float v = O[mi][4 * g4 + j] + bf2f((bf16)pv[j]);
            O[mi][4 * g4 + j] = v;
            ss += v * v;
          }
        }
      ss += __shfl_xor(ss, 32);
      const float rn = rsqrtf(ss * (1.f / 64.f) + 1e-6f);
#pragma unroll
      for (int mi = 0; mi < 2; ++mi)
#pragma unroll
        for (int g4 = 0; g4 < 4; ++g4) {
          const int e0 = hd * 64 + mi * 32 + 8 * g4 + 4 * hh;
          bf16* gp = rg + (size_t)tlq * 512 + e0;
          const bf16x4 gv = pg[mi * 4 + g4];
          const float4 gn = *(const float4*)(p.ret_gn + layer * 512 + e0);
          bf16x4 o;
          o[0] = (short)f2bf(O[mi][4 * g4 + 0] * rn * gn.x * siluf(bf2f((bf16)gv[0])));
          o[1] = (short)f2bf(O[mi][4 * g4 + 1] * rn * gn.y * siluf(bf2f((bf16)gv[1])));
          o[2] = (short)f2bf(O[mi][4 * g4 + 2] * rn * gn.z * siluf(bf2f((bf16)gv[2])));
          o[3] = (short)f2bf(O[mi][4 * g4 + 3] * rn * gn.w * siluf(bf2f((bf16)gv[3])));
          *(bf16x4*)gp = o;
        }
    }
    __builtin_amdgcn_fence(__ATOMIC_SEQ_CST, "workgroup");
    __syncthreads();
#pragma unroll
    for (int i = 0; i < 16; ++i) ST[(etile * 32 + crow(i, hh)) * 72 + dtile * 32 + r] = f2bf(Sacc[i]);
  }
  if (!lat) {
    float* so = p.out + OUT_ST + ((((size_t)bglob * 4 + layer) * 2 + dir) * 8 + hd) * 4096;
#pragma unroll
    for (int i = 0; i < 16; ++i) so[(dtile * 32 + r) * 64 + etile * 32 + crow(i, hh)] = Sacc[i];
  }
}

DI void p2(const Params& p, int layer, int grp, char* smem, int* s_item) {
  int* ctr = (int*)(p.ws + OFF_CTR) + layer * 2 + grp;
  const int n_rl = 32, n_hl = 512, n_al = 512;
  const int n_hc = grp ? 0 : 512, n_rc = grp ? 0 : 256, n_ac = grp ? 0 : 256;
  const int total = n_rl + n_hl + n_al + n_hc + n_rc + n_ac;
  const int latbase = grp ? 0 : T_CTX;
  const int latb0 = grp ? 4 : 0;
  for (;;) {
    __syncthreads();
    if (threadIdx.x == 0) *s_item = atomicAdd(ctr, 1);
    __syncthreads();
    int it = *s_item;
    if (it >= total) break;
    if (it < n_rl) {
      const int b = it >> 3, hd = it & 7;
      ret_item(p, layer, true, 32, latbase + b * 4096, latb0 + b, hd, smem);
      continue;
    }
    it -= n_rl;
    if (it < n_hl) { hyena_item<4, 4096>(p, layer, 0, latbase, it, smem); continue; }
    it -= n_hl;
    if (it < n_al) {
      const int b = it >> 7, kvh = (it >> 6) & 1, qb = it & 63;
      attn_item(p, layer, true, latbase + b * 4096, latb0 + b, kvh, qb, smem);
      continue;
    }
    it -= n_al;
    if (it < n_hc) { hyena_item<32, 256>(p, layer, 1, 0, it, smem); continue; }
    it -= n_hc;
    if (it < n_rc) {
      const int b = it >> 3, hd = it & 7;
      ret_item(p, layer, false, 2, b * 256, b, hd, smem);
      continue;
    }
    it -= n_rc;
    {
      const int b = it >> 3, kvh = (it >> 2) & 1, qb = it & 3;
      attn_item(p, layer, false, b * 256, b, kvh, qb, smem);
    }
  }
}

DI unsigned pk2(float a, float b) { return (unsigned)f2bf(a) | ((unsigned)f2bf(b) << 16); }
DI float pklo(unsigned u) { return __uint_as_float(u << 16); }
DI float pkhi(unsigned u) { return __uint_as_float(u & 0xffff0000u); }
DI void p3a(const Params& p, int layer, int grp, char* smem) {
  const int tgn = grp ? 16384 : TG;
  const int mtiles = tgn / 256, ntot = mtiles * 8;
  const int tid = otid(), lane = tid & 63, wave = tid >> 6;
  const int wm = wave >> 1, wn = wave & 1, r = lane & 31, h = lane >> 5;
  const bf16* H = (const bf16*)(p.ws + OFF_H);
  const bf16* wl = (const bf16*)(p.ws + OFF_W) + (size_t)layer * W_LAYER;
  bf16* MG = (bf16*)(p.ws + OFF_MERGED);
  u32x4 ra[2][4], rb[2][2];
  bool pre = false;
  const bf16* YaT = (const bf16*)(p.ws + OFF_YA);
  for (int id = blockIdx.x; id < ntot; id += gridDim.x) {
    const int m0 = ((id >> 7) * 16 + (id & 15)) * 256, n0 = ((id & 127) >> 4) * 128;
    const int idn = id + gridDim.x;
    const bool hn = idn < ntot;
    const int m0n = ((idn >> 7) * 16 + (idn & 15)) * 256, n0n = ((idn & 127) >> 4) * 128;
    unsigned mgp[2][2][8];
#pragma unroll
    for (int a = 0; a < 2; ++a)
#pragma unroll
      for (int b = 0; b < 2; ++b)
#pragma unroll
        for (int i = 0; i < 8; ++i) mgp[a][b][i] = 0u;
#pragma unroll 1
    for (int br = 0; br < 3; ++br) {
      const GemmSrc gate = mksrc(H + (size_t)m0 * 1024, 1024, wl + W_MG + (size_t)(br * 1024 + n0) * 1024, 1024, 0);
      const bf16* WB = wl + (br == 0 ? W_A : br == 1 ? W_B : W_C);
      const GemmSrc bsrc = br == 0 ? mksrc(YaT + m0, TG, WB + (size_t)n0 * 512, 512, 1)
                                   : mksrc((const bf16*)(p.ws + (br == 1 ? OFF_AG : OFF_RG)) + (size_t)m0 * 512, 512, WB + (size_t)n0 * 512, 512, 0);
      const GemmSrc after = br < 2 ? mksrc(H + (size_t)m0 * 1024, 1024, wl + W_MG + (size_t)((br + 1) * 1024 + n0) * 1024, 1024, 0)
                                   : mksrc(H + (size_t)m0n * 1024, 1024, wl + W_MG + (size_t)n0n * 1024, 1024, 0);
      unsigned sg[2][2][8];
      {
        f32x16 ag[2][2];
#pragma unroll
        for (int a = 0; a < 2; ++a)
#pragma unroll
          for (int b = 0; b < 2; ++b) ag[a][b] = zero16();
        gemm_main<2, false>(gate, 1024, ag, smem, ra, rb, false, bsrc, false);
#pragma unroll
        for (int ni = 0; ni < 2; ++ni) {
          const float bias = p.b_merge[layer * 3072 + br * 1024 + n0 + wn * 64 + ni * 32 + r];
#pragma unroll
          for (int mi = 0; mi < 2; ++mi) {
#pragma unroll
            for (int i = 0; i < 8; ++i)
              sg[mi][ni][i] = pk2(sigmf(ag[mi][ni][2 * i] + bias), sigmf(ag[mi][ni][2 * i + 1] + bias));
            __builtin_amdgcn_sched_barrier(0);
          }
        }
      }
      f32x16 ay[2][2];
#pragma unroll
      for (int a = 0; a < 2; ++a)
#pragma unroll
        for (int b = 0; b < 2; ++b) ay[a][b] = zero16();
      if (br == 0) gemm_main<2, true>(bsrc, 512, ay, smem, ra, rb, false, after, false);
      else gemm_main<2, false>(bsrc, 512, ay, smem, ra, rb, false, after, false);
#pragma unroll
      for (int mi = 0; mi < 2; ++mi)
#pragma unroll
        for (int ni = 0; ni < 2; ++ni) {
#pragma unroll
          for (int i = 0; i < 8; ++i) {
            const float lo = pklo(mgp[mi][ni][i]) + pklo(sg[mi][ni][i]) * ay[mi][ni][2 * i];
            const float hi = pkhi(mgp[mi][ni][i]) + pkhi(sg[mi][ni][i]) * ay[mi][ni][2 * i + 1];
            mgp[mi][ni][i] = pk2(lo, hi);
          }
          __builtin_amdgcn_sched_barrier(0);
        }
    }
    {
      const int t2 = otid(), l2 = t2 & 63, w2 = t2 >> 6;
      const int wm2 = w2 >> 1, wn2 = w2 & 1, r2 = l2 & 31, h2 = l2 >> 5;
#pragma unroll
      for (int mi = 0; mi < 2; ++mi)
#pragma unroll
        for (int ni = 0; ni < 2; ++ni)
#pragma unroll
          for (int i = 0; i < 8; ++i) {
            bf16* d = MG + (size_t)(m0 + wm2 * 64 + mi * 32) * 1024 + n0 + wn2 * 64 + ni * 32 + r2;
            d[(size_t)crow(2 * i, h2) * 1024] = (bf16)(mgp[mi][ni][i] & 0xffffu);
            d[(size_t)crow(2 * i + 1, h2) * 1024] = (bf16)(mgp[mi][ni][i] >> 16);
          }
    }
  }
}

DI void p3b(const Params& p, int layer, int grp, char* smem) {
  const int g0 = grp ? TG : 0, tgn = grp ? 16384 : TG;
  const int mtiles = tgn / 256, ntot = mtiles * 8;
  const int tid = otid(), lane = tid & 63, wave = tid >> 6;
  const int wm = wave >> 1, wn = wave & 1, r = lane & 31, h = lane >> 5;
  const bf16* MG = (const bf16*)(p.ws + OFF_MERGED);
  const bf16* WoT = (const bf16*)(p.ws + OFF_W) + (size_t)layer * W_LAYER + W_O;
  const float* mods = (const float*)(p.ws + OFF_MODS);
  u32x4 ra[2][4], rb[2][2];
  bool pre = false;
  for (int id = blockIdx.x; id < ntot; id += gridDim.x) {
    const int band = id >> 7, rem = id & 127;
    const int mt = band * 16 + (rem & 15), nt = rem >> 4;
    const int m0 = mt * 256, n0 = nt * 128;
    const int idn = id + gridDim.x;
    const bool hn = idn < ntot;
    const int m0n = ((idn >> 7) * 16 + (idn & 15)) * 256, n0n = ((idn & 127) >> 4) * 128;
    f32x16 acc[2][2];
#pragma unroll
    for (int a = 0; a < 2; ++a)
#pragma unroll
      for (int b = 0; b < 2; ++b) acc[a][b] = zero16();
    gemm_main<2, false>(mksrc(MG + (size_t)m0 * 1024, 1024, WoT + (size_t)n0 * 1024, 1024, 0), 1024, acc, smem, ra, rb, pre,
                        mksrc(MG + (size_t)m0n * 1024, 1024, WoT + (size_t)n0n * 1024, 1024, 0), hn);
    pre = true;
    const int tg0 = g0 + m0;
    const float* gate = mods + (layer * 9 + cond_of(tg0)) * 3072 + 2048;
    const float *qxp = launder(p.x_prompt), *qxs = launder(p.x_sample), *qo = launder(p.out);
    const float* xsb = layer == 0 ? (tg0 < T_CTX ? qxp + (size_t)tg0 * DM : qxs + (size_t)(tg0 - T_CTX) * DM) : qo + (size_t)tg0 * DM;
    float* xdb = p.out + (size_t)tg0 * DM;
#pragma unroll
    for (int ni = 0; ni < 2; ++ni) {
      const int col = n0 + wn * 64 + ni * 32 + r;
      const float gt = gate[col];
#pragma unroll
      for (int mi = 0; mi < 2; ++mi)
#pragma unroll
        for (int i = 0; i < 16; ++i) {
          const int ro = (wm * 64 + mi * 32 + crow(i, h)) * DM + col;
          xdb[ro] = xsb[ro] + gt * acc[mi][ni][i];
        }
    }
  }
}

DI void final_norm(const Params& p) {
  const int tid_ = otid();
  const int lane = tid_ & 63, wave = tid_ >> 6;
  for (int it = blockIdx.x; it < T_ALL / 8; it += gridDim.x) {
    const int tg = it * 8 + wave;
    float* x = p.out + (size_t)tg * DM;
    float4 v[4];
    float ss = 0.f;
#pragma unroll
    for (int i = 0; i < 4; ++i) {
      v[i] = *(const float4*)(x + (lane + 64 * i) * 4);
      ss += v[i].x * v[i].x + v[i].y * v[i].y + v[i].z * v[i].z + v[i].w * v[i].w;
    }
#pragma unroll
    for (int o = 32; o > 0; o >>= 1) ss += __shfl_xor(ss, o);
    const float rstd = rsqrtf(ss * (1.f / 1024.f) + 1e-6f);
#pragma unroll
    for (int i = 0; i < 4; ++i) {
      const int col = (lane + 64 * i) * 4;
      const float4 w = *(const float4*)(p.final_w + col);
      *(float4*)(x + col) = make_float4(v[i].x * rstd * w.x, v[i].y * rstd * w.y, v[i].z * rstd * w.z, v[i].w * rstd * w.w);
    }
  }
}


#define XB_TMO 128
#define XB_XCNT(j) (256 + 64 * (j))
#define XB_XSUB(j) (1280 + 64 * (j))
#define XB_XGEN(j) (2304 + 64 * (j))
#define XB_TOP 3328
#define XB_TOPGEN 3392
#define XB_SPIN_CAP (1u << 22)
DI unsigned xb_ld(unsigned* p) { return __hip_atomic_load(p, __ATOMIC_RELAXED, __HIP_MEMORY_SCOPE_AGENT); }
DI unsigned xb_add(unsigned* p, unsigned v) { return __hip_atomic_fetch_add(p, v, __ATOMIC_RELAXED, __HIP_MEMORY_SCOPE_AGENT); }
DI unsigned xb_xcc_id() { return (unsigned)__builtin_amdgcn_s_getreg((3 << 11) | 20) & 0xFu; }
#define XB_SPIN(cond, bar)                                          \
  do {                                                              \
    unsigned _sp = 0;                                               \
    while (cond) {                                                  \
      __builtin_amdgcn_s_sleep(1);                                  \
      if ((++_sp & 255u) == 0u) {                                   \
        if (xb_ld(&(bar)[XB_TMO])) break;                           \
        if (_sp > XB_SPIN_CAP) {                                    \
          atomicAdd(&(bar)[XB_TMO], 1u);                            \
          break;                                                    \
        }                                                           \
      }                                                             \
    }                                                               \
  } while (0)
struct XcdBarrier {
  unsigned* bar;
  unsigned x;
  volatile unsigned* st;
};
DI void xcd_barrier_complete(unsigned* bar, unsigned x, unsigned& nloc, unsigned& nx) {
  const unsigned G = gridDim.x;
  unsigned sum, cnt, mine, sp = 0u;
  for (;;) {
    sum = 0u; cnt = 0u; mine = 0u;
#pragma unroll
    for (unsigned j = 0; j < 16; ++j) {
      const unsigned c = xb_ld(&bar[XB_XCNT(j)]);
      sum += c;
      cnt += (c > 0u) ? 1u : 0u;
      mine = (j == x) ? c : mine;
    }
    if (sum == G) break;
    __builtin_amdgcn_s_sleep(1);
    if ((++sp & 255u) == 0u) {
      if (xb_ld(&bar[XB_TMO])) break;
      if (sp > XB_SPIN_CAP) { atomicAdd(&bar[XB_TMO], 1u); break; }
    }
  }
  nloc = mine > 0u ? mine : 1u;
  nx = cnt > 0u ? cnt : 1u;
}
DI void xcd_barrier(char* ws, volatile unsigned* st) {
  asm volatile("" : "+s"(ws));
  XcdBarrier b;
  b.bar = (unsigned*)(ws + OFF_BAR);
  b.x = xb_xcc_id();
  b.st = st;
  asm volatile("s_waitcnt vmcnt(0)" ::: "memory");
  __syncthreads();
  if (threadIdx.x == 0) {
    unsigned* bar = b.bar;
    __builtin_amdgcn_s_waitcnt(0);
    unsigned nloc = b.st[0], nx = b.st[1];
    if (nloc == 0u) {
      xcd_barrier_complete(bar, b.x, nloc, nx);
      b.st[0] = nloc;
      b.st[1] = nx;
    }
    const unsigned old = xb_add(&bar[XB_XSUB(b.x)], 1u);
    const unsigned gen = old / nloc;
    if (old + 1u == (gen + 1u) * nloc) {
      __builtin_amdgcn_fence(__ATOMIC_RELEASE, "agent");
      asm volatile("s_waitcnt vmcnt(0)" ::: "memory");
      const unsigned og = xb_add(&bar[XB_TOP], 1u);
      const unsigned tg = og / nx;
      if (og + 1u == (tg + 1u) * nx) xb_add(&bar[XB_TOPGEN], 1u);
      else XB_SPIN(xb_ld(&bar[XB_TOPGEN]) == tg, bar);
      __builtin_amdgcn_fence(__ATOMIC_ACQUIRE, "agent");
      xb_add(&bar[XB_XGEN(b.x)], 1u);
      asm volatile("s_waitcnt vmcnt(0)" ::: "memory");
    } else {
      XB_SPIN(xb_ld(&bar[XB_XGEN(b.x)]) == gen, bar);
      __builtin_amdgcn_fence(__ATOMIC_ACQUIRE, "agent");
      asm volatile("s_waitcnt vmcnt(0)" ::: "memory");
    }
  }
  __syncthreads();
}

__global__ void __launch_bounds__(512) mega(Params p) {
  __shared__ __attribute__((aligned(16))) char smem[SMEM_BYTES];
  __shared__ __attribute__((aligned(16))) unsigned xb_words[4];
  __shared__ int s_item;
  cg::grid_group grid = cg::this_grid();
  if (threadIdx.x == 0) { xb_words[0] = 0u; xb_words[1] = 0u; xb_words[2] = 0u; xb_words[3] = 0u; }
  __syncthreads();
  if (threadIdx.x == 0) (void)xb_add(&((unsigned*)(p.ws + OFF_BAR))[XB_XCNT(xb_xcc_id())], 1u);
  phase0(p, smem);
  grid.sync();
#pragma unroll 1
  for (int layer = 0; layer < DEPTH; ++layer) {
#pragma unroll 1
    for (int grp = 0; grp < 2; ++grp) {
      int ly = layer, gp = grp;
      asm volatile("" : "+s"(ly), "+s"(gp));
      p1a(p, ly, gp, smem);
      xcd_barrier(p.ws, xb_words);
      asm volatile("" : "+s"(ly), "+s"(gp));
      p1b(p, ly, gp, smem);
      xcd_barrier(p.ws, xb_words);
      asm volatile("" : "+s"(ly), "+s"(gp));
      p2(p, ly, gp, smem, &s_item);
      xcd_barrier(p.ws, xb_words);
      asm volatile("" : "+s"(ly), "+s"(gp));
      p3a(p, ly, gp, smem);
      xcd_barrier(p.ws, xb_words);
      asm volatile("" : "+s"(ly), "+s"(gp));
      p3b(p, ly, gp, smem);
      xcd_barrier(p.ws, xb_words);
    }
  }
  final_norm(p);
}

extern "C" void kernel_launch(void* const* d_in, const int* in_sizes, int n_in, void* d_out, int out_size, void* d_ws,
                              size_t ws_size, hipStream_t stream) {
  static int grid_blocks = 0;
  if (!grid_blocks) {
    int dev = 0, cus = 0, per_cu = 0;
    hipGetDevice(&dev);
    hipDeviceGetAttribute(&cus, hipDeviceAttributeMultiprocessorCount, dev);
    hipOccupancyMaxActiveBlocksPerMultiprocessor(&per_cu, mega, 512, 0);
    if (per_cu < 1) per_cu = 1;
    if (per_cu > 1) per_cu = 1;
    grid_blocks = cus * per_cu;
  }
  Params p{};
  const float** pp = (const float**)&p;
  for (int i = 0; i < 27; ++i) pp[i] = (const float*)d_in[i];
  p.out = (float*)d_out;
  p.ws = (char*)d_ws;
  if (ws_size < WS_NEEDED) fprintf(stderr, "workspace too small: %zu < %zu\n", ws_size, (size_t)WS_NEEDED);
  hipMemsetAsync(d_ws, 0, ZERO_BYTES, stream);
  void* args[] = {&p};
  hipError_t e = hipLaunchCooperativeKernel((void*)mega, dim3(grid_blocks), dim3(512), args, 0, stream);
  if (e != hipSuccess) fprintf(stderr, "cooperative launch failed: %s (grid %d)\n", hipGetErrorString(e), grid_blocks);
}
```

```cpp
#include <hip/hip_runtime.h>
#include <hip/hip_cooperative_groups.h>
#include <cstdio>
namespace cg = cooperative_groups;

#define DI __device__ __forceinline__
typedef unsigned short bf16;
typedef __attribute__((ext_vector_type(8))) short bf16x8;
typedef __attribute__((ext_vector_type(4))) short bf16x4;
typedef __attribute__((ext_vector_type(16))) float f32x16;
typedef __attribute__((ext_vector_type(4))) unsigned u32x4;
typedef __attribute__((ext_vector_type(4))) float f32x4v;
#define MFMA(a, b, c) __builtin_amdgcn_mfma_f32_32x32x16_bf16((a), (b), (c), 0, 0, 0)

constexpr int DM = 1024;
constexpr int DEPTH = 4;
constexpr int T_CTX = 8192;
constexpr int T_ALL = 40960;
constexpr int TG = 24576;
constexpr int IN_DIM = 5376;
constexpr float LOG2E = 1.4426950408889634f;

constexpr size_t OFF_MODS = 0;
constexpr size_t OFF_FSUM = 458752;
constexpr size_t OFF_CTR = 491520;
constexpr size_t OFF_BAR = 495616;
constexpr size_t ZERO_BYTES = 524288;
constexpr size_t OFF_ROPE = ZERO_BYTES;
constexpr size_t OFF_W = OFF_ROPE + 1048576;
constexpr size_t W_IN = 0, W_MG = 5505024, W_A = 8650752, W_B = 9175040, W_C = 9699328, W_O = 10223616, W_LAYER = 11272192;
constexpr size_t OFF_GL = OFF_W + W_LAYER * 2 * 4;
constexpr size_t OFF_GC = OFF_GL + 33554432;
constexpr size_t OFF_H = OFF_GC + 2097152;
constexpr size_t OFF_HYT = OFF_H + (size_t)TG * 2048;
constexpr size_t OFF_AQ = OFF_HYT + (size_t)TG * 4096;
constexpr size_t OFF_AK = OFF_AQ + (size_t)TG * 1024;
constexpr size_t OFF_AV = OFF_AK + (size_t)TG * 256;
constexpr size_t OFF_AG = OFF_AV + (size_t)TG * 256;
constexpr size_t OFF_RQ = OFF_AG + (size_t)TG * 1024;
constexpr size_t OFF_RK = OFF_RQ + (size_t)TG * 1024;
constexpr size_t OFF_RV = OFF_RK + (size_t)TG * 1024;
constexpr size_t OFF_RG = OFF_RV + (size_t)TG * 1024;
constexpr size_t OFF_YA = OFF_RG + (size_t)TG * 1024;
constexpr size_t OFF_OFB = OFF_YA + (size_t)TG * 1024;
constexpr size_t WS_NEEDED = OFF_OFB + (size_t)TG * 1024;
constexpr size_t OFF_MERGED = OFF_RQ;

constexpr size_t OUT_CK = 41943040, OUT_CV = 46137344, OUT_ST = 50331648;

constexpr int SMEM_BYTES = 135168;

struct Params {
  const float *x_prompt, *x_sample, *c, *cache_k, *cache_v, *state_ret, *c_ctx, *norm_w, *w_mod, *b_mod, *w_in, *hy_conv,
      *hy_w1, *hy_b1, *hy_freq, *hy_w2, *hy_skip, *attn_sink, *ret_theta, *ret_gn, *w_a, *w_b, *w_c, *w_merge, *b_merge,
      *w_out, *final_w;
  float* out;
  char* ws;
};

DI bf16 f2bf(float x) {
  __bf16 b = (__bf16)x;
  return __builtin_bit_cast(unsigned short, b);
}
DI float bf2f(bf16 u) { return __uint_as_float(((unsigned)u) << 16); }
DI int crow(int reg, int h) { return (reg & 3) + 8 * (reg >> 2) + 4 * h; }
DI float siluf(float x) { return x / (1.f + __expf(-x)); }
DI float sigmf(float x) { return 1.f / (1.f + __expf(-x)); }
DI bf16x8 pack8(const f32x16& x, int s) {
  bf16x8 r;
#pragma unroll
  for (int j = 0; j < 8; ++j) r[j] = (short)f2bf(x[8 * s + j]);
  return r;
}
DI f32x16 zero16() {
  f32x16 z;
#pragma unroll
  for (int i = 0; i < 16; ++i) z[i] = 0.f;
  return z;
}
DI const float* launder(const float* q) {
  asm volatile("" : "+s"(q));
  return q;
}
DI int otid() {
  int t = threadIdx.x;
  asm volatile("" : "+v"(t));
  return t;
}
DI int cond_of(int tg) { return tg < T_CTX ? 0 : 1 + ((tg - T_CTX) >> 12); }

DI void lds_barrier() { asm volatile("s_waitcnt lgkmcnt(0)\n\ts_barrier" ::: "memory"); }

struct GemmSrc {
  const bf16* A;
  const bf16* B;
  int lda, ldb, atr;
};
DI GemmSrc mksrc(const bf16* A, int lda, const bf16* B, int ldb, int atr) {
  GemmSrc g;
  g.A = A; g.B = B; g.lda = lda; g.ldb = ldb; g.atr = atr;
  return g;
}
template <int NI>
DI void gemm_issue(const GemmSrc& g, int kt, int tid, u32x4 (&ra)[4], u32x4 (&rb)[NI]) {
  const int lrow = tid >> 3, lkc = (tid & 7) * 8;
  const bf16* ab = g.atr ? g.A + (size_t)(((tid >> 6) * 8 + ((tid >> 3) & 7)) + kt * 64) * g.lda + (tid & 7) * 8
                         : g.A + (size_t)lrow * g.lda + lkc + kt * 64;
  const size_t astep = g.atr ? (size_t)64 : (size_t)64 * g.lda;
#pragma unroll
  for (int i = 0; i < 4; ++i) ra[i] = *(const u32x4*)(ab + astep * i);
  const bf16* bb = g.B + (size_t)lrow * g.ldb + lkc + kt * 64;
#pragma unroll
  for (int i = 0; i < NI; ++i) rb[i] = *(const u32x4*)(bb + (size_t)(64 * i) * g.ldb);
}
template <int NI, bool ATR>
DI void gemm_stage(bf16* As, bf16* Bs, int tid, const u32x4 (&ra)[4], const u32x4 (&rb)[NI]) {
  constexpr int PITCH = 72;
  const int lrow = tid >> 3, lkc = (tid & 7) * 8;
#pragma unroll
  for (int i = 0; i < 4; ++i) {
    if (ATR) {
      const int kk = (tid >> 6) * 8 + ((tid >> 3) & 7), tc = (tid & 7) + 8 * i;
      bf16* d = As + (tc * 8) * PITCH + (kk ^ ((tid & 7) << 3));
      const bf16x8 v = __builtin_bit_cast(bf16x8, ra[i]);
#pragma unroll
      for (int e = 0; e < 8; ++e) d[e * PITCH] = (bf16)v[e];
    } else {
      *(u32x4*)(As + (lrow + 64 * i) * PITCH + lkc) = ra[i];
    }
  }
#pragma unroll
  for (int i = 0; i < NI; ++i) *(u32x4*)(Bs + (lrow + 64 * i) * PITCH + lkc) = rb[i];
}

template <int NI, bool ATR>
DI void gemm_stage_part(bf16* As, bf16* Bs, int tid, const u32x4 (&ra)[4], const u32x4 (&rb)[NI], int part) {
  constexpr int PITCH = 72;
  const int lrow = tid >> 3, lkc = (tid & 7) * 8;
#pragma unroll
  for (int i = 0; i < 4; ++i) {
    if (i != part) continue;
    if (ATR) {
      const int kk = (tid >> 6) * 8 + ((tid >> 3) & 7), tc = (tid & 7) + 8 * i;
      bf16* d = As + (tc * 8) * PITCH + (kk ^ ((tid & 7) << 3));
      const bf16x8 v = __builtin_bit_cast(bf16x8, ra[i]);
#pragma unroll
      for (int e = 0; e < 8; ++e) d[e * PITCH] = (bf16)v[e];
    } else {
      *(u32x4*)(As + (lrow + 64 * i) * PITCH + lkc) = ra[i];
    }
  }
#pragma unroll
  for (int i = 0; i < NI; ++i)
    if (2 * i == part) *(u32x4*)(Bs + (lrow + 64 * i) * PITCH + lkc) = rb[i];
}

template <int NI, bool ATR>
DI void gemm_main(const GemmSrc& cur, int K, f32x16 (&acc)[2][NI], char* smem, u32x4 (&ra)[2][4], u32x4 (&rb)[2][NI],
                  bool preloaded, const GemmSrc& nxt, bool has_next) {
  constexpr int BN = 64 * NI;
  constexpr int PITCH = 72;
  bf16* As = (bf16*)smem;
  bf16* Bs = As + 2 * 256 * PITCH;
  const int tid = otid(), lane = tid & 63, wave = tid >> 6;
  const int wm = wave >> 1, wn = wave & 1, r = lane & 31, h = lane >> 5;
  const int nk = K / 64;
  if (!preloaded) {
    gemm_issue<NI>(cur, 0, tid, ra[0], rb[0]);
    gemm_issue<NI>(cur, 1, tid, ra[1], rb[1]);
  }
  lds_barrier();
  gemm_stage<NI, ATR>(As, Bs, tid, ra[0], rb[0]);
  lds_barrier();
#pragma unroll 1
  for (int kt = 0; kt < nk; kt += 2) {
#pragma unroll
    for (int u = 0; u < 2; ++u) {
      const int k = kt + u;
      {
        const bool inr = k + 2 < nk;
        GemmSrc g = (inr || !has_next) ? cur : nxt;
        const int kk = inr ? k + 2 : (has_next ? k + 2 - nk : nk - 1);
        gemm_issue<NI>(g, kk, tid, ra[u], rb[u]);
      }
      const bf16* Ab = As + u * 256 * PITCH + (wm * 64 + r) * PITCH + h * 8;
      const bf16* Bb = Bs + u * BN * PITCH + (wn * 32 * NI + r) * PITCH + h * 8;
#pragma unroll
      for (int ks = 0; ks < 4; ++ks) {
        bf16x8 a[2], b[NI];
#pragma unroll
        for (int mi = 0; mi < 2; ++mi)
          a[mi] = ATR ? *(const bf16x8*)(Ab - h * 8 + mi * 32 * PITCH + ((ks * 16 + h * 8) ^ (((mi * 4 + (r >> 3)) & 7) << 3)))
                      : *(const bf16x8*)(Ab + mi * 32 * PITCH + ks * 16);
#pragma unroll
        for (int ni = 0; ni < NI; ++ni) b[ni] = *(const bf16x8*)(Bb + ni * 32 * PITCH + ks * 16);
#pragma unroll
        for (int mi = 0; mi < 2; ++mi)
#pragma unroll
          for (int ni = 0; ni < NI; ++ni) acc[mi][ni] = MFMA(a[mi], b[ni], acc[mi][ni]);
        gemm_stage_part<NI, ATR>(As + (u ^ 1) * 256 * PITCH, Bs + (u ^ 1) * BN * PITCH, tid, ra[u ^ 1], rb[u ^ 1], ks);
      }
      lds_barrier();
    }
  }
}

DI void p0_mod_item(const Params& p, int item, char* smem) {
  const int tid = otid();
  const int l = item / 48, rem = item % 48, nch = rem / 8, ks = rem % 8;
  float* sc = (float*)smem;
  __syncthreads();
  for (int idx = tid; idx < 9 * 128; idx += 512) {
    const int cnd = idx >> 7, k = ks * 128 + (idx & 127);
    const float *qcc = launder(p.c_ctx), *qc = launder(p.c);
    const float v = cnd == 0 ? qcc[k] : qc[(cnd - 1) * 1024 + k];
    sc[idx] = v / (1.f + expf(-v));
  }
  __syncthreads();
  const int n = nch * 512 + tid;
  float acc[9];
#pragma unroll
  for (int i = 0; i < 9; ++i) acc[i] = 0.f;
  const float* w = p.w_mod + ((size_t)l * 1024 + ks * 128) * 3072 + n;
#pragma unroll 16
  for (int kk = 0; kk < 128; ++kk) {
    const float wv = w[(size_t)kk * 3072];
#pragma unroll
    for (int i = 0; i < 9; ++i) acc[i] += sc[i * 128 + kk] * wv;
  }
  float* mods = (float*)(p.ws + OFF_MODS);
  const float bias = ks == 0 ? p.b_mod[l * 3072 + n] : 0.f;
#pragma unroll
  for (int i = 0; i < 9; ++i) atomicAdd(&mods[(l * 9 + i) * 3072 + n], acc[i] + bias);
}

DI void transpose_tile(const float* __restrict__ src, int ldn, bf16* __restrict__ dst, int ldk, int k0, int n0, char* smem) {
  float* T = (float*)smem;
  const int tid = otid();
  __syncthreads();
  {
    const int k = tid >> 3, nc = (tid & 7) * 8;
    const float* s = src + (size_t)(k0 + k) * ldn + n0 + nc;
    const float4 a = *(const float4*)s, b = *(const float4*)(s + 4);
    float* t = T + k * 65 + nc;
    t[0] = a.x; t[1] = a.y; t[2] = a.z; t[3] = a.w; t[4] = b.x; t[5] = b.y; t[6] = b.z; t[7] = b.w;
  }
  __syncthreads();
  {
    const int n = tid >> 3, kc = (tid & 7) * 8;
    bf16x8 v;
#pragma unroll
    for (int j = 0; j < 8; ++j) v[j] = (short)f2bf(T[(kc + j) * 65 + n]);
    *(bf16x8*)(dst + (size_t)(n0 + n) * ldk + k0 + kc) = v;
  }
}

DI void p0_transpose_item(const Params& p, int item, char* smem) {
  const int l = item / 2752;
  int rem = item % 2752;
  bf16* wl = (bf16*)(p.ws + OFF_W) + (size_t)l * W_LAYER;
  if (rem < 1344) {
    const int kt = rem / 84, nt = rem % 84;
    transpose_tile(p.w_in + (size_t)l * 1024 * IN_DIM, IN_DIM, wl + W_IN, 1024, kt * 64, nt * 64, smem);
    return;
  }
  rem -= 1344;
  if (rem < 768) {
    const int kt = rem / 48, nt = rem % 48;
    transpose_tile(p.w_merge + (size_t)l * 1024 * 3072, 3072, wl + W_MG, 1024, kt * 64, nt * 64, smem);
    return;
  }
  rem -= 768;
  if (rem < 384) {
    const int br = rem / 128, r2 = rem % 128, kt = r2 / 16, nt = r2 % 16;
    const float *qa = launder(p.w_a), *qb = launder(p.w_b), *qc = launder(p.w_c);
    const float* src = (br == 0 ? qa : br == 1 ? qb : qc) + (size_t)l * 512 * 1024;
    transpose_tile(src, 1024, wl + (br == 0 ? W_A : br == 1 ? W_B : W_C), 512, kt * 64, nt * 64, smem);
    return;
  }
  rem -= 384;
  {
    const int kt = rem / 16, nt = rem % 16;
    transpose_tile(p.w_out + (size_t)l * 1024 * 1024, 1024, wl + W_O, 1024, kt * 64, nt * 64, smem);
  }
}

DI void p0_rope_item(const Params& p, int item) {
  const int idx = item * 512 + otid();
  const int t = idx >> 5, f = idx & 31;
  const float inv = powf(10000.f, -(float)(f & 15) / 16.f);
  const float ang = (float)(f < 16 ? (t >> 6) : (t & 63)) * inv;
  float2 cs;
  cs.x = cosf(ang);
  cs.y = sinf(ang);
  ((float2*)(p.ws + OFF_ROPE))[idx] = cs;
}

DI void phase0(const Params& p, char* smem) {
  const int n_mod = 192, n_tr = 11008, n_rope = 256;
  for (int it = blockIdx.x; it < n_mod + n_tr + n_rope; it += gridDim.x) {
    if (it < n_mod) p0_mod_item(p, it, smem);
    else if (it < n_mod + n_tr) p0_transpose_item(p, it - n_mod, smem);
    else p0_rope_item(p, it - n_mod - n_tr);
  }
}

DI void filter_item(const Params& p, int layer, int item, char* smem) {
  const int tid = otid();
  int var, pc, cc, L;
  if (item < 512) { var = 0; pc = item >> 3; cc = item & 7; L = 4096; }
  else { var = 1; pc = (item - 512) >> 3; cc = (item - 512) & 7; L = 256; }
  float* z = (float*)smem;
  float* hid = z + 64 * 17;
  float* w2s = hid + 64 * 65;
  __syncthreads();
  {
    const int pos = tid >> 3, band = tid & 7;
    const int pa = pc * 64 + pos;
    const float w = 6.283185307179586f * (float)pa / (float)L;
    const float f = 1e-4f + (float)band * ((7.f - 1e-4f) / 7.f);
    z[pos * 17 + 1 + band] = cosf(f * w);
    z[pos * 17 + 9 + band] = -sinf(f * w);
    if (band == 0) z[pos * 17] = (float)pa / (float)(L - 1);
  }
  __syncthreads();
  {
    const int pos = tid >> 3, j0 = (tid & 7) * 8;
    const float* w1 = p.hy_w1 + layer * 17 * 64;
#pragma unroll
    for (int jj = 0; jj < 8; ++jj) {
      const int j = j0 + jj;
      float pre = p.hy_b1[layer * 64 + j];
      for (int f = 0; f < 17; ++f) pre += z[pos * 17 + f] * w1[f * 64 + j];
      hid[pos * 65 + j] = sinf(p.hy_freq[layer * 64 + j] * pre);
    }
    const float* w2 = p.hy_w2 + (size_t)layer * 64 * 2048 + cc * 256;
    for (int idx = tid; idx < 64 * 256; idx += 512) w2s[idx] = w2[(idx >> 8) * 2048 + (idx & 255)];
  }
  __syncthreads();
  {
    const int lane = tid & 63, wave = tid >> 6, r = lane & 31, hh = lane >> 5;
    f32x16 acc[2];
    acc[0] = zero16();
    acc[1] = zero16();
#pragma unroll 4
    for (int ks = 0; ks < 32; ++ks) {
      const float bv = w2s[(2 * ks + hh) * 256 + wave * 32 + r];
#pragma unroll
      for (int mi = 0; mi < 2; ++mi) {
        const float av = hid[(mi * 32 + r) * 65 + 2 * ks + hh];
        acc[mi] = __builtin_amdgcn_mfma_f32_32x32x2f32(av, bv, acc[mi], 0, 0, 0);
      }
    }
    const int n = cc * 256 + wave * 32 + r;
    const int o = n >> 10, dir = (n >> 9) & 1, c = n & 511;
    const float min_d = -3.0701134573253945f, max_d = -15.350567286626973f;
    const float ad = fabsf(min_d + (float)c * ((max_d - min_d) / 511.f));
    float* g = (float*)(p.ws + (var == 0 ? OFF_GL : OFF_GC)) + ((size_t)(o * 512 + c)) * (2 * L);
    float asum = 0.f;
#pragma unroll
    for (int mi = 0; mi < 2; ++mi)
#pragma unroll
      for (int i = 0; i < 16; ++i) {
        const int pa = pc * 64 + mi * 32 + crow(i, hh);
        const float t = (float)pa / (float)(L - 1);
        const float v = acc[mi][i] * expf(-t * ad);
        asum += fabsf(v);
        int y;
        if (dir == 0) y = L - pa;
        else y = (pa == 0) ? 0 : L + pa;
        g[y] = v;
      }
    atomicAdd((float*)(p.ws + OFF_FSUM) + ((layer * 2 + var) * 2 + o) * 512 + c, asum);
  }
}

DI void p1a(const Params& p, int layer, int grp, char* smem) {
  const int g0 = grp ? TG : 0, tgn = grp ? 16384 : TG;
  const int nfilt = grp ? 0 : 544;
  const int nrow_items = tgn / 8;
  const int tid_ = otid();
  const int lane = tid_ & 63, wave = tid_ >> 6;
  bf16* H = (bf16*)(p.ws + OFF_H);
  const float* mods = (const float*)(p.ws + OFF_MODS);
  for (int it = blockIdx.x; it < nfilt + nrow_items; it += gridDim.x) {
    if (it < nfilt) { filter_item(p, layer, it, smem); continue; }
    const int tl = (it - nfilt) * 8 + wave, tg = g0 + tl;
    const float *qxp = launder(p.x_prompt), *qxs = launder(p.x_sample), *qo = launder(p.out);
    const float* x = layer == 0 ? (tg < T_CTX ? qxp + (size_t)tg * DM : qxs + (size_t)(tg - T_CTX) * DM) : qo + (size_t)tg * DM;
    float4 v[4];
    float ss = 0.f;
#pragma unroll
    for (int i = 0; i < 4; ++i) {
      v[i] = *(const float4*)(x + (lane + 64 * i) * 4);
      ss += v[i].x * v[i].x + v[i].y * v[i].y + v[i].z * v[i].z + v[i].w * v[i].w;
    }
#pragma unroll
    for (int o = 32; o > 0; o >>= 1) ss += __shfl_xor(ss, o);
    const float rstd = rsqrtf(ss * (1.f / 1024.f) + 1e-6f);
    const float* md = mods + (layer * 9 + cond_of(tg)) * 3072;
    const float* nw = p.norm_w + layer * 1024;
#pragma unroll
    for (int i = 0; i < 4; ++i) {
      const int col = (lane + 64 * i) * 4;
      const float4 sh = *(const float4*)(md + col), sc = *(const float4*)(md + 1024 + col), w = *(const float4*)(nw + col);
      bf16x4 o;
      o[0] = (short)f2bf(v[i].x * rstd * w.x * (1.f + sc.x) + sh.x);
      o[1] = (short)f2bf(v[i].y * rstd * w.y * (1.f + sc.y) + sh.y);
      o[2] = (short)f2bf(v[i].z * rstd * w.z * (1.f + sc.z) + sh.z);
      o[3] = (short)f2bf(v[i].w * rstd * w.w * (1.f + sc.w) + sh.w);
      *(bf16x4*)(H + (size_t)tl * 1024 + col) = o;
    }
  }
}

DI void p1b(const Params& p, int layer, int grp, char* smem) {
  const int g0 = grp ? TG : 0, tgn = grp ? 16384 : TG;
  const int mtiles = tgn / 256, ntot = mtiles * 42;
  const int tid = otid(), lane = tid & 63, wave = tid >> 6;
  const int wm = wave >> 1, wn = wave & 1, r = lane & 31, h = lane >> 5;
  const bf16* H = (const bf16*)(p.ws + OFF_H);
  const bf16* WinT = (const bf16*)(p.ws + OFF_W) + (size_t)layer * W_LAYER + W_IN;
  float* S = (float*)smem;
  u32x4 ra[2][4], rb[2][2];
  bool pre = false;
  for (int id = blockIdx.x; id < ntot; id += gridDim.x) {
    const int band = id / (16 * 42), rem = id % (16 * 42);
    const int mt = band * 16 + (rem & 15), nt = rem >> 4;
    const int idn = id + gridDim.x;
    const bool hn = idn < ntot;
    const int bandn = idn / (16 * 42), remn = idn % (16 * 42);
    const int mtn = bandn * 16 + (remn & 15), ntn = remn >> 4;
    f32x16 acc[2][2];
#pragma unroll
    for (int a = 0; a < 2; ++a)
#pragma unroll
      for (int b = 0; b < 2; ++b) acc[a][b] = zero16();
    gemm_main<2, false>(mksrc(H + (size_t)mt * 256 * 1024, 1024, WinT + (size_t)nt * 128 * 1024, 1024, 0), 1024, acc, smem, ra, rb, pre,
                        mksrc(H + (size_t)mtn * 256 * 1024, 1024, WinT + (size_t)ntn * 128 * 1024, 1024, 0), hn);
    pre = true;
    const int m0 = mt * 256, tg0 = g0 + m0;
    const bool lat = tg0 >= T_CTX;
    if (nt < 16) {
#pragma unroll
      for (int mi = 0; mi < 2; ++mi)
#pragma unroll
        for (int ni = 0; ni < 2; ++ni)
#pragma unroll
          for (int g4 = 0; g4 < 4; ++g4) {
            f32x4v v;
#pragma unroll
            for (int j = 0; j < 4; ++j) v[j] = acc[mi][ni][4 * g4 + j];
            *(f32x4v*)(S + (wn * 64 + ni * 32 + r) * 260 + wm * 64 + mi * 32 + 8 * g4 + 4 * h) = v;
          }
      __syncthreads();
      const int part = nt >> 2;
#pragma unroll 2
      for (int it = 0; it < 8; ++it) {
        const int pid = tid + 512 * it, cl = pid >> 5, q = pid & 31;
        const f32x4v a = *(const f32x4v*)(S + cl * 260 + q * 8), b = *(const f32x4v*)(S + cl * 260 + q * 8 + 4);
        bf16x8 v;
#pragma unroll
        for (int j = 0; j < 4; ++j) {
          v[j] = (short)f2bf(a[j]);
          v[4 + j] = (short)f2bf(b[j]);
        }
        *(bf16x8*)((bf16*)(p.ws + OFF_HYT) + ((size_t)(part * 512 + (nt & 3) * 128 + cl)) * TG + m0 + q * 8) = v;
      }
    } else {
#pragma unroll
      for (int mi = 0; mi < 2; ++mi)
#pragma unroll
        for (int ni = 0; ni < 2; ++ni)
#pragma unroll
          for (int i = 0; i < 16; ++i) S[(wm * 64 + mi * 32 + crow(i, h)) * 132 + wn * 64 + ni * 32 + r] = acc[mi][ni][i];
      __syncthreads();
      size_t off; int pitch, coloff; bool rope = false; int cache = 0;
      if (nt < 20) { off = OFF_AQ; pitch = 512; coloff = (nt - 16) * 128; rope = lat; }
      else if (nt == 20) { off = OFF_AK; pitch = 128; coloff = 0; rope = lat; cache = lat ? 0 : 1; }
      else if (nt == 21) { off = OFF_AV; pitch = 128; coloff = 0; cache = lat ? 0 : 2; }
      else if (nt < 26) { off = OFF_AG; pitch = 512; coloff = (nt - 22) * 128; }
      else if (nt < 30) { off = OFF_RQ; pitch = 512; coloff = (nt - 26) * 128; rope = lat; }
      else if (nt < 34) { off = OFF_RK; pitch = 512; coloff = (nt - 30) * 128; rope = lat; }
      else if (nt < 38) { off = OFF_RV; pitch = 512; coloff = (nt - 34) * 128; }
      else { off = OFF_RG; pitch = 512; coloff = (nt - 38) * 128; }
      bf16* dst = (bf16*)(p.ws + off);
      const float2* rt = (const float2*)(p.ws + OFF_ROPE);
#pragma unroll 2
      for (int it = 0; it < 8; ++it) {
        const int cid = tid + 512 * it, row = cid >> 4, cc = cid & 15;
        const float* sp = S + row * 132 + cc * 8;
        float v[8];
#pragma unroll
        for (int j = 0; j < 8; ++j) v[j] = sp[j];
        if (cache) {
          float* co = p.out + (cache == 1 ? OUT_CK : OUT_CV) + ((size_t)((tg0 >> 8) * 4 + layer) * 256 + row) * 128 + cc * 8;
          *(float4*)co = make_float4(v[0], v[1], v[2], v[3]);
          *(float4*)(co + 4) = make_float4(v[4], v[5], v[6], v[7]);
        }
        if (rope) {
          const int hd0 = (cc * 8) & 63, q = hd0 >> 4;
          const int tpos = (tg0 - T_CTX + row) & 4095;
          const float2* tb = rt + tpos * 32 + (q >> 1) * 16 + (hd0 & 15);
          const float* pp = sp + ((q & 1) ? -16 : 16);
          const float sg = (q & 1) ? 1.f : -1.f;
#pragma unroll
          for (int j = 0; j < 8; ++j) {
            const float2 cs = tb[j];
            v[j] = v[j] * cs.x + sg * pp[j] * cs.y;
          }
        }
        bf16x8 o;
#pragma unroll
        for (int j = 0; j < 8; ++j) o[j] = (short)f2bf(v[j]);
        *(bf16x8*)(dst + (size_t)(m0 + row) * pitch + coloff + cc * 8) = o;
      }
    }
  }
}

template <int NBT, int L>
DI void hyena_item(const Params& p, int layer, int var, int tlbase, int c, char* smem) {
  constexpr int NP = 32 / NBT, NT = (L / 8) / (32 * NP), UP = L + 8;
  bf16* U = (bf16*)smem;
  bf16* X1 = U + NBT * UP;
  bf16* X2 = X1 + NBT * UP;
  bf16* GR = X2 + NBT * UP;
  bf16* GR1 = GR + 2 * L + 8;
  const int tid = otid(), lane = tid & 63, wave = tid >> 6;
  const int n = lane & 31, hh = lane >> 5, b = n & (NBT - 1), pp = n / NBT;
  const bf16* hyT = (const bf16*)(p.ws + OFF_HYT);
  const float* fs = (const float*)(p.ws + OFF_FSUM) + (layer * 2 + var) * 1024;
  const float* gsrc = (const float*)(p.ws + (var == 0 ? OFF_GL : OFF_GC));
  __syncthreads();
#pragma unroll 1
  for (int part = 0; part < 3; ++part) {
    const bf16* src = hyT + ((size_t)(part * 512 + c)) * TG + tlbase;
    bf16* dstb = part == 0 ? U : part == 1 ? X1 : X2;
    const float w0 = p.hy_conv[(layer * 3 + 0) * 1536 + part * 512 + c];
    const float w1 = p.hy_conv[(layer * 3 + 1) * 1536 + part * 512 + c];
    const float w2 = p.hy_conv[(layer * 3 + 2) * 1536 + part * 512 + c];
#pragma unroll
    for (int it = 0; it < NBT * L / 8 / 512; ++it) {
      const int id = tid + 512 * it;
      const int bb = id / (L / 8), t8 = (id % (L / 8)) * 8;
      const bf16* s = src + bb * L + t8;
      const bf16x8 xv = *(const bf16x8*)s;
      float x[10];
      x[0] = t8 > 0 ? bf2f(s[-1]) : 0.f;
      x[9] = t8 + 8 < L ? bf2f(s[8]) : 0.f;
#pragma unroll
      for (int j = 0; j < 8; ++j) x[j + 1] = bf2f((bf16)xv[j]);
      bf16x8 o;
#pragma unroll
      for (int j = 0; j < 8; ++j) o[j] = (short)f2bf(w0 * x[j] + w1 * x[j + 1] + w2 * x[j + 2]);
      *(bf16x8*)(dstb + bb * UP + t8) = o;
    }
  }
  const int wbase = wave * (L / 8);
  const int dmin = -(wbase + (NT - 1) * 32 * NP + 32 * (NP - 1)), dmax = L - 16 - wbase;
  f32x16 acc[NT];
#pragma unroll 1
  for (int o = 0; o < 2; ++o) {
    {
      const float inv = 1.f / fs[o * 512 + c];
      const float* gs = gsrc + ((size_t)(o * 512 + c)) * (2 * L);
      const float skip = p.hy_skip[(layer * 2 + o) * 512 + c];
#pragma unroll 8
      for (int y = tid; y < 2 * L; y += 512) {
        float v = gs[y] * inv;
        if (y == L) v = (gs[L] + gs[0]) * inv + skip;
        if (y == 0) v = 0.f;
        const bf16 bv = f2bf(v);
        GR[y] = bv;
        if (y > 0) GR1[y - 1] = bv;
      }
      if (tid == 0) GR1[2 * L - 1] = 0;
    }
    __syncthreads();
#pragma unroll
    for (int q = 0; q < NT; ++q) acc[q] = zero16();
#pragma unroll 1
    for (int d = dmin; d <= dmax; d += 16) {
      const unsigned* gp = (const unsigned*)(((n & 1) ? GR1 - 1 : GR) + (L - n + d + 8 * hh));
      typedef __attribute__((ext_vector_type(4))) unsigned u4;
      u4 aw;
#pragma unroll
      for (int j = 0; j < 4; ++j) aw[j] = gp[j];
      const bf16x8 a = __builtin_bit_cast(bf16x8, aw);
#pragma unroll
      for (int q = 0; q < NT; ++q) {
        const int s0 = wbase + q * 32 * NP + 32 * pp + d;
        bf16x8 bb;
#pragma unroll
        for (int j = 0; j < 8; ++j) bb[j] = 0;
        if (s0 >= 0 && s0 <= L - 16) bb = *(const bf16x8*)(U + b * UP + s0 + 8 * hh);
        acc[q] = MFMA(a, bb, acc[q]);
      }
    }
    __syncthreads();
    if (o == 0) {
#pragma unroll
      for (int q = 0; q < NT; ++q)
#pragma unroll
        for (int i = 0; i < 16; ++i) {
          const int t = wbase + q * 32 * NP + 32 * pp + crow(i, hh);
          U[b * UP + t] = f2bf(bf2f(X1[b * UP + t]) * acc[q][i]);
        }
    } else {
      const bf16* gate = hyT + ((size_t)(3 * 512 + c)) * TG + tlbase;
#pragma unroll
      for (int q = 0; q < NT; ++q)
#pragma unroll
        for (int g4 = 0; g4 < 4; ++g4) {
          const int t = wbase + q * 32 * NP + 32 * pp + 8 * g4 + 4 * hh;
          const bf16x4 gv = *(const bf16x4*)(gate + b * L + t);
          bf16x4 ov;
#pragma unroll
          for (int j = 0; j < 4; ++j)
            ov[j] = (short)f2bf(bf2f(X2[b * UP + t + j]) * acc[q][4 * g4 + j] * siluf(bf2f((bf16)gv[j])));
          *(bf16x4*)(U + b * UP + t) = ov;
        }
      __syncthreads();
      bf16* yat = (bf16*)(p.ws + OFF_YA) + (size_t)c * TG + tlbase;
      for (int id = tid; id < NBT * L / 8; id += 512) {
        const int bb = id / (L / 8), t8 = (id % (L / 8)) * 8;
        *(bf16x8*)(yat + bb * L + t8) = *(const bf16x8*)(U + bb * UP + t8);
      }
    }
  }
}

DI void attn_item(const Params& p, int layer, bool lat, int tlbase, int bglob, int kvh, int qblk, char* smem) {
  bf16* Ks = (bf16*)smem;
  bf16* VT = Ks + 64 * 72;
  const int tid = otid(), lane = tid & 63, wave = tid >> 6;
  const int r = lane & 31, hh = lane >> 5;
  const int head = kvh * 4 + (wave >> 1);
  const int qi = qblk * 64 + (wave & 1) * 32 + r;
  const int tlq = tlbase + qi;
  const bf16* aq = (const bf16*)(p.ws + OFF_AQ);
  const bf16* ak = (const bf16*)(p.ws + OFF_AK);
  const bf16* av = (const bf16*)(p.ws + OFF_AV);
  bf16* ag = (bf16*)(p.ws + OFF_AG);
  bf16x8 bq[4];
#pragma unroll
  for (int ks = 0; ks < 4; ++ks) bq[ks] = *(const bf16x8*)(aq + (size_t)tlq * 512 + head * 64 + ks * 16 + hh * 8);
  const float sink2 = p.attn_sink[layer * 8 + head] * LOG2E;
  const float SC = 0.125f * LOG2E;
  float m = sink2, lsum = 0.f;
  f32x16 O[2];
  O[0] = zero16();
  O[1] = zero16();
  const int t_lo = lat ? (2 - qblk > 0 ? 2 - qblk : 0) : 0;
  const int t_hi = lat ? (65 - qblk < 4 ? 65 - qblk : 4) : 3;
  const int nw = t_hi - t_lo + 1;
  const int ntot = lat ? nw + 8 : nw;
  const int lj = tid >> 3, lkc = (tid & 7) * 8;
  u32x4 pr0, pr1, pr2, pr3;
  pr2 = u32x4{0, 0, 0, 0};
  pr3 = u32x4{0, 0, 0, 0};
  {
    const int kp = lat ? qblk * 64 - 128 + t_lo * 64 : 0;
    const size_t o = (size_t)(tlbase + kp + lj) * 128 + kvh * 64 + lkc;
    pr0 = *(const u32x4*)(ak + o);
    pr1 = *(const u32x4*)(av + o);
  }
#pragma unroll 1
  for (int n = 0; n < ntot; ++n) {
    const bool from_cache = lat && n >= nw;
    const bool window = lat && n < nw && (t_lo + n == 0 || t_lo + n == 4);
    const int kpos0 = from_cache ? (n - nw) * 64 : (lat ? qblk * 64 - 128 + (t_lo + n) * 64 : n * 64);
    lds_barrier();
    {
      bf16x8 kv, vv;
      if (from_cache) {
        const f32x4v k0 = __builtin_bit_cast(f32x4v, pr0), k1 = __builtin_bit_cast(f32x4v, pr1);
        const f32x4v v0 = __builtin_bit_cast(f32x4v, pr2), v1 = __builtin_bit_cast(f32x4v, pr3);
#pragma unroll
        for (int e = 0; e < 4; ++e) {
          kv[e] = (short)f2bf(k0[e]);
          kv[4 + e] = (short)f2bf(k1[e]);
          vv[e] = (short)f2bf(v0[e]);
          vv[4 + e] = (short)f2bf(v1[e]);
        }
      } else {
        kv = __builtin_bit_cast(bf16x8, pr0);
        vv = __builtin_bit_cast(bf16x8, pr1);
      }
      *(bf16x8*)(Ks + lj * 72 + lkc) = kv;
#pragma unroll
      for (int jj = 0; jj < 8; ++jj) VT[(lkc + jj) * 68 + lj] = (bf16)vv[jj];
    }
    lds_barrier();
    {
      const int nn = n + 1 < ntot ? n + 1 : n;
      if (lat && nn >= nw) {
        const size_t o = ((((size_t)bglob * 4 + layer) * 512 + (nn - nw) * 64 + lj) * 2 + kvh) * 64 + lkc;
        pr0 = *(const u32x4*)(p.cache_k + o);
        pr1 = *(const u32x4*)(p.cache_k + o + 4);
        pr2 = *(const u32x4*)(p.cache_v + o);
        pr3 = *(const u32x4*)(p.cache_v + o + 4);
      } else {
        const int kp = lat ? qblk * 64 - 128 + (t_lo + nn) * 64 : nn * 64;
        const size_t o = (size_t)(tlbase + kp + lj) * 128 + kvh * 64 + lkc;
        pr0 = *(const u32x4*)(ak + o);
        pr1 = *(const u32x4*)(av + o);
      }
    }
    f32x16 sc[2];
#pragma unroll
    for (int sub = 0; sub < 2; ++sub) {
      sc[sub] = zero16();
#pragma unroll
      for (int ks = 0; ks < 4; ++ks) {
        const bf16x8 a = *(const bf16x8*)(Ks + (sub * 32 + r) * 72 + ks * 16 + hh * 8);
        sc[sub] = MFMA(a, bq[ks], sc[sub]);
      }
    }
    float mx = -3.0e38f;
#pragma unroll
    for (int sub = 0; sub < 2; ++sub)
#pragma unroll
      for (int i = 0; i < 16; ++i) {
        float sv = sc[sub][i] * SC;
        if (window) {
          const int diff = qi - (kpos0 + sub * 32 + crow(i, hh));
          if (diff > 128 || diff < -128) sv = -1e30f;
        }
        sc[sub][i] = sv;
        mx = fmaxf(mx, sv);
      }
    mx = fmaxf(mx, __shfl_xor(mx, 32));
    const float mnew = fmaxf(m, mx);
    const float alpha = __builtin_amdgcn_exp2f(m - mnew);
    m = mnew;
    float ps = 0.f;
#pragma unroll
    for (int sub = 0; sub < 2; ++sub)
#pragma unroll
      for (int i = 0; i < 16; ++i) {
        sc[sub][i] = __builtin_amdgcn_exp2f(sc[sub][i] - m);
        ps += sc[sub][i];
      }
    lsum = lsum * alpha + ps;
    if (__builtin_amdgcn_ballot_w64(alpha != 1.f) != 0) {
#pragma unroll
      for (int i = 0; i < 16; ++i) {
        O[0][i] *= alpha;
        O[1][i] *= alpha;
      }
    }
#pragma unroll
    for (int sub = 0; sub < 2; ++sub)
#pragma unroll
      for (int st = 0; st < 2; ++st) {
        const bf16x8 pf = pack8(sc[sub], st);
#pragma unroll
        for (int mi = 0; mi < 2; ++mi) {
          const bf16* vp = VT + (mi * 32 + r) * 68 + sub * 32 + 16 * st + 4 * hh;
          const bf16x4 lo = *(const bf16x4*)vp, hi = *(const bf16x4*)(vp + 8);
          const bf16x8 va = __builtin_shufflevector(lo, hi, 0, 1, 2, 3, 4, 5, 6, 7);
          O[mi] = MFMA(va, pf, O[mi]);
        }
      }
  }
  const float ltot = lsum + __shfl_xor(lsum, 32) + exp2f(sink2 - m);
  const float inv = 1.f / ltot;
#pragma unroll
  for (int mi = 0; mi < 2; ++mi)
#pragma unroll
    for (int g4 = 0; g4 < 4; ++g4) {
      bf16* gp = ag + (size_t)tlq * 512 + head * 64 + mi * 32 + 8 * g4 + 4 * hh;
      const bf16x4 gv = *(const bf16x4*)gp;
      bf16x4 o;
#pragma unroll
      for (int j = 0; j < 4; ++j) o[j] = (short)f2bf(O[mi][4 * g4 + j] * inv * siluf(bf2f((bf16)gv[j])));
      *(bf16x4*)gp = o;
    }
}

DI void ret_item(const Params& p, int layer, bool lat, int NC, int tlbase, int bglob, int hd, char* smem) {
  const int tid = otid(), lane = tid & 63, wave = tid >> 6;
  const int dir = wave >> 2, w4 = wave & 3, r = lane & 31, hh = lane >> 5, dt = tid & 255;
  bf16* Ks = (bf16*)smem + dir * 31232;
  bf16* KdT = Ks + 128 * 72;
  bf16* VT = KdT + 64 * 136;
  bf16* ST = VT + 64 * 136;
  const bf16* rq = (const bf16*)(p.ws + OFF_RQ);
  const bf16* rk = (const bf16*)(p.ws + OFF_RK);
  const bf16* rv = (const bf16*)(p.ws + OFF_RV);
  bf16* rg = (bf16*)(p.ws + OFF_RG);
  bf16* ofb = (bf16*)(p.ws + OFF_OFB);
  const float theta = p.ret_theta[(layer * 2 + dir) * 8 + hd];
  const float lg2 = -log1pf(expf(-theta)) * LOG2E;
  const float cdec = exp2f(lg2 * 128.f);
  const int etile = w4 >> 1, dtile = w4 & 1;
  f32x16 Sacc;
  if (lat) {
    const float* s0 = p.state_ret + ((((size_t)bglob * 4 + layer) * 2 + dir) * 8 + hd) * 4096;
#pragma unroll
    for (int i = 0; i < 16; ++i) Sacc[i] = s0[(dtile * 32 + r) * 64 + etile * 32 + crow(i, hh)];
  } else {
    Sacc = zero16();
  }
  __syncthreads();
#pragma unroll
  for (int i = 0; i < 16; ++i) ST[(etile * 32 + crow(i, hh)) * 72 + dtile * 32 + r] = f2bf(Sacc[i]);
#pragma unroll 1
  for (int step = 0; step < NC; ++step) {
    const int ch = dir ? NC - 1 - step : step;
    const int tl0 = tlbase + ch * 128;
    const int iq = w4 * 32 + r, tlq = tl0 + iq;
    const bool second = step >= NC / 2;
    bf16x8 kv[4], vv[4], bq[4];
    bf16x4 pp[8], pg[8];
    const int jrow = dt & 127;
#pragma unroll
    for (int i = 0; i < 4; ++i) {
      const int kc = ((dt >> 7) + 2 * i) * 8;
      const size_t o = (size_t)(tl0 + jrow) * 512 + hd * 64 + kc;
      kv[i] = *(const bf16x8*)(rk + o);
      vv[i] = *(const bf16x8*)(rv + o);
    }
#pragma unroll
    for (int ks = 0; ks < 4; ++ks) bq[ks] = *(const bf16x8*)(rq + (size_t)tlq * 512 + hd * 64 + ks * 16 + hh * 8);
    if (second) {
#pragma unroll
      for (int mi = 0; mi < 2; ++mi)
#pragma unroll
        for (int g4 = 0; g4 < 4; ++g4) {
          const size_t o = (size_t)tlq * 512 + hd * 64 + mi * 32 + 8 * g4 + 4 * hh;
          pp[mi * 4 + g4] = *(const bf16x4*)(ofb + o);
          pg[mi * 4 + g4] = *(const bf16x4*)(rg + o);
        }
    } else {
#pragma unroll
      for (int i = 0; i < 8; ++i) {
        pp[i] = bf16x4{0, 0, 0, 0};
        pg[i] = bf16x4{0, 0, 0, 0};
      }
    }
    {
      const float kd = exp2f(lg2 * (float)(dir ? jrow : 127 - jrow)) * 0.125f;
#pragma unroll
      for (int i = 0; i < 4; ++i) {
        const int kc = ((dt >> 7) + 2 * i) * 8;
        *(bf16x8*)(Ks + jrow * 72 + kc) = kv[i];
#pragma unroll
        for (int jj = 0; jj < 8; ++jj) {
          KdT[(kc + jj) * 136 + jrow] = f2bf(bf2f((bf16)kv[i][jj]) * kd);
          VT[(kc + jj) * 136 + jrow] = (bf16)vv[i][jj];
        }
      }
    }
    __syncthreads();
    f32x16 O[2];
    {
      const float qd = exp2f(lg2 * (float)(dir ? 128 - iq : iq + 1));
#pragma unroll
      for (int mi = 0; mi < 2; ++mi) {
        f32x16 oc = zero16();
#pragma unroll
        for (int ks = 0; ks < 4; ++ks) {
          const bf16x8 a = *(const bf16x8*)(ST + (mi * 32 + r) * 72 + ks * 16 + hh * 8);
          oc = MFMA(a, bq[ks], oc);
        }
#pragma unroll
        for (int i = 0; i < 16; ++i) O[mi][i] = oc[i] * qd;
      }
    }
#pragma unroll 1
    for (int jt = 0; jt < 4; ++jt) {
      if (dir == 0 ? (jt <= w4) : (jt >= w4)) {
        f32x16 s = zero16();
#pragma unroll
        for (int ks = 0; ks < 4; ++ks) {
          const bf16x8 a = *(const bf16x8*)(Ks + (jt * 32 + r) * 72 + ks * 16 + hh * 8);
          s = MFMA(a, bq[ks], s);
        }
#pragma unroll
        for (int i = 0; i < 16; ++i) {
          const int j = jt * 32 + crow(i, hh);
          const int diff = dir ? j - iq : iq - j;
          s[i] = diff >= 0 ? s[i] * 0.125f * __builtin_amdgcn_exp2f(lg2 * (float)diff) : 0.f;
        }
#pragma unroll
        for (int st = 0; st < 2; ++st) {
          const bf16x8 pf = pack8(s, st);
#pragma unroll
          for (int mi = 0; mi < 2; ++mi) {
            const bf16* vp = VT + (mi * 32 + r) * 136 + jt * 32 + 16 * st + 4 * hh;
            const bf16x4 lo = *(const bf16x4*)vp, hi = *(const bf16x4*)(vp + 8);
            const bf16x8 va = __builtin_shufflevector(lo, hi, 0, 1, 2, 3, 4, 5, 6, 7);
            O[mi] = MFMA(va, pf, O[mi]);
          }
        }
      }
    }
#pragma unroll
    for (int i = 0; i < 16; ++i) Sacc[i] *= cdec;
#pragma unroll 2
    for (int jk = 0; jk < 8; ++jk) {
      const bf16x8 a = *(const bf16x8*)(VT + (etile * 32 + r) * 136 + jk * 16 + hh * 8);
      const bf16x8 bb = *(const bf16x8*)(KdT + (dtile * 32 + r) * 136 + jk * 16 + hh * 8);
      Sacc = MFMA(a, bb, Sacc);
    }
    if (!second) {
#pragma unroll
      for (int mi = 0; mi < 2; ++mi)
#pragma unroll
        for (int g4 = 0; g4 < 4; ++g4) {
          bf16x4 o;
#pragma unroll
          for (int j = 0; j < 4; ++j) o[j] = (short)f2bf(O[mi][4 * g4 + j]);
          *(bf16x4*)(ofb + (size_t)tlq * 512 + hd * 64 + mi * 32 + 8 * g4 + 4 * hh) = o;
        }
    } else {
      float ss = 0.f;
#pragma unroll
      for (int mi = 0; mi < 2; ++mi)
#pragma unroll
        for (int g4 = 0; g4 < 4; ++g4) {
          const bf16x4 pv = pp[mi * 4 + g4];
#pragma unroll
          for (int j = 0; j < 4; ++j) {
            const float v = O[mi][4 * g4 + j] + bf2f((bf16)pv[j]);
            O[mi][4 * g4 + j] = v;
            ss += v * v;
          }
        }
      ss += __shfl_xor(ss, 32);
      const float rn = rsqrtf(ss * (1.f / 64.f) + 1e-6f);
#pragma unroll
      for (int mi = 0; mi < 2; ++mi)
#pragma unroll
        for (int g4 = 0; g4 < 4; ++g4) {
          const int e0 = hd * 64 + mi * 32 + 8 * g4 + 4 * hh;
          bf16* gp = rg + (size_t)tlq * 512 + e0;
          const bf16x4 gv = pg[mi * 4 + g4];
          const float4 gn = *(const float4*)(p.ret_gn + layer * 512 + e0);
          bf16x4 o;
          o[0] = (short)f2bf(O[mi][4 * g4 + 0] * rn * gn.x * siluf(bf2f((bf16)gv[0])));
          o[1] = (short)f2bf(O[mi][4 * g4 + 1] * rn * gn.y * siluf(bf2f((bf16)gv[1])));
          o[2] = (short)f2bf(O[mi][4 * g4 + 2] * rn * gn.z * siluf(bf2f((bf16)gv[2])));
          o[3] = (short)f2bf(O[mi][4 * g4 + 3] * rn * gn.w * siluf(bf2f((bf16)gv[3])));
          *(bf16x4*)gp = o;
        }
    }
    __builtin_amdgcn_fence(__ATOMIC_SEQ_CST, "workgroup");
    __syncthreads();
#pragma unroll
    for (int i = 0; i < 16; ++i) ST[(etile * 32 + crow(i, hh)) * 72 + dtile * 32 + r] = f2bf(Sacc[i]);
  }
  if (!lat) {
    float* so = p.out + OUT_ST + ((((size_t)bglob * 4 + layer) * 2 + dir) * 8 + hd) * 4096;
#pragma unroll
    for (int i = 0; i < 16; ++i) so[(dtile * 32 + r) * 64 + etile * 32 + crow(i, hh)] = Sacc[i];
  }
}

DI void p2(const Params& p, int layer, int grp, char* smem, int* s_item) {
  int* ctr = (int*)(p.ws + OFF_CTR) + layer * 2 + grp;
  const int n_rl = 32, n_hl = 512, n_al = 512;
  const int n_hc = grp ? 0 : 512, n_rc = grp ? 0 : 256, n_ac = grp ? 0 : 256;
  const int total = n_rl + n_hl + n_al + n_hc + n_rc + n_ac;
  const int latbase = grp ? 0 : T_CTX;
  const int latb0 = grp ? 4 : 0;
  for (;;) {
    __syncthreads();
    if (threadIdx.x == 0) *s_item = atomicAdd(ctr, 1);
    __syncthreads();
    int it = *s_item;
    if (it >= total) break;
    if (it < n_rl) {
      const int b = it >> 3, hd = it & 7;
      ret_item(p, layer, true, 32, latbase + b * 4096, latb0 + b, hd, smem);
      continue;
    }
    it -= n_rl;
    if (it < n_hl) { hyena_item<4, 4096>(p, layer, 0, latbase, it, smem); continue; }
    it -= n_hl;
    if (it < n_al) {
      const int b = it >> 7, kvh = (it >> 6) & 1, qb = it & 63;
      attn_item(p, layer, true, latbase + b * 4096, latb0 + b, kvh, qb, smem);
      continue;
    }
    it -= n_al;
    if (it < n_hc) { hyena_item<32, 256>(p, layer, 1, 0, it, smem); continue; }
    it -= n_hc;
    if (it < n_rc) {
      const int b = it >> 3, hd = it & 7;
      ret_item(p, layer, false, 2, b * 256, b, hd, smem);
      continue;
    }
    it -= n_rc;
    {
      const int b = it >> 3, kvh = (it >> 2) & 1, qb = it & 3;
      attn_item(p, layer, false, b * 256, b, kvh, qb, smem);
    }
  }
}

DI unsigned pk2(float a, float b) { return (unsigned)f2bf(a) | ((unsigned)f2bf(b) << 16); }
DI float pklo(unsigned u) { return __uint_as_float(u << 16); }
DI float pkhi(unsigned u) { return __uint_as_float(u & 0xffff0000u); }
DI void p3a(const Params& p, int layer, int grp, char* smem) {
  const int tgn = grp ? 16384 : TG;
  const int mtiles = tgn / 256, ntot = mtiles * 8;
  const int tid = otid(), lane = tid & 63, wave = tid >> 6;
  const int wm = wave >> 1, wn = wave & 1, r = lane & 31, h = lane >> 5;
  const bf16* H = (const bf16*)(p.ws + OFF_H);
  const bf16* wl = (const bf16*)(p.ws + OFF_W) + (size_t)layer * W_LAYER;
  bf16* MG = (bf16*)(p.ws + OFF_MERGED);
  u32x4 ra[2][4], rb[2][2];
  bool pre = false;
  const bf16* YaT = (const bf16*)(p.ws + OFF_YA);
  for (int id = blockIdx.x; id < ntot; id += gridDim.x) {
    const int m0 = ((id >> 7) * 16 + (id & 15)) * 256, n0 = ((id & 127) >> 4) * 128;
    const int idn = id + gridDim.x;
    const bool hn = idn < ntot;
    const int m0n = ((idn >> 7) * 16 + (idn & 15)) * 256, n0n = ((idn & 127) >> 4) * 128;
    unsigned mgp[2][2][8];
#pragma unroll
    for (int a = 0; a < 2; ++a)
#pragma unroll
      for (int b = 0; b < 2; ++b)
#pragma unroll
        for (int i = 0; i < 8; ++i) mgp[a][b][i] = 0u;
#pragma unroll 1
    for (int br = 0; br < 3; ++br) {
      const GemmSrc gate = mksrc(H + (size_t)m0 * 1024, 1024, wl + W_MG + (size_t)(br * 1024 + n0) * 1024, 1024, 0);
      const bf16* WB = wl + (br == 0 ? W_A : br == 1 ? W_B : W_C);
      const GemmSrc bsrc = br == 0 ? mksrc(YaT + m0, TG, WB + (size_t)n0 * 512, 512, 1)
                                   : mksrc((const bf16*)(p.ws + (br == 1 ? OFF_AG : OFF_RG)) + (size_t)m0 * 512, 512, WB + (size_t)n0 * 512, 512, 0);
      const GemmSrc after = br < 2 ? mksrc(H + (size_t)m0 * 1024, 1024, wl + W_MG + (size_t)((br + 1) * 1024 + n0) * 1024, 1024, 0)
                                   : mksrc(H + (size_t)m0n * 1024, 1024, wl + W_MG + (size_t)n0n * 1024, 1024, 0);
      unsigned sg[2][2][8];
      {
        f32x16 ag[2][2];
#pragma unroll
        for (int a = 0; a < 2; ++a)
#pragma unroll
          for (int b = 0; b < 2; ++b) ag[a][b] = zero16();
        gemm_main<2, false>(gate, 1024, ag, smem, ra, rb, false, bsrc, false);
#pragma unroll
        for (int ni = 0; ni < 2; ++ni) {
          const float bias = p.b_merge[layer * 3072 + br * 1024 + n0 + wn * 64 + ni * 32 + r];
#pragma unroll
          for (int mi = 0; mi < 2; ++mi) {
#pragma unroll
            for (int i = 0; i < 8; ++i)
              sg[mi][ni][i] = pk2(sigmf(ag[mi][ni][2 * i] + bias), sigmf(ag[mi][ni][2 * i + 1] + bias));
            __builtin_amdgcn_sched_barrier(0);
          }
        }
      }
      f32x16 ay[2][2];
#pragma unroll
      for (int a = 0; a < 2; ++a)
#pragma unroll
        for (int b = 0; b < 2; ++b) ay[a][b] = zero16();
      if (br == 0) gemm_main<2, true>(bsrc, 512, ay, smem, ra, rb, false, after, false);
      else gemm_main<2, false>(bsrc, 512, ay, smem, ra, rb, false, after, false);
#pragma unroll
      for (int mi = 0; mi < 2; ++mi)
#pragma unroll
        for (int ni = 0; ni < 2; ++ni) {
#pragma unroll
          for (int i = 0; i < 8; ++i) {
            const float lo = pklo(mgp[mi][ni][i]) + pklo(sg[mi][ni][i]) * ay[mi][ni][2 * i];
            const float hi = pkhi(mgp[mi][ni][i]) + pkhi(sg[mi][ni][i]) * ay[mi][ni][2 * i + 1];
            mgp[mi][ni][i] = pk2(lo, hi);
          }
          __builtin_amdgcn_sched_barrier(0);
        }
    }
    {
      const int t2 = otid(), l2 = t2 & 63, w2 = t2 >> 6;
      const int wm2 = w2 >> 1, wn2 = w2 & 1, r2 = l2 & 31, h2 = l2 >> 5;
#pragma unroll
      for (int mi = 0; mi < 2; ++mi)
#pragma unroll
        for (int ni = 0; ni < 2; ++ni)
#pragma unroll
          for (int i = 0; i < 8; ++i) {
            bf16* d = MG + (size_t)(m0 + wm2 * 64 + mi * 32) * 1024 + n0 + wn2 * 64 + ni * 32 + r2;
            d[(size_t)crow(2 * i, h2) * 1024] = (bf16)(mgp[mi][ni][i] & 0xffffu);
            d[(size_t)crow(2 * i + 1, h2) * 1024] = (bf16)(mgp[mi][ni][i] >> 16);
          }
    }
  }
}

DI void p3b(const Params& p, int layer, int grp, char* smem) {
  const int g0 = grp ? TG : 0, tgn = grp ? 16384 : TG;
  const int mtiles = tgn / 256, ntot = mtiles * 8;
  const int tid = otid(), lane = tid & 63, wave = tid >> 6;
  const int wm = wave >> 1, wn = wave & 1, r = lane & 31, h = lane >> 5;
  const bf16* MG = (const bf16*)(p.ws + OFF_MERGED);
  const bf16* WoT = (const bf16*)(p.ws + OFF_W) + (size_t)layer * W_LAYER + W_O;
  const float* mods = (const float*)(p.ws + OFF_MODS);
  u32x4 ra[2][4], rb[2][2];
  bool pre = false;
  for (int id = blockIdx.x; id < ntot; id += gridDim.x) {
    const int band = id >> 7, rem = id & 127;
    const int mt = band * 16 + (rem & 15), nt = rem >> 4;
    const int m0 = mt * 256, n0 = nt * 128;
    const int idn = id + gridDim.x;
    const bool hn = idn < ntot;
    const int m0n = ((idn >> 7) * 16 + (idn & 15)) * 256, n0n = ((idn & 127) >> 4) * 128;
    f32x16 acc[2][2];
#pragma unroll
    for (int a = 0; a < 2; ++a)
#pragma unroll
      for (int b = 0; b < 2; ++b) acc[a][b] = zero16();
    gemm_main<2, false>(mksrc(MG + (size_t)m0 * 1024, 1024, WoT + (size_t)n0 * 1024, 1024, 0), 1024, acc, smem, ra, rb, pre,
                        mksrc(MG + (size_t)m0n * 1024, 1024, WoT + (size_t)n0n * 1024, 1024, 0), hn);
    pre = true;
    const int tg0 = g0 + m0;
    const float* gate = mods + (layer * 9 + cond_of(tg0)) * 3072 + 2048;
    const float *qxp = launder(p.x_prompt), *qxs = launder(p.x_sample), *qo = launder(p.out);
    const float* xsb = layer == 0 ? (tg0 < T_CTX ? qxp + (size_t)tg0 * DM : qxs + (size_t)(tg0 - T_CTX) * DM) : qo + (size_t)tg0 * DM;
    float* xdb = p.out + (size_t)tg0 * DM;
#pragma unroll
    for (int ni = 0; ni < 2; ++ni) {
      const int col = n0 + wn * 64 + ni * 32 + r;
      const float gt = gate[col];
#pragma unroll
      for (int mi = 0; mi < 2; ++mi)
#pragma unroll
        for (int i = 0; i < 16; ++i) {
          const int ro = (wm * 64 + mi * 32 + crow(i, h)) * DM + col;
          xdb[ro] = xsb[ro] + gt * acc[mi][ni][i];
        }
    }
  }
}

DI void final_norm(const Params& p) {
  const int tid_ = otid();
  const int lane = tid_ & 63, wave = tid_ >> 6;
  for (int it = blockIdx.x; it < T_ALL / 8; it += gridDim.x) {
    const int tg = it * 8 + wave;
    float* x = p.out + (size_t)tg * DM;
    float4 v[4];
    float ss = 0.f;
#pragma unroll
    for (int i = 0; i < 4; ++i) {
      v[i] = *(const float4*)(x + (lane + 64 * i) * 4);
      ss += v[i].x * v[i].x + v[i].y * v[i].y + v[i].z * v[i].z + v[i].w * v[i].w;
    }
#pragma unroll
    for (int o = 32; o > 0; o >>= 1) ss += __shfl_xor(ss, o);
    const float rstd = rsqrtf(ss * (1.f / 1024.f) + 1e-6f);
#pragma unroll
    for (int i = 0; i < 4; ++i) {
      const int col = (lane + 64 * i) * 4;
      const float4 w = *(const float4*)(p.final_w + col);
      *(float4*)(x + col) = make_float4(v[i].x * rstd * w.x, v[i].y * rstd * w.y, v[i].z * rstd * w.z, v[i].w * rstd * w.w);
    }
  }
}


#define XB_TMO 128
#define XB_XCNT(j) (256 + 64 * (j))
#define XB_XSUB(j) (1280 + 64 * (j))
#define XB_XGEN(j) (2304 + 64 * (j))
#define XB_TOP 3328
#define XB_TOPGEN 3392
#define XB_SPIN_CAP (1u << 22)
DI unsigned xb_ld(unsigned* p) { return __hip_atomic_load(p, __ATOMIC_RELAXED, __HIP_MEMORY_SCOPE_AGENT); }
DI unsigned xb_add(unsigned* p, unsigned v) { return __hip_atomic_fetch_add(p, v, __ATOMIC_RELAXED, __HIP_MEMORY_SCOPE_AGENT); }
DI unsigned xb_xcc_id() { return (unsigned)__builtin_amdgcn_s_getreg((3 << 11) | 20) & 0xFu; }
#define XB_SPIN(cond, bar)                                          \
  do {                                                              \
    unsigned _sp = 0;                                               \
    while (cond) {                                                  \
      __builtin_amdgcn_s_sleep(1);                                  \
      if ((++_sp & 255u) == 0u) {                                   \
        if (xb_ld(&(bar)[XB_TMO])) break;                           \
        if (_sp > XB_SPIN_CAP) {                                    \
          atomicAdd(&(bar)[XB_TMO], 1u);                            \
          break;                                                    \
        }                                                           \
      }                                                             \
    }                                                               \
  } while (0)
struct XcdBarrier {
  unsigned* bar;
  unsigned x;
  volatile unsigned* st;
};
DI void xcd_barrier_complete(unsigned* bar, unsigned x, unsigned& nloc, unsigned& nx) {
  const unsigned G = gridDim.x;
  unsigned sum, cnt, mine, sp = 0u;
  for (;;) {
    sum = 0u; cnt = 0u; mine = 0u;
#pragma unroll
    for (unsigned j = 0; j < 16; ++j) {
      const unsigned c = xb_ld(&bar[XB_XCNT(j)]);
      sum += c;
      cnt += (c > 0u) ? 1u : 0u;
      mine = (j == x) ? c : mine;
    }
    if (sum == G) break;
    __builtin_amdgcn_s_sleep(1);
    if ((++sp & 255u) == 0u) {
      if (xb_ld(&bar[XB_TMO])) break;
      if (sp > XB_SPIN_CAP) { atomicAdd(&bar[XB_TMO], 1u); break; }
    }
  }
  nloc = mine > 0u ? mine : 1u;
  nx = cnt > 0u ? cnt : 1u;
}
DI void xcd_barrier(char* ws, volatile unsigned* st) {
  asm volatile("" : "+s"(ws));
  XcdBarrier b;
  b.bar = (unsigned*)(ws + OFF_BAR);
  b.x = xb_xcc_id();
  b.st = st;
  asm volatile("s_waitcnt vmcnt(0)" ::: "memory");
  __syncthreads();
  if (threadIdx.x == 0) {
    unsigned* bar = b.bar;
    __builtin_amdgcn_s_waitcnt(0);
    unsigned nloc = b.st[0], nx = b.st[1];
    if (nloc == 0u) {
      xcd_barrier_complete(bar, b.x, nloc, nx);
      b.st[0] = nloc;
      b.st[1] = nx;
    }
    const unsigned old = xb_add(&bar[XB_XSUB(b.x)], 1u);
    const unsigned gen = old / nloc;
    if (old + 1u == (gen + 1u) * nloc) {
      __builtin_amdgcn_fence(__ATOMIC_RELEASE, "agent");
      asm volatile("s_waitcnt vmcnt(0)" ::: "memory");
      const unsigned og = xb_add(&bar[XB_TOP], 1u);
      const unsigned tg = og / nx;
      if (og + 1u == (tg + 1u) * nx) xb_add(&bar[XB_TOPGEN], 1u);
      else XB_SPIN(xb_ld(&bar[XB_TOPGEN]) == tg, bar);
      __builtin_amdgcn_fence(__ATOMIC_ACQUIRE, "agent");
      xb_add(&bar[XB_XGEN(b.x)], 1u);
      asm volatile("s_waitcnt vmcnt(0)" ::: "memory");
    } else {
      XB_SPIN(xb_ld(&bar[XB_XGEN(b.x)]) == gen, bar);
      __builtin_amdgcn_fence(__ATOMIC_ACQUIRE, "agent");
      asm volatile("s_waitcnt vmcnt(0)" ::: "memory");
    }
  }
  __syncthreads();
}

__global__ void __launch_bounds__(512) mega(Params p) {
  __shared__ __attribute__((aligned(16))) char smem[SMEM_BYTES];
  __shared__ __attribute__((aligned(16))) unsigned xb_words[4];
  __shared__ int s_item;
  cg::grid_group grid = cg::this_grid();
  if (threadIdx.x == 0) { xb_words[0] = 0u; xb_words[1] = 0u; xb_words[2] = 0u; xb_words[3] = 0u; }
  __syncthreads();
  if (threadIdx.x == 0) (void)xb_add(&((unsigned*)(p.ws + OFF_BAR))[XB_XCNT(xb_xcc_id())], 1u);
  phase0(p, smem);
  grid.sync();
#pragma unroll 1
  for (int layer = 0; layer < DEPTH; ++layer) {
#pragma unroll 1
    for (int grp = 0; grp < 2; ++grp) {
      int ly = layer, gp = grp;
      asm volatile("" : "+s"(ly), "+s"(gp));
      p1a(p, ly, gp, smem);
      xcd_barrier(p.ws, xb_words);
      asm volatile("" : "+s"(ly), "+s"(gp));
      p1b(p, ly, gp, smem);
      xcd_barrier(p.ws, xb_words);
      asm volatile("" : "+s"(ly), "+s"(gp));
      p2(p, ly, gp, smem, &s_item);
      xcd_barrier(p.ws, xb_words);
      asm volatile("" : "+s"(ly), "+s"(gp));
      p3a(p, ly, gp, smem);
      xcd_barrier(p.ws, xb_words);
      asm volatile("" : "+s"(ly), "+s"(gp));
      p3b(p, ly, gp, smem);
      xcd_barrier(p.ws, xb_words);
    }
  }
  final_norm(p);
}

extern "C" void kernel_launch(void* const* d_in, const int* in_sizes, int n_in, void* d_out, int out_size, void* d_ws,
                              size_t ws_size, hipStream_t stream) {
  static int grid_blocks = 0;
  if (!grid_blocks) {
    int dev = 0, cus = 0, per_cu = 0;
    hipGetDevice(&dev);
    hipDeviceGetAttribute(&cus, hipDeviceAttributeMultiprocessorCount, dev);
    hipOccupancyMaxActiveBlocksPerMultiprocessor(&per_cu, mega, 512, 0);
    if (per_cu < 1) per_cu = 1;
    if (per_cu > 1) per_cu = 1;
    grid_blocks = cus * per_cu;
  }
  Params p{};
  const float** pp = (const float**)&p;
  for (int i = 0; i < 27; ++i) pp[i] = (const float*)d_in[i];
  p.out = (float*)d_out;
  p.ws = (char*)d_ws;
  if (ws_size < WS_NEEDED) fprintf(stderr, "workspace too small: %zu < %zu\n", ws_size, (size_t)WS_NEEDED);
  hipMemsetAsync(d_ws, 0, ZERO_BYTES, stream);
  void* args[] = {&p};
  hipError_t e = hipLaunchCooperativeKernel((void*)mega, dim3(grid_blocks), dim3(512), args, 0, stream);
  if (e != hipSuccess) fprintf(stderr, "cooperative launch failed: %s (grid %d)\n", hipGetErrorString(e), grid_blocks);
}
```

```cpp
#include <hip/hip_runtime.h>
#include <hip/hip_cooperative_groups.h>
#include <cstdio>
namespace cg = cooperative_groups;

#define DI __device__ __forceinline__
typedef unsigned short bf16;
typedef __attribute__((ext_vector_type(8))) short bf16x8;
typedef __attribute__((ext_vector_type(4))) short bf16x4;
typedef __attribute__((ext_vector_type(16))) float f32x16;
typedef __attribute__((ext_vector_type(4))) unsigned u32x4;
typedef __attribute__((ext_vector_type(4))) float f32x4v;
#define MFMA(a, b, c) __builtin_amdgcn_mfma_f32_32x32x16_bf16((a), (b), (c), 0, 0, 0)

constexpr int DM = 1024;
constexpr int DEPTH = 4;
constexpr int T_CTX = 8192;
constexpr int T_ALL = 40960;
constexpr int TG = 24576;
constexpr int IN_DIM = 5376;
constexpr float LOG2E = 1.4426950408889634f;

constexpr size_t OFF_MODS = 0;
constexpr size_t OFF_FSUM = 458752;
constexpr size_t OFF_CTR = 491520;
constexpr size_t OFF_BAR = 495616;
constexpr size_t ZERO_BYTES = 524288;
constexpr size_t OFF_ROPE = ZERO_BYTES;
constexpr size_t OFF_W = OFF_ROPE + 1048576;
constexpr size_t W_IN = 0, W_MG = 5505024, W_A = 8650752, W_B = 9175040, W_C = 9699328, W_O = 10223616, W_LAYER = 11272192;
constexpr size_t OFF_GL = OFF_W + W_LAYER * 2 * 4;
constexpr size_t OFF_GC = OFF_GL + 33554432;
constexpr size_t OFF_H = OFF_GC + 2097152;
constexpr size_t OFF_HYT = OFF_H + (size_t)TG * 2048;
constexpr size_t OFF_AQ = OFF_HYT + (size_t)TG * 4096;
constexpr size_t OFF_AK = OFF_AQ + (size_t)TG * 1024;
constexpr size_t OFF_AV = OFF_AK + (size_t)TG * 256;
constexpr size_t OFF_AG = OFF_AV + (size_t)TG * 256;
constexpr size_t OFF_RQ = OFF_AG + (size_t)TG * 1024;
constexpr size_t OFF_RK = OFF_RQ + (size_t)TG * 1024;
constexpr size_t OFF_RV = OFF_RK + (size_t)TG * 1024;
constexpr size_t OFF_RG = OFF_RV + (size_t)TG * 1024;
constexpr size_t OFF_YA = OFF_RG + (size_t)TG * 1024;
constexpr size_t OFF_OFB = OFF_YA + (size_t)TG * 1024;
constexpr size_t WS_NEEDED = OFF_OFB + (size_t)TG * 1024;
constexpr size_t OFF_MERGED = OFF_RQ;

constexpr size_t OUT_CK = 41943040, OUT_CV = 46137344, OUT_ST = 50331648;

constexpr int SMEM_BYTES = 135168;

struct Params {
  const float *x_prompt, *x_sample, *c, *cache_k, *cache_v, *state_ret, *c_ctx, *norm_w, *w_mod, *b_mod, *w_in, *hy_conv,
      *hy_w1, *hy_b1, *hy_freq, *hy_w2, *hy_skip, *attn_sink, *ret_theta, *ret_gn, *w_a, *w_b, *w_c, *w_merge, *b_merge,
      *w_out, *final_w;
  float* out;
  char* ws;
};

DI bf16 f2bf(float x) {
  __bf16 b = (__bf16)x;
  return __builtin_bit_cast(unsigned short, b);
}
DI float bf2f(bf16 u) { return __uint_as_float(((unsigned)u) << 16); }
DI int crow(int reg, int h) { return (reg & 3) + 8 * (reg >> 2) + 4 * h; }
DI float siluf(float x) { return x / (1.f + __expf(-x)); }
DI float sigmf(float x) { return 1.f / (1.f + __expf(-x)); }
DI bf16x8 pack8(const f32x16& x, int s) {
  bf16x8 r;
#pragma unroll
  for (int j = 0; j < 8; ++j) r[j] = (short)f2bf(x[8 * s + j]);
  return r;
}
DI f32x16 zero16() {
  f32x16 z;
#pragma unroll
  for (int i = 0; i < 16; ++i) z[i] = 0.f;
  return z;
}
DI const float* launder(const float* q) {
  asm volatile("" : "+s"(q));
  return q;
}
DI int otid() {
  int t = threadIdx.x;
  asm volatile("" : "+v"(t));
  return t;
}
DI int cond_of(int tg) { return tg < T_CTX ? 0 : 1 + ((tg - T_CTX) >> 12); }

DI void lds_barrier() { asm volatile("s_waitcnt lgkmcnt(0)\n\ts_barrier" ::: "memory"); }

struct GemmSrc {
  const bf16* A;
  const bf16* B;
  int lda, ldb, atr;
};
DI GemmSrc mksrc(const bf16* A, int lda, const bf16* B, int ldb, int atr) {
  GemmSrc g;
  g.A = A; g.B = B; g.lda = lda; g.ldb = ldb; g.atr = atr;
  return g;
}
template <int NI>
DI void gemm_issue(const GemmSrc& g, int kt, int tid, u32x4 (&ra)[4], u32x4 (&rb)[NI]) {
  const int lrow = tid >> 3, lkc = (tid & 7) * 8;
  const bf16* ab = g.atr ? g.A + (size_t)(((tid >> 6) * 8 + ((tid >> 3) & 7)) + kt * 64) * g.lda + (tid & 7) * 8
                         : g.A + (size_t)lrow * g.lda + lkc + kt * 64;
  const size_t astep = g.atr ? (size_t)64 : (size_t)64 * g.lda;
#pragma unroll
  for (int i = 0; i < 4; ++i) ra[i] = *(const u32x4*)(ab + astep * i);
  const bf16* bb = g.B + (size_t)lrow * g.ldb + lkc + kt * 64;
#pragma unroll
  for (int i = 0; i < NI; ++i) rb[i] = *(const u32x4*)(bb + (size_t)(64 * i) * g.ldb);
}
template <int NI, bool ATR>
DI void gemm_stage(bf16* As, bf16* Bs, int tid, const u32x4 (&ra)[4], const u32x4 (&rb)[NI]) {
  constexpr int PITCH = 72;
  const int lrow = tid >> 3, lkc = (tid & 7) * 8;
#pragma unroll
  for (int i = 0; i < 4; ++i) {
    if (ATR) {
      const int kk = (tid >> 6) * 8 + ((tid >> 3) & 7), tc = (tid & 7) + 8 * i;
      bf16* d = As + (tc * 8) * PITCH + (kk ^ ((tid & 7) << 3));
      const bf16x8 v = __builtin_bit_cast(bf16x8, ra[i]);
#pragma unroll
      for (int e = 0; e < 8; ++e) d[e * PITCH] = (bf16)v[e];
    } else {
      *(u32x4*)(As + (lrow + 64 * i) * PITCH + lkc) = ra[i];
    }
  }
#pragma unroll
  for (int i = 0; i < NI; ++i) *(u32x4*)(Bs + (lrow + 64 * i) * PITCH + lkc) = rb[i];
}

template <int NI, bool ATR>
DI void gemm_stage_part(bf16* As, bf16* Bs, int tid, const u32x4 (&ra)[4], const u32x4 (&rb)[NI], int part) {
  constexpr int PITCH = 72;
  const int lrow = tid >> 3, lkc = (tid & 7) * 8;
#pragma unroll
  for (int i = 0; i < 4; ++i) {
    if (i != part) continue;
    if (ATR) {
      const int kk = (tid >> 6) * 8 + ((tid >> 3) & 7), tc = (tid & 7) + 8 * i;
      bf16* d = As + (tc * 8) * PITCH + (kk ^ ((tid & 7) << 3));
      const bf16x8 v = __builtin_bit_cast(bf16x8, ra[i]);
#pragma unroll
      for (int e = 0; e < 8; ++e) d[e * PITCH] = (bf16)v[e];
    } else {
      *(u32x4*)(As + (lrow + 64 * i) * PITCH + lkc) = ra[i];
    }
  }
#pragma unroll
  for (int i = 0; i < NI; ++i)
    if (2 * i == part) *(u32x4*)(Bs + (lrow + 64 * i) * PITCH + lkc) = rb[i];
}

template <int NI, bool ATR>
DI void gemm_main(const GemmSrc& cur, int K, f32x16 (&acc)[2][NI], char* smem, u32x4 (&ra)[2][4], u32x4 (&rb)[2][NI],
                  bool preloaded, const GemmSrc& nxt, bool has_next) {
  constexpr int BN = 64 * NI;
  constexpr int PITCH = 72;
  bf16* As = (bf16*)smem;
  bf16* Bs = As + 2 * 256 * PITCH;
  const int tid = otid(), lane = tid & 63, wave = tid >> 6;
  const int wm = wave >> 1, wn = wave & 1, r = lane & 31, h = lane >> 5;
  const int nk = K / 64;
  if (!preloaded) {
    gemm_issue<NI>(cur, 0, tid, ra[0], rb[0]);
    gemm_issue<NI>(cur, 1, tid, ra[1], rb[1]);
  }
  lds_barrier();
  gemm_stage<NI, ATR>(As, Bs, tid, ra[0], rb[0]);
  lds_barrier();
#pragma unroll 1
  for (int kt = 0; kt < nk; kt += 2) {
#pragma unroll
    for (int u = 0; u < 2; ++u) {
      const int k = kt + u;
      {
        const bool inr = k + 2 < nk;
        GemmSrc g = (inr || !has_next) ? cur : nxt;
        const int kk = inr ? k + 2 : (has_next ? k + 2 - nk : nk - 1);
        gemm_issue<NI>(g, kk, tid, ra[u], rb[u]);
      }
      const bf16* Ab = As + u * 256 * PITCH + (wm * 64 + r) * PITCH + h * 8;
      const bf16* Bb = Bs + u * BN * PITCH + (wn * 32 * NI + r) * PITCH + h * 8;
#pragma unroll
      for (int ks = 0; ks < 4; ++ks) {
        bf16x8 a[2], b[NI];
#pragma unroll
        for (int mi = 0; mi < 2; ++mi)
          a[mi] = ATR ? *(const bf16x8*)(Ab - h * 8 + mi * 32 * PITCH + ((ks * 16 + h * 8) ^ (((mi * 4 + (r >> 3)) & 7) << 3)))
                      : *(const bf16x8*)(Ab + mi * 32 * PITCH + ks * 16);
#pragma unroll
        for (int ni = 0; ni < NI; ++ni) b[ni] = *(const bf16x8*)(Bb + ni * 32 * PITCH + ks * 16);
#pragma unroll
        for (int mi = 0; mi < 2; ++mi)
#pragma unroll
          for (int ni = 0; ni < NI; ++ni) acc[mi][ni] = MFMA(a[mi], b[ni], acc[mi][ni]);
        gemm_stage_part<NI, ATR>(As + (u ^ 1) * 256 * PITCH, Bs + (u ^ 1) * BN * PITCH, tid, ra[u ^ 1], rb[u ^ 1], ks);
      }
      lds_barrier();
    }
  }
}

DI void p0_mod_item(const Params& p, int item, char* smem) {
  const int tid = otid();
  const int l = item / 48, rem = item % 48, nch = rem / 8, ks = rem % 8;
  float* sc = (float*)smem;
  __syncthreads();
  for (int idx = tid; idx < 9 * 128; idx += 512) {
    const int cnd = idx >> 7, k = ks * 128 + (idx & 127);
    const float *qcc = launder(p.c_ctx), *qc = launder(p.c);
    const float v = cnd == 0 ? qcc[k] : qc[(cnd - 1) * 1024 + k];
    sc[idx] = v / (1.f + expf(-v));
  }
  __syncthreads();
  const int n = nch * 512 + tid;
  float acc[9];
#pragma unroll
  for (int i = 0; i < 9; ++i) acc[i] = 0.f;
  const float* w = p.w_mod + ((size_t)l * 1024 + ks * 128) * 3072 + n;
#pragma unroll 16
  for (int kk = 0; kk < 128; ++kk) {
    const float wv = w[(size_t)kk * 3072];
#pragma unroll
    for (int i = 0; i < 9; ++i) acc[i] += sc[i * 128 + kk] * wv;
  }
  float* mods = (float*)(p.ws + OFF_MODS);
  const float bias = ks == 0 ? p.b_mod[l * 3072 + n] : 0.f;
#pragma unroll
  for (int i = 0; i < 9; ++i) atomicAdd(&mods[(l * 9 + i) * 3072 + n], acc[i] + bias);
}

DI void transpose_tile(const float* __restrict__ src, int ldn, bf16* __restrict__ dst, int ldk, int k0, int n0, char* smem) {
  float* T = (float*)smem;
  const int tid = otid();
  __syncthreads();
  {
    const int k = tid >> 3, nc = (tid & 7) * 8;
    const float* s = src + (size_t)(k0 + k) * ldn + n0 + nc;
    const float4 a = *(const float4*)s, b = *(const float4*)(s + 4);
    float* t = T + k * 65 + nc;
    t[0] = a.x; t[1] = a.y; t[2] = a.z; t[3] = a.w; t[4] = b.x; t[5] = b.y; t[6] = b.z; t[7] = b.w;
  }
  __syncthreads();
  {
    const int n = tid >> 3, kc = (tid & 7) * 8;
    bf16x8 v;
#pragma unroll
    for (int j = 0; j < 8; ++j) v[j] = (short)f2bf(T[(kc + j) * 65 + n]);
    *(bf16x8*)(dst + (size_t)(n0 + n) * ldk + k0 + kc) = v;
  }
}

DI void p0_transpose_item(const Params& p, int item, char* smem) {
  const int l = item / 2752;
  int rem = item % 2752;
  bf16* wl = (bf16*)(p.ws + OFF_W) + (size_t)l * W_LAYER;
  if (rem < 1344) {
    const int kt = rem / 84, nt = rem % 84;
    transpose_tile(p.w_in + (size_t)l * 1024 * IN_DIM, IN_DIM, wl + W_IN, 1024, kt * 64, nt * 64, smem);
    return;
  }
  rem -= 1344;
  if (rem < 768) {
    const int kt = rem / 48, nt = rem % 48;
    transpose_tile(p.w_merge + (size_t)l * 1024 * 3072, 3072, wl + W_MG, 1024, kt * 64, nt * 64, smem);
    return;
  }
  rem -= 768;
  if (rem < 384) {
    const int br = rem / 128, r2 = rem % 128, kt = r2 / 16, nt = r2 % 16;
    const float *qa = launder(p.w_a), *qb = launder(p.w_b), *qc = launder(p.w_c);
    const float* src = (br == 0 ? qa : br == 1 ? qb : qc) + (size_t)l * 512 * 1024;
    transpose_tile(src, 1024, wl + (br == 0 ? W_A : br == 1 ? W_B : W_C), 512, kt * 64, nt * 64, smem);
    return;
  }
  rem -= 384;
  {
    const int kt = rem / 16, nt = rem % 16;
    transpose_tile(p.w_out + (size_t)l * 1024 * 1024, 1024, wl + W_O, 1024, kt * 64, nt * 64, smem);
  }
}

DI void p0_rope_item(const Params& p, int item) {
  const int idx = item * 512 + otid();
  const int t = idx >> 5, f = idx & 31;
  const float inv = powf(10000.f, -(float)(f & 15) / 16.f);
  const float ang = (float)(f < 16 ? (t >> 6) : (t & 63)) * inv;
  float2 cs;
  cs.x = cosf(ang);
  cs.y = sinf(ang);
  ((float2*)(p.ws + OFF_ROPE))[idx] = cs;
}

DI void phase0(const Params& p, char* smem) {
  const int n_mod = 192, n_tr = 11008, n_rope = 256;
  for (int it = blockIdx.x; it < n_mod + n_tr + n_rope; it += gridDim.x) {
    if (it < n_mod) p0_mod_item(p, it, smem);
    else if (it < n_mod + n_tr) p0_transpose_item(p, it - n_mod, smem);
    else p0_rope_item(p, it - n_mod - n_tr);
  }
}

DI void filter_item(const Params& p, int layer, int item, char* smem) {
  const int tid = otid();
  int var, pc, cc, L;
  if (item < 512) { var = 0; pc = item >> 3; cc = item & 7; L = 4096; }
  else { var = 1; pc = (item - 512) >> 3; cc = (item - 512) & 7; L = 256; }
  float* z = (float*)smem;
  float* hid = z + 64 * 17;
  float* w2s = hid + 64 * 65;
  __syncthreads();
  {
    const int pos = tid >> 3, band = tid & 7;
    const int pa = pc * 64 + pos;
    const float w = 6.283185307179586f * (float)pa / (float)L;
    const float f = 1e-4f + (float)band * ((7.f - 1e-4f) / 7.f);
    z[pos * 17 + 1 + band] = cosf(f * w);
    z[pos * 17 + 9 + band] = -sinf(f * w);
    if (band == 0) z[pos * 17] = (float)pa / (float)(L - 1);
  }
  __syncthreads();
  {
    const int pos = tid >> 3, j0 = (tid & 7) * 8;
    const float* w1 = p.hy_w1 + layer * 17 * 64;
#pragma unroll
    for (int jj = 0; jj < 8; ++jj) {
      const int j = j0 + jj;
      float pre = p.hy_b1[layer * 64 + j];
      for (int f = 0; f < 17; ++f) pre += z[pos * 17 + f] * w1[f * 64 + j];
      hid[pos * 65 + j] = sinf(p.hy_freq[layer * 64 + j] * pre);
    }
    const float* w2 = p.hy_w2 + (size_t)layer * 64 * 2048 + cc * 256;
    for (int idx = tid; idx < 64 * 256; idx += 512) w2s[idx] = w2[(idx >> 8) * 2048 + (idx & 255)];
  }
  __syncthreads();
  {
    const int lane = tid & 63, wave = tid >> 6, r = lane & 31, hh = lane >> 5;
    f32x16 acc[2];
    acc[0] = zero16();
    acc[1] = zero16();
#pragma unroll 4
    for (int ks = 0; ks < 32; ++ks) {
      const float bv = w2s[(2 * ks + hh) * 256 + wave * 32 + r];
#pragma unroll
      for (int mi = 0; mi < 2; ++mi) {
        const float av = hid[(mi * 32 + r) * 65 + 2 * ks + hh];
        acc[mi] = __builtin_amdgcn_mfma_f32_32x32x2f32(av, bv, acc[mi], 0, 0, 0);
      }
    }
    const int n = cc * 256 + wave * 32 + r;
    const int o = n >> 10, dir = (n >> 9) & 1, c = n & 511;
    const float min_d = -3.0701134573253945f, max_d = -15.350567286626973f;
    const float ad = fabsf(min_d + (float)c * ((max_d - min_d) / 511.f));
    float* g = (float*)(p.ws + (var == 0 ? OFF_GL : OFF_GC)) + ((size_t)(o * 512 + c)) * (2 * L);
    float asum = 0.f;
#pragma unroll
    for (int mi = 0; mi < 2; ++mi)
#pragma unroll
      for (int i = 0; i < 16; ++i) {
        const int pa = pc * 64 + mi * 32 + crow(i, hh);
        const float t = (float)pa / (float)(L - 1);
        const float v = acc[mi][i] * expf(-t * ad);
        asum += fabsf(v);
        int y;
        if (dir == 0) y = L - pa;
        else y = (pa == 0) ? 0 : L + pa;
        g[y] = v;
      }
    atomicAdd((float*)(p.ws + OFF_FSUM) + ((layer * 2 + var) * 2 + o) * 512 + c, asum);
  }
}

DI void p1a(const Params& p, int layer, int grp, char* smem) {
  const int g0 = grp ? TG : 0, tgn = grp ? 16384 : TG;
  const int nfilt = grp ? 0 : 544;
  const int nrow_items = tgn / 8;
  const int tid_ = otid();
  const int lane = tid_ & 63, wave = tid_ >> 6;
  bf16* H = (bf16*)(p.ws + OFF_H);
  const float* mods = (const float*)(p.ws + OFF_MODS);
  for (int it = blockIdx.x; it < nfilt + nrow_items; it += gridDim.x) {
    if (it < nfilt) { filter_item(p, layer, it, smem); continue; }
    const int tl = (it - nfilt) * 8 + wave, tg = g0 + tl;
    const float *qxp = launder(p.x_prompt), *qxs = launder(p.x_sample), *qo = launder(p.out);
    const float* x = layer == 0 ? (tg < T_CTX ? qxp + (size_t)tg * DM : qxs + (size_t)(tg - T_CTX) * DM) : qo + (size_t)tg * DM;
    float4 v[4];
    float ss = 0.f;
#pragma unroll
    for (int i = 0; i < 4; ++i) {
      v[i] = *(const float4*)(x + (lane + 64 * i) * 4);
      ss += v[i].x * v[i].x + v[i].y * v[i].y + v[i].z * v[i].z + v[i].w * v[i].w;
    }
#pragma unroll
    for (int o = 32; o > 0; o >>= 1) ss += __shfl_xor(ss, o);
    const float rstd = rsqrtf(ss * (1.f / 1024.f) + 1e-6f);
    const float* md = mods + (layer * 9 + cond_of(tg)) * 3072;
    const float* nw = p.norm_w + layer * 1024;
#pragma unroll
    for (int i = 0; i < 4; ++i) {
      const int col = (lane + 64 * i) * 4;
      const float4 sh = *(const float4*)(md + col), sc = *(const float4*)(md + 1024 + col), w = *(const float4*)(nw + col);
      bf16x4 o;
      o[0] = (short)f2bf(v[i].x * rstd * w.x * (1.f + sc.x) + sh.x);
      o[1] = (short)f2bf(v[i].y * rstd * w.y * (1.f + sc.y) + sh.y);
      o[2] = (short)f2bf(v[i].z * rstd * w.z * (1.f + sc.z) + sh.z);
      o[3] = (short)f2bf(v[i].w * rstd * w.w * (1.f + sc.w) + sh.w);
      *(bf16x4*)(H + (size_t)tl * 1024 + col) = o;
    }
  }
}

DI void p1b(const Params& p, int layer, int grp, char* smem) {
  const int g0 = grp ? TG : 0, tgn = grp ? 16384 : TG;
  const int mtiles = tgn / 256, ntot = mtiles * 42;
  const int tid = otid(), lane = tid & 63, wave = tid >> 6;
  const int wm = wave >> 1, wn = wave & 1, r = lane & 31, h = lane >> 5;
  const bf16* H = (const bf16*)(p.ws + OFF_H);
  const bf16* WinT = (const bf16*)(p.ws + OFF_W) + (size_t)layer * W_LAYER + W_IN;
  float* S = (float*)smem;
  u32x4 ra[2][4], rb[2][2];
  bool pre = false;
  for (int id = blockIdx.x; id < ntot; id += gridDim.x) {
    const int band = id / (32 * 42), rem = id % (32 * 42);
    const int mt = band * 32 + (rem & 31), nt = rem >> 5;
    const int idn = id + gridDim.x;
    const bool hn = idn < ntot;
    const int bandn = idn / (32 * 42), remn = idn % (32 * 42);
    const int mtn = bandn * 32 + (remn & 31), ntn = remn >> 5;
    f32x16 acc[2][2];
#pragma unroll
    for (int a = 0; a < 2; ++a)
#pragma unroll
      for (int b = 0; b < 2; ++b) acc[a][b] = zero16();
    gemm_main<2, false>(mksrc(H + (size_t)mt * 256 * 1024, 1024, WinT + (size_t)nt * 128 * 1024, 1024, 0), 1024, acc, smem, ra, rb, pre,
                        mksrc(H + (size_t)mtn * 256 * 1024, 1024, WinT + (size_t)ntn * 128 * 1024, 1024, 0), hn);
    pre = true;
    const int m0 = mt * 256, tg0 = g0 + m0;
    const bool lat = tg0 >= T_CTX;
    if (nt < 16) {
#pragma unroll
      for (int mi = 0; mi < 2; ++mi)
#pragma unroll
        for (int ni = 0; ni < 2; ++ni)
#pragma unroll
          for (int g4 = 0; g4 < 4; ++g4) {
            f32x4v v;
#pragma unroll
            for (int j = 0; j < 4; ++j) v[j] = acc[mi][ni][4 * g4 + j];
            *(f32x4v*)(S + (wn * 64 + ni * 32 + r) * 260 + wm * 64 + mi * 32 + 8 * g4 + 4 * h) = v;
          }
      __syncthreads();
      const int part = nt >> 2;
#pragma unroll 2
      for (int it = 0; it < 8; ++it) {
        const int pid = tid + 512 * it, cl = pid >> 5, q = pid & 31;
        const f32x4v a = *(const f32x4v*)(S + cl * 260 + q * 8), b = *(const f32x4v*)(S + cl * 260 + q * 8 + 4);
        bf16x8 v;
#pragma unroll
        for (int j = 0; j < 4; ++j) {
          v[j] = (short)f2bf(a[j]);
          v[4 + j] = (short)f2bf(b[j]);
        }
        *(bf16x8*)((bf16*)(p.ws + OFF_HYT) + ((size_t)(part * 512 + (nt & 3) * 128 + cl)) * TG + m0 + q * 8) = v;
      }
    } else {
#pragma unroll
      for (int mi = 0; mi < 2; ++mi)
#pragma unroll
        for (int ni = 0; ni < 2; ++ni)
#pragma unroll
          for (int i = 0; i < 16; ++i) S[(wm * 64 + mi * 32 + crow(i, h)) * 132 + wn * 64 + ni * 32 + r] = acc[mi][ni][i];
      __syncthreads();
      size_t off; int pitch, coloff; bool rope = false; int cache = 0;
      if (nt < 20) { off = OFF_AQ; pitch = 512; coloff = (nt - 16) * 128; rope = lat; }
      else if (nt == 20) { off = OFF_AK; pitch = 128; coloff = 0; rope = lat; cache = lat ? 0 : 1; }
      else if (nt == 21) { off = OFF_AV; pitch = 128; coloff = 0; cache = lat ? 0 : 2; }
      else if (nt < 26) { off = OFF_AG; pitch = 512; coloff = (nt - 22) * 128; }
      else if (nt < 30) { off = OFF_RQ; pitch = 512; coloff = (nt - 26) * 128; rope = lat; }
      else if (nt < 34) { off = OFF_RK; pitch = 512; coloff = (nt - 30) * 128; rope = lat; }
      else if (nt < 38) { off = OFF_RV; pitch = 512; coloff = (nt - 34) * 128; }
      else { off = OFF_RG; pitch = 512; coloff = (nt - 38) * 128; }
      bf16* dst = (bf16*)(p.ws + off);
      const float2* rt = (const float2*)(p.ws + OFF_ROPE);
#pragma unroll 2
      for (int it = 0; it < 8; ++it) {
        const int cid = tid + 512 * it, row = cid >> 4, cc = cid & 15;
        const float* sp = S + row * 132 + cc * 8;
        float v[8];
#pragma unroll
        for (int j = 0; j < 8; ++j) v[j] = sp[j];
        if (cache) {
          float* co = p.out + (cache == 1 ? OUT_CK : OUT_CV) + ((size_t)((tg0 >> 8) * 4 + layer) * 256 + row) * 128 + cc * 8;
          *(float4*)co = make_float4(v[0], v[1], v[2], v[3]);
          *(float4*)(co + 4) = make_float4(v[4], v[5], v[6], v[7]);
        }
        if (rope) {
          const int hd0 = (cc * 8) & 63, q = hd0 >> 4;
          const int tpos = (tg0 - T_CTX + row) & 4095;
          const float2* tb = rt + tpos * 32 + (q >> 1) * 16 + (hd0 & 15);
          const float* pp = sp + ((q & 1) ? -16 : 16);
          const float sg = (q & 1) ? 1.f : -1.f;
#pragma unroll
          for (int j = 0; j < 8; ++j) {
            const float2 cs = tb[j];
            v[j] = v[j] * cs.x + sg * pp[j] * cs.y;
          }
        }
        bf16x8 o;
#pragma unroll
        for (int j = 0; j < 8; ++j) o[j] = (short)f2bf(v[j]);
        *(bf16x8*)(dst + (size_t)(m0 + row) * pitch + coloff + cc * 8) = o;
      }
    }
  }
}

template <int NBT, int L>
DI void hyena_item(const Params& p, int layer, int var, int tlbase, int c, char* smem) {
  constexpr int NP = 32 / NBT, NT = (L / 8) / (32 * NP), UP = L + 8;
  bf16* U = (bf16*)smem;
  bf16* X1 = U + NBT * UP;
  bf16* X2 = X1 + NBT * UP;
  bf16* GR = X2 + NBT * UP;
  bf16* GR1 = GR + 2 * L + 8;
  const int tid = otid(), lane = tid & 63, wave = tid >> 6;
  const int n = lane & 31, hh = lane >> 5, b = n & (NBT - 1), pp = n / NBT;
  const bf16* hyT = (const bf16*)(p.ws + OFF_HYT);
  const float* fs = (const float*)(p.ws + OFF_FSUM) + (layer * 2 + var) * 1024;
  const float* gsrc = (const float*)(p.ws + (var == 0 ? OFF_GL : OFF_GC));
  __syncthreads();
#pragma unroll 1
  for (int part = 0; part < 3; ++part) {
    const bf16* src = hyT + ((size_t)(part * 512 + c)) * TG + tlbase;
    bf16* dstb = part == 0 ? U : part == 1 ? X1 : X2;
    const float w0 = p.hy_conv[(layer * 3 + 0) * 1536 + part * 512 + c];
    const float w1 = p.hy_conv[(layer * 3 + 1) * 1536 + part * 512 + c];
    const float w2 = p.hy_conv[(layer * 3 + 2) * 1536 + part * 512 + c];
#pragma unroll
    for (int it = 0; it < NBT * L / 8 / 512; ++it) {
      const int id = tid + 512 * it;
      const int bb = id / (L / 8), t8 = (id % (L / 8)) * 8;
      const bf16* s = src + bb * L + t8;
      const bf16x8 xv = *(const bf16x8*)s;
      float x[10];
      x[0] = t8 > 0 ? bf2f(s[-1]) : 0.f;
      x[9] = t8 + 8 < L ? bf2f(s[8]) : 0.f;
#pragma unroll
      for (int j = 0; j < 8; ++j) x[j + 1] = bf2f((bf16)xv[j]);
      bf16x8 o;
#pragma unroll
      for (int j = 0; j < 8; ++j) o[j] = (short)f2bf(w0 * x[j] + w1 * x[j + 1] + w2 * x[j + 2]);
      *(bf16x8*)(dstb + bb * UP + t8) = o;
    }
  }
  const int wbase = wave * (L / 8);
  const int dmin = -(wbase + (NT - 1) * 32 * NP + 32 * (NP - 1)), dmax = L - 16 - wbase;
  f32x16 acc[NT];
#pragma unroll 1
  for (int o = 0; o < 2; ++o) {
    {
      const float inv = 1.f / fs[o * 512 + c];
      const float* gs = gsrc + ((size_t)(o * 512 + c)) * (2 * L);
      const float skip = p.hy_skip[(layer * 2 + o) * 512 + c];
#pragma unroll 8
      for (int y = tid; y < 2 * L; y += 512) {
        float v = gs[y] * inv;
        if (y == L) v = (gs[L] + gs[0]) * inv + skip;
        if (y == 0) v = 0.f;
        const bf16 bv = f2bf(v);
        GR[y] = bv;
        if (y > 0) GR1[y - 1] = bv;
      }
      if (tid == 0) GR1[2 * L - 1] = 0;
    }
    __syncthreads();
#pragma unroll
    for (int q = 0; q < NT; ++q) acc[q] = zero16();
#pragma unroll 1
    for (int d = dmin; d <= dmax; d += 16) {
      const unsigned* gp = (const unsigned*)(((n & 1) ? GR1 - 1 : GR) + (L - n + d + 8 * hh));
      typedef __attribute__((ext_vector_type(4))) unsigned u4;
      u4 aw;
#pragma unroll
      for (int j = 0; j < 4; ++j) aw[j] = gp[j];
      const bf16x8 a = __builtin_bit_cast(bf16x8, aw);
#pragma unroll
      for (int q = 0; q < NT; ++q) {
        const int s0 = wbase + q * 32 * NP + 32 * pp + d;
        bf16x8 bb;
#pragma unroll
        for (int j = 0; j < 8; ++j) bb[j] = 0;
        if (s0 >= 0 && s0 <= L - 16) bb = *(const bf16x8*)(U + b * UP + s0 + 8 * hh);
        acc[q] = MFMA(a, bb, acc[q]);
      }
    }
    __syncthreads();
    if (o == 0) {
#pragma unroll
      for (int q = 0; q < NT; ++q)
#pragma unroll
        for (int i = 0; i < 16; ++i) {
          const int t = wbase + q * 32 * NP + 32 * pp + crow(i, hh);
          U[b * UP + t] = f2bf(bf2f(X1[b * UP + t]) * acc[q][i]);
        }
    } else {
      const bf16* gate = hyT + ((size_t)(3 * 512 + c)) * TG + tlbase;
#pragma unroll
      for (int q = 0; q < NT; ++q)
#pragma unroll
        for (int g4 = 0; g4 < 4; ++g4) {
          const int t = wbase + q * 32 * NP + 32 * pp + 8 * g4 + 4 * hh;
          const bf16x4 gv = *(const bf16x4*)(gate + b * L + t);
          bf16x4 ov;
#pragma unroll
          for (int j = 0; j < 4; ++j)
            ov[j] = (short)f2bf(bf2f(X2[b * UP + t + j]) * acc[q][4 * g4 + j] * siluf(bf2f((bf16)gv[j])));
          *(bf16x4*)(U + b * UP + t) = ov;
        }
      __syncthreads();
      bf16* yat = (bf16*)(p.ws + OFF_YA) + (size_t)c * TG + tlbase;
      for (int id = tid; id < NBT * L / 8; id += 512) {
        const int bb = id / (L / 8), t8 = (id % (L / 8)) * 8;
        *(bf16x8*)(yat + bb * L + t8) = *(const bf16x8*)(U + bb * UP + t8);
      }
    }
  }
}

DI void attn_item(const Params& p, int layer, bool lat, int tlbase, int bglob, int kvh, int qblk, char* smem) {
  bf16* Ks = (bf16*)smem;
  bf16* VT = Ks + 64 * 72;
  const int tid = otid(), lane = tid & 63, wave = tid >> 6;
  const int r = lane & 31, hh = lane >> 5;
  const int head = kvh * 4 + (wave >> 1);
  const int qi = qblk * 64 + (wave & 1) * 32 + r;
  const int tlq = tlbase + qi;
  const bf16* aq = (const bf16*)(p.ws + OFF_AQ);
  const bf16* ak = (const bf16*)(p.ws + OFF_AK);
  const bf16* av = (const bf16*)(p.ws + OFF_AV);
  bf16* ag = (bf16*)(p.ws + OFF_AG);
  bf16x8 bq[4];
#pragma unroll
  for (int ks = 0; ks < 4; ++ks) bq[ks] = *(const bf16x8*)(aq + (size_t)tlq * 512 + head * 64 + ks * 16 + hh * 8);
  const float sink2 = p.attn_sink[layer * 8 + head] * LOG2E;
  const float SC = 0.125f * LOG2E;
  float m = sink2, lsum = 0.f;
  f32x16 O[2];
  O[0] = zero16();
  O[1] = zero16();
  const int t_lo = lat ? (2 - qblk > 0 ? 2 - qblk : 0) : 0;
  const int t_hi = lat ? (65 - qblk < 4 ? 65 - qblk : 4) : 3;
  const int nw = t_hi - t_lo + 1;
  const int ntot = lat ? nw + 8 : nw;
  const int lj = tid >> 3, lkc = (tid & 7) * 8;
  u32x4 pr0, pr1, pr2, pr3;
  pr2 = u32x4{0, 0, 0, 0};
  pr3 = u32x4{0, 0, 0, 0};
  {
    const int kp = lat ? qblk * 64 - 128 + t_lo * 64 : 0;
    const size_t o = (size_t)(tlbase + kp + lj) * 128 + kvh * 64 + lkc;
    pr0 = *(const u32x4*)(ak + o);
    pr1 = *(const u32x4*)(av + o);
  }
#pragma unroll 1
  for (int n = 0; n < ntot; ++n) {
    const bool from_cache = lat && n >= nw;
    const bool window = lat && n < nw && (t_lo + n == 0 || t_lo + n == 4);
    const int kpos0 = from_cache ? (n - nw) * 64 : (lat ? qblk * 64 - 128 + (t_lo + n) * 64 : n * 64);
    lds_barrier();
    {
      bf16x8 kv, vv;
      if (from_cache) {
        const f32x4v k0 = __builtin_bit_cast(f32x4v, pr0), k1 = __builtin_bit_cast(f32x4v, pr1);
        const f32x4v v0 = __builtin_bit_cast(f32x4v, pr2), v1 = __builtin_bit_cast(f32x4v, pr3);
#pragma unroll
        for (int e = 0; e < 4; ++e) {
          kv[e] = (short)f2bf(k0[e]);
          kv[4 + e] = (short)f2bf(k1[e]);
          vv[e] = (short)f2bf(v0[e]);
          vv[4 + e] = (short)f2bf(v1[e]);
        }
      } else {
        kv = __builtin_bit_cast(bf16x8, pr0);
        vv = __builtin_bit_cast(bf16x8, pr1);
      }
      *(bf16x8*)(Ks + lj * 72 + lkc) = kv;
#pragma unroll
      for (int jj = 0; jj < 8; ++jj) VT[(lkc + jj) * 68 + lj] = (bf16)vv[jj];
    }
    lds_barrier();
    {
      const int nn = n + 1 < ntot ? n + 1 : n;
      if (lat && nn >= nw) {
        const size_t o = ((((size_t)bglob * 4 + layer) * 512 + (nn - nw) * 64 + lj) * 2 + kvh) * 64 + lkc;
        pr0 = *(const u32x4*)(p.cache_k + o);
        pr1 = *(const u32x4*)(p.cache_k + o + 4);
        pr2 = *(const u32x4*)(p.cache_v + o);
        pr3 = *(const u32x4*)(p.cache_v + o + 4);
      } else {
        const int kp = lat ? qblk * 64 - 128 + (t_lo + nn) * 64 : nn * 64;
        const size_t o = (size_t)(tlbase + kp + lj) * 128 + kvh * 64 + lkc;
        pr0 = *(const u32x4*)(ak + o);
        pr1 = *(const u32x4*)(av + o);
      }
    }
    f32x16 sc[2];
#pragma unroll
    for (int sub = 0; sub < 2; ++sub) {
      sc[sub] = zero16();
#pragma unroll
      for (int ks = 0; ks < 4; ++ks) {
        const bf16x8 a = *(const bf16x8*)(Ks + (sub * 32 + r) * 72 + ks * 16 + hh * 8);
        sc[sub] = MFMA(a, bq[ks], sc[sub]);
      }
    }
    float mx = -3.0e38f;
#pragma unroll
    for (int sub = 0; sub < 2; ++sub)
#pragma unroll
      for (int i = 0; i < 16; ++i) {
        float sv = sc[sub][i] * SC;
        if (window) {
          const int diff = qi - (kpos0 + sub * 32 + crow(i, hh));
          if (diff > 128 || diff < -128) sv = -1e30f;
        }
        sc[sub][i] = sv;
        mx = fmaxf(mx, sv);
      }
    mx = fmaxf(mx, __shfl_xor(mx, 32));
    const float mnew = fmaxf(m, mx);
    const float alpha = __builtin_amdgcn_exp2f(m - mnew);
    m = mnew;
    float ps = 0.f;
#pragma unroll
    for (int sub = 0; sub < 2; ++sub)
#pragma unroll
      for (int i = 0; i < 16; ++i) {
        sc[sub][i] = __builtin_amdgcn_exp2f(sc[sub][i] - m);
        ps += sc[sub][i];
      }
    lsum = lsum * alpha + ps;
    if (__builtin_amdgcn_ballot_w64(alpha != 1.f) != 0) {
#pragma unroll
      for (int i = 0; i < 16; ++i) {
        O[0][i] *= alpha;
        O[1][i] *= alpha;
      }
    }
#pragma unroll
    for (int sub = 0; sub < 2; ++sub)
#pragma unroll
      for (int st = 0; st < 2; ++st) {
        const bf16x8 pf = pack8(sc[sub], st);
#pragma unroll
        for (int mi = 0; mi < 2; ++mi) {
          const bf16* vp = VT + (mi * 32 + r) * 68 + sub * 32 + 16 * st + 4 * hh;
          const bf16x4 lo = *(const bf16x4*)vp, hi = *(const bf16x4*)(vp + 8);
          const bf16x8 va = __builtin_shufflevector(lo, hi, 0, 1, 2, 3, 4, 5, 6, 7);
          O[mi] = MFMA(va, pf, O[mi]);
        }
      }
  }
  const float ltot = lsum + __shfl_xor(lsum, 32) + exp2f(sink2 - m);
  const float inv = 1.f / ltot;
#pragma unroll
  for (int mi = 0; mi < 2; ++mi)
#pragma unroll
    for (int g4 = 0; g4 < 4; ++g4) {
      bf16* gp = ag + (size_t)tlq * 512 + head * 64 + mi * 32 + 8 * g4 + 4 * hh;
      const bf16x4 gv = *(const bf16x4*)gp;
      bf16x4 o;
#pragma unroll
      for (int j = 0; j < 4; ++j) o[j] = (short)f2bf(O[mi][4 * g4 + j] * inv * siluf(bf2f((bf16)gv[j])));
      *(bf16x4*)gp = o;
    }
}

DI void ret_item(const Params& p, int layer, bool lat, int NC, int tlbase, int bglob, int hd, char* smem) {
  const int tid = otid(), lane = tid & 63, wave = tid >> 6;
  const int dir = wave >> 2, w4 = wave & 3, r = lane & 31, hh = lane >> 5, dt = tid & 255;
  bf16* Ks = (bf16*)smem + dir * 31232;
  bf16* KdT = Ks + 128 * 72;
  bf16* VT = KdT + 64 * 136;
  bf16* ST = VT + 64 * 136;
  const bf16* rq = (const bf16*)(p.ws + OFF_RQ);
  const bf16* rk = (const bf16*)(p.ws + OFF_RK);
  const bf16* rv = (const bf16*)(p.ws + OFF_RV);
  bf16* rg = (bf16*)(p.ws + OFF_RG);
  bf16* ofb = (bf16*)(p.ws + OFF_OFB);
  const float theta = p.ret_theta[(layer * 2 + dir) * 8 + hd];
  const float lg2 = -log1pf(expf(-theta)) * LOG2E;
  const float cdec = exp2f(lg2 * 128.f);
  const int etile = w4 >> 1, dtile = w4 & 1;
  f32x16 Sacc;
  if (lat) {
    const float* s0 = p.state_ret + ((((size_t)bglob * 4 + layer) * 2 + dir) * 8 + hd) * 4096;
#pragma unroll
    for (int i = 0; i < 16; ++i) Sacc[i] = s0[(dtile * 32 + r) * 64 + etile * 32 + crow(i, hh)];
  } else {
    Sacc = zero16();
  }
  __syncthreads();
#pragma unroll
  for (int i = 0; i < 16; ++i) ST[(etile * 32 + crow(i, hh)) * 72 + dtile * 32 + r] = f2bf(Sacc[i]);
#pragma unroll 1
  for (int step = 0; step < NC; ++step) {
    const int ch = dir ? NC - 1 - step : step;
    const int tl0 = tlbase + ch * 128;
    const int iq = w4 * 32 + r, tlq = tl0 + iq;
    const bool second = step >= NC / 2;
    bf16x8 kv[4], vv[4], bq[4];
    bf16x4 pp[8], pg[8];
    const int jrow = dt & 127;
#pragma unroll
    for (int i = 0; i < 4; ++i) {
      const int kc = ((dt >> 7) + 2 * i) * 8;
      const size_t o = (size_t)(tl0 + jrow) * 512 + hd * 64 + kc;
      kv[i] = *(const bf16x8*)(rk + o);
      vv[i] = *(const bf16x8*)(rv + o);
    }
#pragma unroll
    for (int ks = 0; ks < 4; ++ks) bq[ks] = *(const bf16x8*)(rq + (size_t)tlq * 512 + hd * 64 + ks * 16 + hh * 8);
    if (second) {
#pragma unroll
      for (int mi = 0; mi < 2; ++mi)
#pragma unroll
        for (int g4 = 0; g4 < 4; ++g4) {
          const size_t o = (size_t)tlq * 512 + hd * 64 + mi * 32 + 8 * g4 + 4 * hh;
          pp[mi * 4 + g4] = *(const bf16x4*)(ofb + o);
          pg[mi * 4 + g4] = *(const bf16x4*)(rg + o);
        }
    } else {
#pragma unroll
      for (int i = 0; i < 8; ++i) {
        pp[i] = bf16x4{0, 0, 0, 0};
        pg[i] = bf16x4{0, 0, 0, 0};
      }
    }
    {
      const float kd = exp2f(lg2 * (float)(dir ? jrow : 127 - jrow)) * 0.125f;
#pragma unroll
      for (int i = 0; i < 4; ++i) {
        const int kc = ((dt >> 7) + 2 * i) * 8;
        *(bf16x8*)(Ks + jrow * 72 + kc) = kv[i];
#pragma unroll
        for (int jj = 0; jj < 8; ++jj) {
          KdT[(kc + jj) * 136 + jrow] = f2bf(bf2f((bf16)kv[i][jj]) * kd);
          VT[(kc + jj) * 136 + jrow] = (bf16)vv[i][jj];
        }
      }
    }
    __syncthreads();
    f32x16 O[2];
    {
      const float qd = exp2f(lg2 * (float)(dir ? 128 - iq : iq + 1));
#pragma unroll
      for (int mi = 0; mi < 2; ++mi) {
        f32x16 oc = zero16();
#pragma unroll
        for (int ks = 0; ks < 4; ++ks) {
          const bf16x8 a = *(const bf16x8*)(ST + (mi * 32 + r) * 72 + ks * 16 + hh * 8);
          oc = MFMA(a, bq[ks], oc);
        }
#pragma unroll
        for (int i = 0; i < 16; ++i) O[mi][i] = oc[i] * qd;
      }
    }
#pragma unroll 1
    for (int jt = 0; jt < 4; ++jt) {
      if (dir == 0 ? (jt <= w4) : (jt >= w4)) {
        f32x16 s = zero16();
#pragma unroll
        for (int ks = 0; ks < 4; ++ks) {
          const bf16x8 a = *(const bf16x8*)(Ks + (jt * 32 + r) * 72 + ks * 16 + hh * 8);
          s = MFMA(a, bq[ks], s);
        }
#pragma unroll
        for (int i = 0; i < 16; ++i) {
          const int j = jt * 32 + crow(i, hh);
          const int diff = dir ? j - iq : iq - j;
          s[i] = diff >= 0 ? s[i] * 0.125f * __builtin_amdgcn_exp2f(lg2 * (float)diff) : 0.f;
        }
#pragma unroll
        for (int st = 0; st < 2; ++st) {
          const bf16x8 pf = pack8(s, st);
#pragma unroll
          for (int mi = 0; mi < 2; ++mi) {
            const bf16* vp = VT + (mi * 32 + r) * 136 + jt * 32 + 16 * st + 4 * hh;
            const bf16x4 lo = *(const bf16x4*)vp, hi = *(const bf16x4*)(vp + 8);
            const bf16x8 va = __builtin_shufflevector(lo, hi, 0, 1, 2, 3, 4, 5, 6, 7);
            O[mi] = MFMA(va, pf, O[mi]);
          }
        }
      }
    }
#pragma unroll
    for (int i = 0; i < 16; ++i) Sacc[i] *= cdec;
#pragma unroll 2
    for (int jk = 0; jk < 8; ++jk) {
      const bf16x8 a = *(const bf16x8*)(VT + (etile * 32 + r) * 136 + jk * 16 + hh * 8);
      const bf16x8 bb = *(const bf16x8*)(KdT + (dtile * 32 + r) * 136 + jk * 16 + hh * 8);
      Sacc = MFMA(a, bb, Sacc);
    }
    if (!second) {
#pragma unroll
      for (int mi = 0; mi < 2; ++mi)
#pragma unroll
        for (int g4 = 0; g4 < 4; ++g4) {
          bf16x4 o;
#pragma unroll
          for (int j = 0; j < 4; ++j) o[j] = (short)f2bf(O[mi][4 * g4 + j]);
          *(bf16x4*)(ofb + (size_t)tlq * 512 + hd * 64 + mi * 32 + 8 * g4 + 4 * hh) = o;
        }
    } else {
      float ss = 0.f;
#pragma unroll
      for (int mi = 0; mi < 2; ++mi)
#pragma unroll
        for (int g4 = 0; g4 < 4; ++g4) {
          const bf16x4 pv = pp[mi * 4 + g4];
#pragma unroll
          for (int j = 0; j < 4; ++j) {
            const float v = O[mi][4 * g4 + j] + bf2f((bf16)pv[j]);
            O[mi][4 * g4 + j] = v;
            ss += v * v;
          }
        }
      ss += __shfl_xor(ss, 32);
      const float rn = rsqrtf(ss * (1.f / 64.f) + 1e-6f);
#pragma unroll
      for (int mi = 0; mi < 2; ++mi)
#pragma unroll
        for (int g4 = 0; g4 < 4; ++g4) {
          const int e0 = hd * 64 + mi * 32 + 8 * g4 + 4 * hh;
          bf16* gp = rg + (size_t)tlq * 512 + e0;
          const bf16x4 gv = pg[mi * 4 + g4];
          const float4 gn = *(const float4*)(p.ret_gn + layer * 512 + e0);
          bf16x4 o;
          o[0] = (short)f2bf(O[mi][4 * g4 + 0] * rn * gn.x * siluf(bf2f((bf16)gv[0])));
          o[1] = (short)f2bf(O[mi][4 * g4 + 1] * rn * gn.y * siluf(bf2f((bf16)gv[1])));
          o[2] = (short)f2bf(O[mi][4 * g4 + 2] * rn * gn.z * siluf(bf2f((bf16)gv[2])));
          o[3] = (short)f2bf(O[mi][4 * g4 + 3] * rn * gn.w * siluf(bf2f((bf16)gv[3])));
          *(bf16x4*)gp = o;
        }
    }
    __builtin_amdgcn_fence(__ATOMIC_SEQ_CST, "workgroup");
    __syncthreads();
#pragma unroll
    for (int i = 0; i < 16; ++i) ST[(etile * 32 + crow(i, hh)) * 72 + dtile * 32 + r] = f2bf(Sacc[i]);
  }
  if (!lat) {
    float* so = p.out + OUT_ST + ((((size_t)bglob * 4 + layer) * 2 + dir) * 8 + hd) * 4096;
#pragma unroll
    for (int i = 0; i < 16; ++i) so[(dtile * 32 + r) * 64 + etile * 32 + crow(i, hh)] = Sacc[i];
  }
}

DI void p2(const Params& p, int layer, int grp, char* smem, int* s_item) {
  int* ctr = (int*)(p.ws + OFF_CTR) + layer * 2 + grp;
  const int n_rl = 32, n_hl = 512, n_al = 512;
  const int n_hc = grp ? 0 : 512, n_rc = grp ? 0 : 256, n_ac = grp ? 0 : 256;
  const int total = n_rl + n_hl + n_al + n_hc + n_rc + n_ac;
  const int latbase = grp ? 0 : T_CTX;
  const int latb0 = grp ? 4 : 0;
  for (;;) {
    __syncthreads();
    if (threadIdx.x == 0) *s_item = atomicAdd(ctr, 1);
    __syncthreads();
    int it = *s_item;
    if (it >= total) break;
    if (it < n_rl) {
      const int b = it >> 3, hd = it & 7;
      ret_item(p, layer, true, 32, latbase + b * 4096, latb0 + b, hd, smem);
      continue;
    }
    it -= n_rl;
    if (it < n_hl) { hyena_item<4, 4096>(p, layer, 0, latbase, it, smem); continue; }
    it -= n_hl;
    if (it < n_al) {
      const int b = it >> 7, kvh = (it >> 6) & 1, qb = it & 63;
      attn_item(p, layer, true, latbase + b * 4096, latb0 + b, kvh, qb, smem);
      continue;
    }
    it -= n_al;
    if (it < n_hc) { hyena_item<32, 256>(p, layer, 1, 0, it, smem); continue; }
    it -= n_hc;
    if (it < n_rc) {
      const int b = it >> 3, hd = it & 7;
      ret_item(p, layer, false, 2, b * 256, b, hd, smem);
      continue;
    }
    it -= n_rc;
    {
      const int b = it >> 3, kvh = (it >> 2) & 1, qb = it & 3;
      attn_item(p, layer, false, b * 256, b, kvh, qb, smem);
    }
  }
}

DI unsigned pk2(float a, float b) { return (unsigned)f2bf(a) | ((unsigned)f2bf(b) << 16); }
DI float pklo(unsigned u) { return __uint_as_float(u << 16); }
DI float pkhi(unsigned u) { return __uint_as_float(u & 0xffff0000u); }
DI void p3a(const Params& p, int layer, int grp, char* smem) {
  const int tgn = grp ? 16384 : TG;
  const int mtiles = tgn / 256, ntot = mtiles * 8;
  const int tid = otid(), lane = tid & 63, wave = tid >> 6;
  const int wm = wave >> 1, wn = wave & 1, r = lane & 31, h = lane >> 5;
  const bf16* H = (const bf16*)(p.ws + OFF_H);
  const bf16* wl = (const bf16*)(p.ws + OFF_W) + (size_t)layer * W_LAYER;
  bf16* MG = (bf16*)(p.ws + OFF_MERGED);
  u32x4 ra[2][4], rb[2][2];
  bool pre = false;
  const bf16* YaT = (const bf16*)(p.ws + OFF_YA);
  for (int id = blockIdx.x; id < ntot; id += gridDim.x) {
    const int m0 = ((id >> 7) * 16 + (id & 15)) * 256, n0 = ((id & 127) >> 4) * 128;
    const int idn = id + gridDim.x;
    const bool hn = idn < ntot;
    const int m0n = ((idn >> 7) * 16 + (idn & 15)) * 256, n0n = ((idn & 127) >> 4) * 128;
    unsigned mgp[2][2][8];
#pragma unroll
    for (int a = 0; a < 2; ++a)
#pragma unroll
      for (int b = 0; b < 2; ++b)
#pragma unroll
        for (int i = 0; i < 8; ++i) mgp[a][b][i] = 0u;
#pragma unroll 1
    for (int br = 0; br < 3; ++br) {
      const GemmSrc gate = mksrc(H + (size_t)m0 * 1024, 1024, wl + W_MG + (size_t)(br * 1024 + n0) * 1024, 1024, 0);
      const bf16* WB = wl + (br == 0 ? W_A : br == 1 ? W_B : W_C);
      const GemmSrc bsrc = br == 0 ? mksrc(YaT + m0, TG, WB + (size_t)n0 * 512, 512, 1)
                                   : mksrc((const bf16*)(p.ws + (br == 1 ? OFF_AG : OFF_RG)) + (size_t)m0 * 512, 512, WB + (size_t)n0 * 512, 512, 0);
      const GemmSrc after = br < 2 ? mksrc(H + (size_t)m0 * 1024, 1024, wl + W_MG + (size_t)((br + 1) * 1024 + n0) * 1024, 1024, 0)
                                   : mksrc(H + (size_t)m0n * 1024, 1024, wl + W_MG + (size_t)n0n * 1024, 1024, 0);
      unsigned sg[2][2][8];
      {
        f32x16 ag[2][2];
#pragma unroll
        for (int a = 0; a < 2; ++a)
#pragma unroll
          for (int b = 0; b < 2; ++b) ag[a][b] = zero16();
        gemm_main<2, false>(gate, 1024, ag, smem, ra, rb, false, bsrc, false);
#pragma unroll
        for (int ni = 0; ni < 2; ++ni) {
          const float bias = p.b_merge[layer * 3072 + br * 1024 + n0 + wn * 64 + ni * 32 + r];
#pragma unroll
          for (int mi = 0; mi < 2; ++mi) {
#pragma unroll
            for (int i = 0; i < 8; ++i)
              sg[mi][ni][i] = pk2(sigmf(ag[mi][ni][2 * i] + bias), sigmf(ag[mi][ni][2 * i + 1] + bias));
            __builtin_amdgcn_sched_barrier(0);
          }
        }
      }
      f32x16 ay[2][2];
#pragma unroll
      for (int a = 0; a < 2; ++a)
#pragma unroll
        for (int b = 0; b < 2; ++b) ay[a][b] = zero16();
      if (br == 0) gemm_main<2, true>(bsrc, 512, ay, smem, ra, rb, false, after, false);
      else gemm_main<2, false>(bsrc, 512, ay, smem, ra, rb, false, after, false);
#pragma unroll
      for (int mi = 0; mi < 2; ++mi)
#pragma unroll
        for (int ni = 0; ni < 2; ++ni) {
#pragma unroll
          for (int i = 0; i < 8; ++i) {
            const float lo = pklo(mgp[mi][ni][i]) + pklo(sg[mi][ni][i]) * ay[mi][ni][2 * i];
            const float hi = pkhi(mgp[mi][ni][i]) + pkhi(sg[mi][ni][i]) * ay[mi][ni][2 * i + 1];
            mgp[mi][ni][i] = pk2(lo, hi);
          }
          __builtin_amdgcn_sched_barrier(0);
        }
    }
    {
      const int t2 = otid(), l2 = t2 & 63, w2 = t2 >> 6;
      const int wm2 = w2 >> 1, wn2 = w2 & 1, r2 = l2 & 31, h2 = l2 >> 5;
#pragma unroll
      for (int mi = 0; mi < 2; ++mi)
#pragma unroll
        for (int ni = 0; ni < 2; ++ni)
#pragma unroll
          for (int i = 0; i < 8; ++i) {
            bf16* d = MG + (size_t)(m0 + wm2 * 64 + mi * 32) * 1024 + n0 + wn2 * 64 + ni * 32 + r2;
            d[(size_t)crow(2 * i, h2) * 1024] = (bf16)(mgp[mi][ni][i] & 0xffffu);
            d[(size_t)crow(2 * i + 1, h2) * 1024] = (bf16)(mgp[mi][ni][i] >> 16);
          }
    }
  }
}

DI void p3b(const Params& p, int layer, int grp, char* smem) {
  const int g0 = grp ? TG : 0, tgn = grp ? 16384 : TG;
  const int mtiles = tgn / 256, ntot = mtiles * 8;
  const int tid = otid(), lane = tid & 63, wave = tid >> 6;
  const int wm = wave >> 1, wn = wave & 1, r = lane & 31, h = lane >> 5;
  const bf16* MG = (const bf16*)(p.ws + OFF_MERGED);
  const bf16* WoT = (const bf16*)(p.ws + OFF_W) + (size_t)layer * W_LAYER + W_O;
  const float* mods = (const float*)(p.ws + OFF_MODS);
  u32x4 ra[2][4], rb[2][2];
  bool pre = false;
  for (int id = blockIdx.x; id < ntot; id += gridDim.x) {
    const int band = id >> 7, rem = id & 127;
    const int mt = band * 16 + (rem & 15), nt = rem >> 4;
    const int m0 = mt * 256, n0 = nt * 128;
    const int idn = id + gridDim.x;
    const bool hn = idn < ntot;
    const int m0n = ((idn >> 7) * 16 + (idn & 15)) * 256, n0n = ((idn & 127) >> 4) * 128;
    f32x16 acc[2][2];
#pragma unroll
    for (int a = 0; a < 2; ++a)
#pragma unroll
      for (int b = 0; b < 2; ++b) acc[a][b] = zero16();
    gemm_main<2, false>(mksrc(MG + (size_t)m0 * 1024, 1024, WoT + (size_t)n0 * 1024, 1024, 0), 1024, acc, smem, ra, rb, pre,
                        mksrc(MG + (size_t)m0n * 1024, 1024, WoT + (size_t)n0n * 1024, 1024, 0), hn);
    pre = true;
    const int tg0 = g0 + m0;
    const float* gate = mods + (layer * 9 + cond_of(tg0)) * 3072 + 2048;
    const float *qxp = launder(p.x_prompt), *qxs = launder(p.x_sample), *qo = launder(p.out);
    const float* xsb = layer == 0 ? (tg0 < T_CTX ? qxp + (size_t)tg0 * DM : qxs + (size_t)(tg0 - T_CTX) * DM) : qo + (size_t)tg0 * DM;
    float* xdb = p.out + (size_t)tg0 * DM;
#pragma unroll
    for (int ni = 0; ni < 2; ++ni) {
      const int col = n0 + wn * 64 + ni * 32 + r;
      const float gt = gate[col];
#pragma unroll
      for (int mi = 0; mi < 2; ++mi)
#pragma unroll
        for (int i = 0; i < 16; ++i) {
          const int ro = (wm * 64 + mi * 32 + crow(i, h)) * DM + col;
          xdb[ro] = xsb[ro] + gt * acc[mi][ni][i];
        }
    }
  }
}

DI void final_norm(const Params& p) {
  const int tid_ = otid();
  const int lane = tid_ & 63, wave = tid_ >> 6;
  for (int it = blockIdx.x; it < T_ALL / 8; it += gridDim.x) {
    const int tg = it * 8 + wave;
    float* x = p.out + (size_t)tg * DM;
    float4 v[4];
    float ss = 0.f;
#pragma unroll
    for (int i = 0; i < 4; ++i) {
      v[i] = *(const float4*)(x + (lane + 64 * i) * 4);
      ss += v[i].x * v[i].x + v[i].y * v[i].y + v[i].z * v[i].z + v[i].w * v[i].w;
    }
#pragma unroll
    for (int o = 32; o > 0; o >>= 1) ss += __shfl_xor(ss, o);
    const float rstd = rsqrtf(ss * (1.f / 1024.f) + 1e-6f);
#pragma unroll
    for (int i = 0; i < 4; ++i) {
      const int col = (lane + 64 * i) * 4;
      const float4 w = *(const float4*)(p.final_w + col);
      *(float4*)(x + col) = make_float4(v[i].x * rstd * w.x, v[i].y * rstd * w.y, v[i].z * rstd * w.z, v[i].w * rstd * w.w);
    }
  }
}


#define XB_TMO 128
#define XB_XCNT(j) (256 + 64 * (j))
#define XB_XSUB(j) (1280 + 64 * (j))
#define XB_XGEN(j) (2304 + 64 * (j))
#define XB_TOP 3328
#define XB_TOPGEN 3392
#define XB_SPIN_CAP (1u << 22)
DI unsigned xb_ld(unsigned* p) { return __hip_atomic_load(p, __ATOMIC_RELAXED, __HIP_MEMORY_SCOPE_AGENT); }
DI unsigned xb_add(unsigned* p, unsigned v) { return __hip_atomic_fetch_add(p, v, __ATOMIC_RELAXED, __HIP_MEMORY_SCOPE_AGENT); }
DI unsigned xb_xcc_id() { return (unsigned)__builtin_amdgcn_s_getreg((3 << 11) | 20) & 0xFu; }
#define XB_SPIN(cond, bar)                                          \
  do {                                                              \
    unsigned _sp = 0;                                               \
    while (cond) {                                                  \
      __builtin_amdgcn_s_sleep(1);                                  \
      if ((++_sp & 255u) == 0u) {                                   \
        if (xb_ld(&(bar)[XB_TMO])) break;                           \
        if (_sp > XB_SPIN_CAP) {                                    \
          atomicAdd(&(bar)[XB_TMO], 1u);                            \
          break;                                                    \
        }                                                           \
      }                                                             \
    }                                                               \
  } while (0)
struct XcdBarrier {
  unsigned* bar;
  unsigned x;
  volatile unsigned* st;
};
DI void xcd_barrier_complete(unsigned* bar, unsigned x, unsigned& nloc, unsigned& nx) {
  const unsigned G = gridDim.x;
  unsigned sum, cnt, mine, sp = 0u;
  for (;;) {
    sum = 0u; cnt = 0u; mine = 0u;
#pragma unroll
    for (unsigned j = 0; j < 16; ++j) {
      const unsigned c = xb_ld(&bar[XB_XCNT(j)]);
      sum += c;
      cnt += (c > 0u) ? 1u : 0u;
      mine = (j == x) ? c : mine;
    }
    if (sum == G) break;
    __builtin_amdgcn_s_sleep(1);
    if ((++sp & 255u) == 0u) {
      if (xb_ld(&bar[XB_TMO])) break;
      if (sp > XB_SPIN_CAP) { atomicAdd(&bar[XB_TMO], 1u); break; }
    }
  }
  nloc = mine > 0u ? mine : 1u;
  nx = cnt > 0u ? cnt : 1u;
}
DI void xcd_barrier(char* ws, volatile unsigned* st) {
  asm volatile("" : "+s"(ws));
  XcdBarrier b;
  b.bar = (unsigned*)(ws + OFF_BAR);
  b.x = xb_xcc_id();
  b.st = st;
  asm volatile("s_waitcnt vmcnt(0)" ::: "memory");
  __syncthreads();
  if (threadIdx.x == 0) {
    unsigned* bar = b.bar;
    __builtin_amdgcn_s_waitcnt(0);
    unsigned nloc = b.st[0], nx = b.st[1];
    if (nloc == 0u) {
      xcd_barrier_complete(bar, b.x, nloc, nx);
      b.st[0] = nloc;
      b.st[1] = nx;
    }
    const unsigned old = xb_add(&bar[XB_XSUB(b.x)], 1u);
    const unsigned gen = old / nloc;
    if (old + 1u == (gen + 1u) * nloc) {
      __builtin_amdgcn_fence(__ATOMIC_RELEASE, "agent");
      asm volatile("s_waitcnt vmcnt(0)" ::: "memory");
      const unsigned og = xb_add(&bar[XB_TOP], 1u);
      const unsigned tg = og / nx;
      if (og + 1u == (tg + 1u) * nx) xb_add(&bar[XB_TOPGEN], 1u);
      else XB_SPIN(xb_ld(&bar[XB_TOPGEN]) == tg, bar);
      __builtin_amdgcn_fence(__ATOMIC_ACQUIRE, "agent");
      xb_add(&bar[XB_XGEN(b.x)], 1u);
      asm volatile("s_waitcnt vmcnt(0)" ::: "memory");
    } else {
      XB_SPIN(xb_ld(&bar[XB_XGEN(b.x)]) == gen, bar);
      __builtin_amdgcn_fence(__ATOMIC_ACQUIRE, "agent");
      asm volatile("s_waitcnt vmcnt(0)" ::: "memory");
    }
  }
  __syncthreads();
}

__global__ void __launch_bounds__(512) mega(Params p) {
  __shared__ __attribute__((aligned(16))) char smem[SMEM_BYTES];
  __shared__ __attribute__((aligned(16))) unsigned xb_words[4];
  __shared__ int s_item;
  cg::grid_group grid = cg::this_grid();
  if (threadIdx.x == 0) { xb_words[0] = 0u; xb_words[1] = 0u; xb_words[2] = 0u; xb_words[3] = 0u; }
  __syncthreads();
  if (threadIdx.x == 0) (void)xb_add(&((unsigned*)(p.ws + OFF_BAR))[XB_XCNT(xb_xcc_id())], 1u);
  phase0(p, smem);
  grid.sync();
#pragma unroll 1
  for (int layer = 0; layer < DEPTH; ++layer) {
#pragma unroll 1
    for (int grp = 0; grp < 2; ++grp) {
      int ly = layer, gp = grp;
      asm volatile("" : "+s"(ly), "+s"(gp));
      p1a(p, ly, gp, smem);
      xcd_barrier(p.ws, xb_words);
      asm volatile("" : "+s"(ly), "+s"(gp));
      p1b(p, ly, gp, smem);
      xcd_barrier(p.ws, xb_words);
      asm volatile("" : "+s"(ly), "+s"(gp));
      p2(p, ly, gp, smem, &s_item);
      xcd_barrier(p.ws, xb_words);
      asm volatile("" : "+s"(ly), "+s"(gp));
      p3a(p, ly, gp, smem);
      xcd_barrier(p.ws, xb_words);
      asm volatile("" : "+s"(ly), "+s"(gp));
      p3b(p, ly, gp, smem);
      xcd_barrier(p.ws, xb_words);
    }
  }
  final_norm(p);
}

extern "C" void kernel_launch(void* const* d_in, const int* in_sizes, int n_in, void* d_out, int out_size, void* d_ws,
                              size_t ws_size, hipStream_t stream) {
  static int grid_blocks = 0;
  if (!grid_blocks) {
    int dev = 0, cus = 0, per_cu = 0;
    hipGetDevice(&dev);
    hipDeviceGetAttribute(&cus, hipDeviceAttributeMultiprocessorCount, dev);
    hipOccupancyMaxActiveBlocksPerMultiprocessor(&per_cu, mega, 512, 0);
    if (per_cu < 1) per_cu = 1;
    if (per_cu > 1) per_cu = 1;
    grid_blocks = cus * per_cu;
  }
  Params p{};
  const float** pp = (const float**)&p;
  for (int i = 0; i < 27; ++i) pp[i] = (const float*)d_in[i];
  p.out = (float*)d_out;
  p.ws = (char*)d_ws;
  if (ws_size < WS_NEEDED) fprintf(stderr, "workspace too small: %zu < %zu\n", ws_size, (size_t)WS_NEEDED);
  hipMemsetAsync(d_ws, 0, ZERO_BYTES, stream);
  void* args[] = {&p};
  hipError_t e = hipLaunchCooperativeKernel((void*)mega, dim3(grid_blocks), dim3(512), args, 0, stream);
  if (e != hipSuccess) fprintf(stderr, "cooperative launch failed: %s (grid %d)\n", hipGetErrorString(e), grid_blocks);
}
```

```cpp
#include <hip/hip_runtime.h>
#include <hip/hip_cooperative_groups.h>
#include <cstdio>
namespace cg = cooperative_groups;

#define DI __device__ __forceinline__
typedef unsigned short bf16;
typedef __attribute__((ext_vector_type(8))) short bf16x8;
typedef __attribute__((ext_vector_type(4))) short bf16x4;
typedef __attribute__((ext_vector_type(16))) float f32x16;
typedef __attribute__((ext_vector_type(4))) unsigned u32x4;
typedef __attribute__((ext_vector_type(4))) float f32x4v;
#define MFMA(a, b, c) __builtin_amdgcn_mfma_f32_32x32x16_bf16((a), (b), (c), 0, 0, 0)

constexpr int DM = 1024;
constexpr int DEPTH = 4;
constexpr int T_CTX = 8192;
constexpr int T_ALL = 40960;
constexpr int TG = 24576;
constexpr int IN_DIM = 5376;
constexpr float LOG2E = 1.4426950408889634f;

constexpr size_t OFF_MODS = 0;
constexpr size_t OFF_FSUM = 458752;
constexpr size_t OFF_CTR = 491520;
constexpr size_t OFF_BAR = 495616;
constexpr size_t ZERO_BYTES = 524288;
constexpr size_t OFF_ROPE = ZERO_BYTES;
constexpr size_t OFF_W = OFF_ROPE + 1048576;
constexpr size_t W_IN = 0, W_MG = 5505024, W_A = 8650752, W_B = 9175040, W_C = 9699328, W_O = 10223616, W_LAYER = 11272192;
constexpr size_t OFF_GL = OFF_W + W_LAYER * 2 * 4;
constexpr size_t OFF_GC = OFF_GL + 33554432;
constexpr size_t OFF_H = OFF_GC + 2097152;
constexpr size_t OFF_HYT = OFF_H + (size_t)TG * 2048;
constexpr size_t OFF_AQ = OFF_HYT + (size_t)TG * 4096;
constexpr size_t OFF_AK = OFF_AQ + (size_t)TG * 1024;
constexpr size_t OFF_AV = OFF_AK + (size_t)TG * 256;
constexpr size_t OFF_AG = OFF_AV + (size_t)TG * 256;
constexpr size_t OFF_RQ = OFF_AG + (size_t)TG * 1024;
constexpr size_t OFF_RK = OFF_RQ + (size_t)TG * 1024;
constexpr size_t OFF_RV = OFF_RK + (size_t)TG * 1024;
constexpr size_t OFF_RG = OFF_RV + (size_t)TG * 1024;
constexpr size_t OFF_YA = OFF_RG + (size_t)TG * 1024;
constexpr size_t OFF_OFB = OFF_YA + (size_t)TG * 1024;
constexpr size_t WS_NEEDED = OFF_OFB + (size_t)TG * 1024;
constexpr size_t OFF_MERGED = OFF_RQ;

constexpr size_t OUT_CK = 41943040, OUT_CV = 46137344, OUT_ST = 50331648;

constexpr int SMEM_BYTES = 135168;

struct Params {
  const float *x_prompt, *x_sample, *c, *cache_k, *cache_v, *state_ret, *c_ctx, *norm_w, *w_mod, *b_mod, *w_in, *hy_conv,
      *hy_w1, *hy_b1, *hy_freq, *hy_w2, *hy_skip, *attn_sink, *ret_theta, *ret_gn, *w_a, *w_b, *w_c, *w_merge, *b_merge,
      *w_out, *final_w;
  float* out;
  char* ws;
};

DI bf16 f2bf(float x) {
  __bf16 b = (__bf16)x;
  return __builtin_bit_cast(unsigned short, b);
}
DI float bf2f(bf16 u) { return __uint_as_float(((unsigned)u) << 16); }
DI int crow(int reg, int h) { return (reg & 3) + 8 * (reg >> 2) + 4 * h; }
DI float siluf(float x) { return x / (1.f + __expf(-x)); }
DI float sigmf(float x) { return 1.f / (1.f + __expf(-x)); }
DI bf16x8 pack8(const f32x16& x, int s) {
  bf16x8 r;
#pragma unroll
  for (int j = 0; j < 8; ++j) r[j] = (short)f2bf(x[8 * s + j]);
  return r;
}
DI f32x16 zero16() {
  f32x16 z;
#pragma unroll
  for (int i = 0; i < 16; ++i) z[i] = 0.f;
  return z;
}
DI const float* launder(const float* q) {
  asm volatile("" : "+s"(q));
  return q;
}
DI int otid() {
  int t = threadIdx.x;
  asm volatile("" : "+v"(t));
  return t;
}
DI int cond_of(int tg) { return tg < T_CTX ? 0 : 1 + ((tg - T_CTX) >> 12); }

DI void lds_barrier() { asm volatile("s_waitcnt lgkmcnt(0)\n\ts_barrier" ::: "memory"); }

struct GemmSrc {
  const bf16* A;
  const bf16* B;
  int lda, ldb, atr;
};
DI GemmSrc mksrc(const bf16* A, int lda, const bf16* B, int ldb, int atr) {
  GemmSrc g;
  g.A = A; g.B = B; g.lda = lda; g.ldb = ldb; g.atr = atr;
  return g;
}
template <int NI>
DI void gemm_issue(const GemmSrc& g, int kt, int tid, u32x4 (&ra)[4], u32x4 (&rb)[NI]) {
  const int lrow = tid >> 3, lkc = (tid & 7) * 8;
  const bf16* ab = g.atr ? g.A + (size_t)(((tid >> 6) * 8 + ((tid >> 3) & 7)) + kt * 64) * g.lda + (tid & 7) * 8
                         : g.A + (size_t)lrow * g.lda + lkc + kt * 64;
  const size_t astep = g.atr ? (size_t)64 : (size_t)64 * g.lda;
#pragma unroll
  for (int i = 0; i < 4; ++i) ra[i] = *(const u32x4*)(ab + astep * i);
  const bf16* bb = g.B + (size_t)lrow * g.ldb + lkc + kt * 64;
#pragma unroll
  for (int i = 0; i < NI; ++i) rb[i] = *(const u32x4*)(bb + (size_t)(64 * i) * g.ldb);
}
template <int NI, bool ATR>
DI void gemm_stage(bf16* As, bf16* Bs, int tid, const u32x4 (&ra)[4], const u32x4 (&rb)[NI]) {
  constexpr int PITCH = 72;
  const int lrow = tid >> 3, lkc = (tid & 7) * 8;
#pragma unroll
  for (int i = 0; i < 4; ++i) {
    if (ATR) {
      const int kk = (tid >> 6) * 8 + ((tid >> 3) & 7), tc = (tid & 7) + 8 * i;
      bf16* d = As + (tc * 8) * PITCH + (kk ^ ((tid & 7) << 3));
      const bf16x8 v = __builtin_bit_cast(bf16x8, ra[i]);
#pragma unroll
      for (int e = 0; e < 8; ++e) d[e * PITCH] = (bf16)v[e];
    } else {
      *(u32x4*)(As + (lrow + 64 * i) * PITCH + lkc) = ra[i];
    }
  }
#pragma unroll
  for (int i = 0; i < NI; ++i) *(u32x4*)(Bs + (lrow + 64 * i) * PITCH + lkc) = rb[i];
}

template <int NI, bool ATR>
DI void gemm_stage_part(bf16* As, bf16* Bs, int tid, const u32x4 (&ra)[4], const u32x4 (&rb)[NI], int part) {
  constexpr int PITCH = 72;
  const int lrow = tid >> 3, lkc = (tid & 7) * 8;
#pragma unroll
  for (int i = 0; i < 4; ++i) {
    if (i != part) continue;
    if (ATR) {
      const int kk = (tid >> 6) * 8 + ((tid >> 3) & 7), tc = (tid & 7) + 8 * i;
      bf16* d = As + (tc * 8) * PITCH + (kk ^ ((tid & 7) << 3));
      const bf16x8 v = __builtin_bit_cast(bf16x8, ra[i]);
#pragma unroll
      for (int e = 0; e < 8; ++e) d[e * PITCH] = (bf16)v[e];
    } else {
      *(u32x4*)(As + (lrow + 64 * i) * PITCH + lkc) = ra[i];
    }
  }
#pragma unroll
  for (int i = 0; i < NI; ++i)
    if (2 * i == part) *(u32x4*)(Bs + (lrow + 64 * i) * PITCH + lkc) = rb[i];
}

template <int NI, bool ATR>
DI void gemm_main(const GemmSrc& cur, int K, f32x16 (&acc)[2][NI], char* smem, u32x4 (&ra)[2][4], u32x4 (&rb)[2][NI],
                  bool preloaded, const GemmSrc& nxt, bool has_next) {
  constexpr int BN = 64 * NI;
  constexpr int PITCH = 72;
  bf16* As = (bf16*)smem;
  bf16* Bs = As + 2 * 256 * PITCH;
  const int tid = otid(), lane = tid & 63, wave = tid >> 6;
  const int wm = wave >> 1, wn = wave & 1, r = lane & 31, h = lane >> 5;
  const int nk = K / 64;
  if (!preloaded) {
    gemm_issue<NI>(cur, 0, tid, ra[0], rb[0]);
    gemm_issue<NI>(cur, 1, tid, ra[1], rb[1]);
  }
  lds_barrier();
  gemm_stage<NI, ATR>(As, Bs, tid, ra[0], rb[0]);
  lds_barrier();
#pragma unroll 1
  for (int kt = 0; kt < nk; kt += 2) {
#pragma unroll
    for (int u = 0; u < 2; ++u) {
      const int k = kt + u;
      {
        const bool inr = k + 2 < nk;
        GemmSrc g = (inr || !has_next) ? cur : nxt;
        const int kk = inr ? k + 2 : (has_next ? k + 2 - nk : nk - 1);
        gemm_issue<NI>(g, kk, tid, ra[u], rb[u]);
      }
      const bf16* Ab = As + u * 256 * PITCH + (wm * 64 + r) * PITCH + h * 8;
      const bf16* Bb = Bs + u * BN * PITCH + (wn * 32 * NI + r) * PITCH + h * 8;
#pragma unroll
      for (int ks = 0; ks < 4; ++ks) {
        bf16x8 a[2], b[NI];
#pragma unroll
        for (int mi = 0; mi < 2; ++mi)
          a[mi] = ATR ? *(const bf16x8*)(Ab - h * 8 + mi * 32 * PITCH + ((ks * 16 + h * 8) ^ (((mi * 4 + (r >> 3)) & 7) << 3)))
                      : *(const bf16x8*)(Ab + mi * 32 * PITCH + ks * 16);
#pragma unroll
        for (int ni = 0; ni < NI; ++ni) b[ni] = *(const bf16x8*)(Bb + ni * 32 * PITCH + ks * 16);
#pragma unroll
        for (int mi = 0; mi < 2; ++mi)
#pragma unroll
          for (int ni = 0; ni < NI; ++ni) acc[mi][ni] = MFMA(a[mi], b[ni], acc[mi][ni]);
        gemm_stage_part<NI, ATR>(As + (u ^ 1) * 256 * PITCH, Bs + (u ^ 1) * BN * PITCH, tid, ra[u ^ 1], rb[u ^ 1], ks);
      }
      lds_barrier();
    }
  }
}

DI void p0_mod_item(const Params& p, int item, char* smem) {
  const int tid = otid();
  const int l = item / 48, rem = item % 48, nch = rem / 8, ks = rem % 8;
  float* sc = (float*)smem;
  __syncthreads();
  for (int idx = tid; idx < 9 * 128; idx += 512) {
    const int cnd = idx >> 7, k = ks * 128 + (idx & 127);
    const float *qcc = launder(p.c_ctx), *qc = launder(p.c);
    const float v = cnd == 0 ? qcc[k] : qc[(cnd - 1) * 1024 + k];
    sc[idx] = v / (1.f + expf(-v));
  }
  __syncthreads();
  const int n = nch * 512 + tid;
  float acc[9];
#pragma unroll
  for (int i = 0; i < 9; ++i) acc[i] = 0.f;
  const float* w = p.w_mod + ((size_t)l * 1024 + ks * 128) * 3072 + n;
#pragma unroll 16
  for (int kk = 0; kk < 128; ++kk) {
    const float wv = w[(size_t)kk * 3072];
#pragma unroll
    for (int i = 0; i < 9; ++i) acc[i] += sc[i * 128 + kk] * wv;
  }
  float* mods = (float*)(p.ws + OFF_MODS);
  const float bias = ks == 0 ? p.b_mod[l * 3072 + n] : 0.f;
#pragma unroll
  for (int i = 0; i < 9; ++i) atomicAdd(&mods[(l * 9 + i) * 3072 + n], acc[i] + bias);
}

DI void transpose_tile(const float* __restrict__ src, int ldn, bf16* __restrict__ dst, int ldk, int k0, int n0, char* smem) {
  float* T = (float*)smem;
  const int tid = otid();
  __syncthreads();
  {
    const int k = tid >> 3, nc = (tid & 7) * 8;
    const float* s = src + (size_t)(k0 + k) * ldn + n0 + nc;
    const float4 a = *(const float4*)s, b = *(const float4*)(s + 4);
    float* t = T + k * 65 + nc;
    t[0] = a.x; t[1] = a.y; t[2] = a.z; t[3] = a.w; t[4] = b.x; t[5] = b.y; t[6] = b.z; t[7] = b.w;
  }
  __syncthreads();
  {
    const int n = tid >> 3, kc = (tid & 7) * 8;
    bf16x8 v;
#pragma unroll
    for (int j = 0; j < 8; ++j) v[j] = (short)f2bf(T[(kc + j) * 65 + n]);
    *(bf16x8*)(dst + (size_t)(n0 + n) * ldk + k0 + kc) = v;
  }
}

DI void p0_transpose_item(const Params& p, int item, char* smem) {
  const int l = item / 2752;
  int rem = item % 2752;
  bf16* wl = (bf16*)(p.ws + OFF_W) + (size_t)l * W_LAYER;
  if (rem < 1344) {
    const int kt = rem / 84, nt = rem % 84;
    transpose_tile(p.w_in + (size_t)l * 1024 * IN_DIM, IN_DIM, wl + W_IN, 1024, kt * 64, nt * 64, smem);
    return;
  }
  rem -= 1344;
  if (rem < 768) {
    const int kt = rem / 48, nt = rem % 48;
    transpose_tile(p.w_merge + (size_t)l * 1024 * 3072, 3072, wl + W_MG, 1024, kt * 64, nt * 64, smem);
    return;
  }
  rem -= 768;
  if (rem < 384) {
    const int br = rem / 128, r2 = rem % 128, kt = r2 / 16, nt = r2 % 16;
    const float *qa = launder(p.w_a), *qb = launder(p.w_b), *qc = launder(p.w_c);
    const float* src = (br == 0 ? qa : br == 1 ? qb : qc) + (size_t)l * 512 * 1024;
    transpose_tile(src, 1024, wl + (br == 0 ? W_A : br == 1 ? W_B : W_C), 512, kt * 64, nt * 64, smem);
    return;
  }
  rem -= 384;
  {
    const int kt = rem / 16, nt = rem % 16;
    transpose_tile(p.w_out + (size_t)l * 1024 * 1024, 1024, wl + W_O, 1024, kt * 64, nt * 64, smem);
  }
}

DI void p0_rope_item(const Params& p, int item) {
  const int idx = item * 512 + otid();
  const int t = idx >> 5, f = idx & 31;
  const float inv = powf(10000.f, -(float)(f & 15) / 16.f);
  const float ang = (float)(f < 16 ? (t >> 6) : (t & 63)) * inv;
  float2 cs;
  cs.x = cosf(ang);
  cs.y = sinf(ang);
  ((float2*)(p.ws + OFF_ROPE))[idx] = cs;
}

DI void phase0(const Params& p, char* smem) {
  const int n_mod = 192, n_tr = 11008, n_rope = 256;
  for (int it = blockIdx.x; it < n_mod + n_tr + n_rope; it += gridDim.x) {
    if (it < n_mod) p0_mod_item(p, it, smem);
    else if (it < n_mod + n_tr) p0_transpose_item(p, it - n_mod, smem);
    else p0_rope_item(p, it - n_mod - n_tr);
  }
}

DI void filter_item(const Params& p, int layer, int item, char* smem) {
  const int tid = otid();
  int var, pc, cc, L;
  if (item < 512) { var = 0; pc = item >> 3; cc = item & 7; L = 4096; }
  else { var = 1; pc = (item - 512) >> 3; cc = (item - 512) & 7; L = 256; }
  float* z = (float*)smem;
  float* hid = z + 64 * 17;
  float* w2s = hid + 64 * 65;
  __syncthreads();
  {
    const int pos = tid >> 3, band = tid & 7;
    const int pa = pc * 64 + pos;
    const float w = 6.283185307179586f * (float)pa / (float)L;
    const float f = 1e-4f + (float)band * ((7.f - 1e-4f) / 7.f);
    z[pos * 17 + 1 + band] = cosf(f * w);
    z[pos * 17 + 9 + band] = -sinf(f * w);
    if (band == 0) z[pos * 17] = (float)pa / (float)(L - 1);
  }
  __syncthreads();
  {
    const int pos = tid >> 3, j0 = (tid & 7) * 8;
    const float* w1 = p.hy_w1 + layer * 17 * 64;
#pragma unroll
    for (int jj = 0; jj < 8; ++jj) {
      const int j = j0 + jj;
      float pre = p.hy_b1[layer * 64 + j];
      for (int f = 0; f < 17; ++f) pre += z[pos * 17 + f] * w1[f * 64 + j];
      hid[pos * 65 + j] = sinf(p.hy_freq[layer * 64 + j] * pre);
    }
    const float* w2 = p.hy_w2 + (size_t)layer * 64 * 2048 + cc * 256;
    for (int idx = tid; idx < 64 * 256; idx += 512) w2s[idx] = w2[(idx >> 8) * 2048 + (idx & 255)];
  }
  __syncthreads();
  {
    const int lane = tid & 63, wave = tid >> 6, r = lane & 31, hh = lane >> 5;
    f32x16 acc[2];
    acc[0] = zero16();
    acc[1] = zero16();
#pragma unroll 4
    for (int ks = 0; ks < 32; ++ks) {
      const float bv = w2s[(2 * ks + hh) * 256 + wave * 32 + r];
#pragma unroll
      for (int mi = 0; mi < 2; ++mi) {
        const float av = hid[(mi * 32 + r) * 65 + 2 * ks + hh];
        acc[mi] = __builtin_amdgcn_mfma_f32_32x32x2f32(av, bv, acc[mi], 0, 0, 0);
      }
    }
    const int n = cc * 256 + wave * 32 + r;
    const int o = n >> 10, dir = (n >> 9) & 1, c = n & 511;
    const float min_d = -3.0701134573253945f, max_d = -15.350567286626973f;
    const float ad = fabsf(min_d + (float)c * ((max_d - min_d) / 511.f));
    float* g = (float*)(p.ws + (var == 0 ? OFF_GL : OFF_GC)) + ((size_t)(o * 512 + c)) * (2 * L);
    float asum = 0.f;
#pragma unroll
    for (int mi = 0; mi < 2; ++mi)
#pragma unroll
      for (int i = 0; i < 16; ++i) {
        const int pa = pc * 64 + mi * 32 + crow(i, hh);
        const float t = (float)pa / (float)(L - 1);
        const float v = acc[mi][i] * expf(-t * ad);
        asum += fabsf(v);
        int y;
        if (dir == 0) y = L - pa;
        else y = (pa == 0) ? 0 : L + pa;
        g[y] = v;
      }
    atomicAdd((float*)(p.ws + OFF_FSUM) + ((layer * 2 + var) * 2 + o) * 512 + c, asum);
  }
}

DI void p1a(const Params& p, int layer, int grp, char* smem) {
  const int g0 = grp ? TG : 0, tgn = grp ? 16384 : TG;
  const int nfilt = grp ? 0 : 544;
  const int nrow_items = tgn / 8;
  const int tid_ = otid();
  const int lane = tid_ & 63, wave = tid_ >> 6;
  bf16* H = (bf16*)(p.ws + OFF_H);
  const float* mods = (const float*)(p.ws + OFF_MODS);
  for (int it = blockIdx.x; it < nfilt + nrow_items; it += gridDim.x) {
    if (it < nfilt) { filter_item(p, layer, it, smem); continue; }
    const int tl = (it - nfilt) * 8 + wave, tg = g0 + tl;
    const float *qxp = launder(p.x_prompt), *qxs = launder(p.x_sample), *qo = launder(p.out);
    const float* x = layer == 0 ? (tg < T_CTX ? qxp + (size_t)tg * DM : qxs + (size_t)(tg - T_CTX) * DM) : qo + (size_t)tg * DM;
    float4 v[4];
    float ss = 0.f;
#pragma unroll
    for (int i = 0; i < 4; ++i) {
      v[i] = *(const float4*)(x + (lane + 64 * i) * 4);
      ss += v[i].x * v[i].x + v[i].y * v[i].y + v[i].z * v[i].z + v[i].w * v[i].w;
    }
#pragma unroll
    for (int o = 32; o > 0; o >>= 1) ss += __shfl_xor(ss, o);
    const float rstd = rsqrtf(ss * (1.f / 1024.f) + 1e-6f);
    const float* md = mods + (layer * 9 + cond_of(tg)) * 3072;
    const float* nw = p.norm_w + layer * 1024;
#pragma unroll
    for (int i = 0; i < 4; ++i) {
      const int col = (lane + 64 * i) * 4;
      const float4 sh = *(const float4*)(md + col), sc = *(const float4*)(md + 1024 + col), w = *(const float4*)(nw + col);
      bf16x4 o;
      o[0] = (short)f2bf(v[i].x * rstd * w.x * (1.f + sc.x) + sh.x);
      o[1] = (short)f2bf(v[i].y * rstd * w.y * (1.f + sc.y) + sh.y);
      o[2] = (short)f2bf(v[i].z * rstd * w.z * (1.f + sc.z) + sh.z);
      o[3] = (short)f2bf(v[i].w * rstd * w.w * (1.f + sc.w) + sh.w);
      *(bf16x4*)(H + (size_t)tl * 1024 + col) = o;
    }
  }
}

DI void p1b(const Params& p, int layer, int grp, char* smem) {
  const int g0 = grp ? TG : 0, tgn = grp ? 16384 : TG;
  const int mtiles = tgn / 256, ntot = mtiles * 42;
  const int tid = otid(), lane = tid & 63, wave = tid >> 6;
  const int wm = wave >> 1, wn = wave & 1, r = lane & 31, h = lane >> 5;
  const bf16* H = (const bf16*)(p.ws + OFF_H);
  const bf16* WinT = (const bf16*)(p.ws + OFF_W) + (size_t)layer * W_LAYER + W_IN;
  float* S = (float*)smem;
  u32x4 ra[2][4], rb[2][2];
  bool pre = false;
  for (int id = blockIdx.x; id < ntot; id += gridDim.x) {
    const int band = id / (32 * 42), rem = id % (32 * 42);
    const int mt = band * 32 + (rem & 31), nt = rem >> 5;
    const int idn = id + gridDim.x;
    const bool hn = idn < ntot;
    const int bandn = idn / (32 * 42), remn = idn % (32 * 42);
    const int mtn = bandn * 32 + (remn & 31), ntn = remn >> 5;
    f32x16 acc[2][2];
#pragma unroll
    for (int a = 0; a < 2; ++a)
#pragma unroll
      for (int b = 0; b < 2; ++b) acc[a][b] = zero16();
    gemm_main<2, false>(mksrc(H + (size_t)mt * 256 * 1024, 1024, WinT + (size_t)nt * 128 * 1024, 1024, 0), 1024, acc, smem, ra, rb, pre,
                        mksrc(H + (size_t)mtn * 256 * 1024, 1024, WinT + (size_t)ntn * 128 * 1024, 1024, 0), hn);
    pre = true;
    const int m0 = mt * 256, tg0 = g0 + m0;
    const bool lat = tg0 >= T_CTX;
    if (nt < 16) {
#pragma unroll
      for (int mi = 0; mi < 2; ++mi)
#pragma unroll
        for (int ni = 0; ni < 2; ++ni)
#pragma unroll
          for (int g4 = 0; g4 < 4; ++g4) {
            f32x4v v;
#pragma unroll
            for (int j = 0; j < 4; ++j) v[j] = acc[mi][ni][4 * g4 + j];
            *(f32x4v*)(S + (wn * 64 + ni * 32 + r) * 260 + wm * 64 + mi * 32 + 8 * g4 + 4 * h) = v;
          }
      __syncthreads();
      const int part = nt >> 2;
#pragma unroll 2
      for (int it = 0; it < 8; ++it) {
        const int pid = tid + 512 * it, cl = pid >> 5, q = pid & 31;
        const f32x4v a = *(const f32x4v*)(S + cl * 260 + q * 8), b = *(const f32x4v*)(S + cl * 260 + q * 8 + 4);
        bf16x8 v;
#pragma unroll
        for (int j = 0; j < 4; ++j) {
          v[j] = (short)f2bf(a[j]);
          v[4 + j] = (short)f2bf(b[j]);
        }
        *(bf16x8*)((bf16*)(p.ws + OFF_HYT) + ((size_t)(part * 512 + (nt & 3) * 128 + cl)) * TG + m0 + q * 8) = v;
      }
    } else {
#pragma unroll
      for (int mi = 0; mi < 2; ++mi)
#pragma unroll
        for (int ni = 0; ni < 2; ++ni)
#pragma unroll
          for (int i = 0; i < 16; ++i) S[(wm * 64 + mi * 32 + crow(i, h)) * 132 + wn * 64 + ni * 32 + r] = acc[mi][ni][i];
      __syncthreads();
      size_t off; int pitch, coloff; bool rope = false; int cache = 0;
      if (nt < 20) { off = OFF_AQ; pitch = 512; coloff = (nt - 16) * 128; rope = lat; }
      else if (nt == 20) { off = OFF_AK; pitch = 128; coloff = 0; rope = lat; cache = lat ? 0 : 1; }
      else if (nt == 21) { off = OFF_AV; pitch = 128; coloff = 0; cache = lat ? 0 : 2; }
      else if (nt < 26) { off = OFF_AG; pitch = 512; coloff = (nt - 22) * 128; }
      else if (nt < 30) { off = OFF_RQ; pitch = 512; coloff = (nt - 26) * 128; rope = lat; }
      else if (nt < 34) { off = OFF_RK; pitch = 512; coloff = (nt - 30) * 128; rope = lat; }
      else if (nt < 38) { off = OFF_RV; pitch = 512; coloff = (nt - 34) * 128; }
      else { off = OFF_RG; pitch = 512; coloff = (nt - 38) * 128; }
      bf16* dst = (bf16*)(p.ws + off);
      const float2* rt = (const float2*)(p.ws + OFF_ROPE);
#pragma unroll 2
      for (int it = 0; it < 8; ++it) {
        const int cid = tid + 512 * it, row = cid >> 4, cc = cid & 15;
        const float* sp = S + row * 132 + cc * 8;
        float v[8];
#pragma unroll
        for (int j = 0; j < 8; ++j) v[j] = sp[j];
        if (cache) {
          float* co = p.out + (cache == 1 ? OUT_CK : OUT_CV) + ((size_t)((tg0 >> 8) * 4 + layer) * 256 + row) * 128 + cc * 8;
          *(float4*)co = make_float4(v[0], v[1], v[2], v[3]);
          *(float4*)(co + 4) = make_float4(v[4], v[5], v[6], v[7]);
        }
        if (rope) {
          const int hd0 = (cc * 8) & 63, q = hd0 >> 4;
          const int tpos = (tg0 - T_CTX + row) & 4095;
          const float2* tb = rt + tpos * 32 + (q >> 1) * 16 + (hd0 & 15);
          const float* pp = sp + ((q & 1) ? -16 : 16);
          const float sg = (q & 1) ? 1.f : -1.f;
#pragma unroll
          for (int j = 0; j < 8; ++j) {
            const float2 cs = tb[j];
            v[j] = v[j] * cs.x + sg * pp[j] * cs.y;
          }
        }
        bf16x8 o;
#pragma unroll
        for (int j = 0; j < 8; ++j) o[j] = (short)f2bf(v[j]);
        *(bf16x8*)(dst + (size_t)(m0 + row) * pitch + coloff + cc * 8) = o;
      }
    }
  }
}

template <int NBT, int L>
DI void hyena_item(const Params& p, int layer, int var, int tlbase, int c, char* smem) {
  constexpr int NP = 32 / NBT, NT = (L / 8) / (32 * NP), UP = L + 8;
  bf16* U = (bf16*)smem;
  bf16* X1 = U + NBT * UP;
  bf16* X2 = X1 + NBT * UP;
  bf16* GR = X2 + NBT * UP;
  bf16* GR1 = GR + 2 * L + 8;
  const int tid = otid(), lane = tid & 63, wave = tid >> 6;
  const int n = lane & 31, hh = lane >> 5, b = n & (NBT - 1), pp = n / NBT;
  const bf16* hyT = (const bf16*)(p.ws + OFF_HYT);
  const float* fs = (const float*)(p.ws + OFF_FSUM) + (layer * 2 + var) * 1024;
  const float* gsrc = (const float*)(p.ws + (var == 0 ? OFF_GL : OFF_GC));
  __syncthreads();
#pragma unroll 1
  for (int part = 0; part < 3; ++part) {
    const bf16* src = hyT + ((size_t)(part * 512 + c)) * TG + tlbase;
    bf16* dstb = part == 0 ? U : part == 1 ? X1 : X2;
    const float w0 = p.hy_conv[(layer * 3 + 0) * 1536 + part * 512 + c];
    const float w1 = p.hy_conv[(layer * 3 + 1) * 1536 + part * 512 + c];
    const float w2 = p.hy_conv[(layer * 3 + 2) * 1536 + part * 512 + c];
#pragma unroll
    for (int it = 0; it < NBT * L / 8 / 512; ++it) {
      const int id = tid + 512 * it;
      const int bb = id / (L / 8), t8 = (id % (L / 8)) * 8;
      const bf16* s = src + bb * L + t8;
      const bf16x8 xv = *(const bf16x8*)s;
      float x[10];
      x[0] = t8 > 0 ? bf2f(s[-1]) : 0.f;
      x[9] = t8 + 8 < L ? bf2f(s[8]) : 0.f;
#pragma unroll
      for (int j = 0; j < 8; ++j) x[j + 1] = bf2f((bf16)xv[j]);
      bf16x8 o;
#pragma unroll
      for (int j = 0; j < 8; ++j) o[j] = (short)f2bf(w0 * x[j] + w1 * x[j + 1] + w2 * x[j + 2]);
      *(bf16x8*)(dstb + bb * UP + t8) = o;
    }
  }
  const int wbase = wave * (L / 8);
  const int dmin = -(wbase + (NT - 1) * 32 * NP + 32 * (NP - 1)), dmax = L - 16 - wbase;
  f32x16 acc[NT];
#pragma unroll 1
  for (int o = 0; o < 2; ++o) {
    {
      const float inv = 1.f / fs[o * 512 + c];
      const float* gs = gsrc + ((size_t)(o * 512 + c)) * (2 * L);
      const float skip = p.hy_skip[(layer * 2 + o) * 512 + c];
#pragma unroll 8
      for (int y = tid; y < 2 * L; y += 512) {
        float v = gs[y] * inv;
        if (y == L) v = (gs[L] + gs[0]) * inv + skip;
        if (y == 0) v = 0.f;
        const bf16 bv = f2bf(v);
        GR[y] = bv;
        if (y > 0) GR1[y - 1] = bv;
      }
      if (tid == 0) GR1[2 * L - 1] = 0;
    }
    __syncthreads();
#pragma unroll
    for (int q = 0; q < NT; ++q) acc[q] = zero16();
#pragma unroll 1
    for (int d = dmin; d <= dmax; d += 16) {
      const unsigned* gp = (const unsigned*)(((n & 1) ? GR1 - 1 : GR) + (L - n + d + 8 * hh));
      typedef __attribute__((ext_vector_type(4))) unsigned u4;
      u4 aw;
#pragma unroll
      for (int j = 0; j < 4; ++j) aw[j] = gp[j];
      const bf16x8 a = __builtin_bit_cast(bf16x8, aw);
#pragma unroll
      for (int q = 0; q < NT; ++q) {
        const int s0 = wbase + q * 32 * NP + 32 * pp + d;
        bf16x8 bb;
#pragma unroll
        for (int j = 0; j < 8; ++j) bb[j] = 0;
        if (s0 >= 0 && s0 <= L - 16) bb = *(const bf16x8*)(U + b * UP + s0 + 8 * hh);
        acc[q] = MFMA(a, bb, acc[q]);
      }
    }
    __syncthreads();
    if (o == 0) {
#pragma unroll
      for (int q = 0; q < NT; ++q)
#pragma unroll
        for (int i = 0; i < 16; ++i) {
          const int t = wbase + q * 32 * NP + 32 * pp + crow(i, hh);
          U[b * UP + t] = f2bf(bf2f(X1[b * UP + t]) * acc[q][i]);
        }
    } else {
      const bf16* gate = hyT + ((size_t)(3 * 512 + c)) * TG + tlbase;
#pragma unroll
      for (int q = 0; q < NT; ++q)
#pragma unroll
        for (int g4 = 0; g4 < 4; ++g4) {
          const int t = wbase + q * 32 * NP + 32 * pp + 8 * g4 + 4 * hh;
          const bf16x4 gv = *(const bf16x4*)(gate + b * L + t);
          bf16x4 ov;
#pragma unroll
          for (int j = 0; j < 4; ++j)
            ov[j] = (short)f2bf(bf2f(X2[b * UP + t + j]) * acc[q][4 * g4 + j] * siluf(bf2f((bf16)gv[j])));
          *(bf16x4*)(U + b * UP + t) = ov;
        }
      __syncthreads();
      bf16* yat = (bf16*)(p.ws + OFF_YA) + (size_t)c * TG + tlbase;
      for (int id = tid; id < NBT * L / 8; id += 512) {
        const int bb = id / (L / 8), t8 = (id % (L / 8)) * 8;
        *(bf16x8*)(yat + bb * L + t8) = *(const bf16x8*)(U + bb * UP + t8);
      }
    }
  }
}

DI void attn_item(const Params& p, int layer, bool lat, int tlbase, int bglob, int kvh, int qblk, char* smem) {
  bf16* Ks = (bf16*)smem;
  bf16* VT = Ks + 64 * 72;
  const int tid = otid(), lane = tid & 63, wave = tid >> 6;
  const int r = lane & 31, hh = lane >> 5;
  const int head = kvh * 4 + (wave >> 1);
  const int qi = qblk * 64 + (wave & 1) * 32 + r;
  const int tlq = tlbase + qi;
  const bf16* aq = (const bf16*)(p.ws + OFF_AQ);
  const bf16* ak = (const bf16*)(p.ws + OFF_AK);
  const bf16* av = (const bf16*)(p.ws + OFF_AV);
  bf16* ag = (bf16*)(p.ws + OFF_AG);
  bf16x8 bq[4];
#pragma unroll
  for (int ks = 0; ks < 4; ++ks) bq[ks] = *(const bf16x8*)(aq + (size_t)tlq * 512 + head * 64 + ks * 16 + hh * 8);
  const float sink2 = p.attn_sink[layer * 8 + head] * LOG2E;
  const float SC = 0.125f * LOG2E;
  float m = sink2, lsum = 0.f;
  f32x16 O[2];
  O[0] = zero16();
  O[1] = zero16();
  const int t_lo = lat ? (2 - qblk > 0 ? 2 - qblk : 0) : 0;
  const int t_hi = lat ? (65 - qblk < 4 ? 65 - qblk : 4) : 3;
  const int nw = t_hi - t_lo + 1;
  const int ntot = lat ? nw + 8 : nw;
  const int lj = tid >> 3, lkc = (tid & 7) * 8;
  u32x4 pr0, pr1, pr2, pr3;
  pr2 = u32x4{0, 0, 0, 0};
  pr3 = u32x4{0, 0, 0, 0};
  {
    const int kp = lat ? qblk * 64 - 128 + t_lo * 64 : 0;
    const size_t o = (size_t)(tlbase + kp + lj) * 128 + kvh * 64 + lkc;
    pr0 = *(const u32x4*)(ak + o);
    pr1 = *(const u32x4*)(av + o);
  }
#pragma unroll 1
  for (int n = 0; n < ntot; ++n) {
    const bool from_cache = lat && n >= nw;
    const bool window = lat && n < nw && (t_lo + n == 0 || t_lo + n == 4);
    const int kpos0 = from_cache ? (n - nw) * 64 : (lat ? qblk * 64 - 128 + (t_lo + n) * 64 : n * 64);
    lds_barrier();
    {
      bf16x8 kv, vv;
      if (from_cache) {
        const f32x4v k0 = __builtin_bit_cast(f32x4v, pr0), k1 = __builtin_bit_cast(f32x4v, pr1);
        const f32x4v v0 = __builtin_bit_cast(f32x4v, pr2), v1 = __builtin_bit_cast(f32x4v, pr3);
#pragma unroll
        for (int e = 0; e < 4; ++e) {
          kv[e] = (short)f2bf(k0[e]);
          kv[4 + e] = (short)f2bf(k1[e]);
          vv[e] = (short)f2bf(v0[e]);
          vv[4 + e] = (short)f2bf(v1[e]);
        }
      } else {
        kv = __builtin_bit_cast(bf16x8, pr0);
        vv = __builtin_bit_cast(bf16x8, pr1);
      }
      *(bf16x8*)(Ks + lj * 72 + lkc) = kv;
#pragma unroll
      for (int jj = 0; jj < 8; ++jj) VT[(lkc + jj) * 68 + lj] = (bf16)vv[jj];
    }
    lds_barrier();
    {
      const int nn = n + 1 < ntot ? n + 1 : n;
      if (lat && nn >= nw) {
        const size_t o = ((((size_t)bglob * 4 + layer) * 512 + (nn - nw) * 64 + lj) * 2 + kvh) * 64 + lkc;
        pr0 = *(const u32x4*)(p.cache_k + o);
        pr1 = *(const u32x4*)(p.cache_k + o + 4);
        pr2 = *(const u32x4*)(p.cache_v + o);
        pr3 = *(const u32x4*)(p.cache_v + o + 4);
      } else {
        const int kp = lat ? qblk * 64 - 128 + (t_lo + nn) * 64 : nn * 64;
        const size_t o = (size_t)(tlbase + kp + lj) * 128 + kvh * 64 + lkc;
        pr0 = *(const u32x4*)(ak + o);
        pr1 = *(const u32x4*)(av + o);
      }
    }
    f32x16 sc[2];
#pragma unroll
    for (int sub = 0; sub < 2; ++sub) {
      sc[sub] = zero16();
#pragma unroll
      for (int ks = 0; ks < 4; ++ks) {
        const bf16x8 a = *(const bf16x8*)(Ks + (sub * 32 + r) * 72 + ks * 16 + hh * 8);
        sc[sub] = MFMA(a, bq[ks], sc[sub]);
      }
    }
    float mx = -3.0e38f;
#pragma unroll
    for (int sub = 0; sub < 2; ++sub)
#pragma unroll
      for (int i = 0; i < 16; ++i) {
        float sv = sc[sub][i] * SC;
        if (window) {
          const int diff = qi - (kpos0 + sub * 32 + crow(i, hh));
          if (diff > 128 || diff < -128) sv = -1e30f;
        }
        sc[sub][i] = sv;
        mx = fmaxf(mx, sv);
      }
    mx = fmaxf(mx, __shfl_xor(mx, 32));
    const float mnew = fmaxf(m, mx);
    const float alpha = __builtin_amdgcn_exp2f(m - mnew);
    m = mnew;
    float ps = 0.f;
#pragma unroll
    for (int sub = 0; sub < 2; ++sub)
#pragma unroll
      for (int i = 0; i < 16; ++i) {
        sc[sub][i] = __builtin_amdgcn_exp2f(sc[sub][i] - m);
        ps += sc[sub][i];
      }
    lsum = lsum * alpha + ps;
    if (__builtin_amdgcn_ballot_w64(alpha != 1.f) != 0) {
#pragma unroll
      for (int i = 0; i < 16; ++i) {
        O[0][i] *= alpha;
        O[1][i] *= alpha;
      }
    }
#pragma unroll
    for (int sub = 0; sub < 2; ++sub)
#pragma unroll
      for (int st = 0; st < 2; ++st) {
        const bf16x8 pf = pack8(sc[sub], st);
#pragma unroll
        for (int mi = 0; mi < 2; ++mi) {
          const bf16* vp = VT + (mi * 32 + r) * 68 + sub * 32 + 16 * st + 4 * hh;
          const bf16x4 lo = *(const bf16x4*)vp, hi = *(const bf16x4*)(vp + 8);
          const bf16x8 va = __builtin_shufflevector(lo, hi, 0, 1, 2, 3, 4, 5, 6, 7);
          O[mi] = MFMA(va, pf, O[mi]);
        }
      }
  }
  const float ltot = lsum + __shfl_xor(lsum, 32) + exp2f(sink2 - m);
  const float inv = 1.f / ltot;
#pragma unroll
  for (int mi = 0; mi < 2; ++mi)
#pragma unroll
    for (int g4 = 0; g4 < 4; ++g4) {
      bf16* gp = ag + (size_t)tlq * 512 + head * 64 + mi * 32 + 8 * g4 + 4 * hh;
      const bf16x4 gv = *(const bf16x4*)gp;
      bf16x4 o;
#pragma unroll
      for (int j = 0; j < 4; ++j) o[j] = (short)f2bf(O[mi][4 * g4 + j] * inv * siluf(bf2f((bf16)gv[j])));
      *(bf16x4*)gp = o;
    }
}

DI void ret_item(const Params& p, int layer, bool lat, int NC, int tlbase, int bglob, int hd, char* smem) {
  const int tid = otid(), lane = tid & 63, wave = tid >> 6;
  const int dir = wave >> 2, w4 = wave & 3, r = lane & 31, hh = lane >> 5, dt = tid & 255;
  bf16* Ks = (bf16*)smem + dir * 31232;
  bf16* KdT = Ks + 128 * 72;
  bf16* VT = KdT + 64 * 136;
  bf16* ST = VT + 64 * 136;
  const bf16* rq = (const bf16*)(p.ws + OFF_RQ);
  const bf16* rk = (const bf16*)(p.ws + OFF_RK);
  const bf16* rv = (const bf16*)(p.ws + OFF_RV);
  bf16* rg = (bf16*)(p.ws + OFF_RG);
  bf16* ofb = (bf16*)(p.ws + OFF_OFB);
  const float theta = p.ret_theta[(layer * 2 + dir) * 8 + hd];
  const float lg2 = -log1pf(expf(-theta)) * LOG2E;
  const float cdec = exp2f(lg2 * 128.f);
  const int etile = w4 >> 1, dtile = w4 & 1;
  f32x16 Sacc;
  if (lat) {
    const float* s0 = p.state_ret + ((((size_t)bglob * 4 + layer) * 2 + dir) * 8 + hd) * 4096;
#pragma unroll
    for (int i = 0; i < 16; ++i) Sacc[i] = s0[(dtile * 32 + r) * 64 + etile * 32 + crow(i, hh)];
  } else {
    Sacc = zero16();
  }
  __syncthreads();
#pragma unroll
  for (int i = 0; i < 16; ++i) ST[(etile * 32 + crow(i, hh)) * 72 + dtile * 32 + r] = f2bf(Sacc[i]);
#pragma unroll 1
  for (int step = 0; step < NC; ++step) {
    const int tid_s = otid();
    const int r = tid_s & 31, hh = (tid_s >> 5) & 1, dt = tid_s & 255;
    const int ch = dir ? NC - 1 - step : step;
    const int tl0 = tlbase + ch * 128;
    const int iq = w4 * 32 + r, tlq = tl0 + iq;
    const bool second = step >= NC / 2;
    bf16x8 kv[4], vv[4], bq[4];
    bf16x4 pp[8], pg[8];
    const int kq = dt & 7;
#pragma unroll
    for (int i = 0; i < 4; ++i) {
      const int j = (dt + 256 * i) >> 3;
      const size_t o = (size_t)(tl0 + j) * 512 + hd * 64 + kq * 8;
      kv[i] = *(const bf16x8*)(rk + o);
      vv[i] = *(const bf16x8*)(rv + o);
    }
#pragma unroll
    for (int ks = 0; ks < 4; ++ks) bq[ks] = *(const bf16x8*)(rq + (size_t)tlq * 512 + hd * 64 + ks * 16 + hh * 8);
    if (second) {
#pragma unroll
      for (int mi = 0; mi < 2; ++mi)
#pragma unroll
        for (int g4 = 0; g4 < 4; ++g4) {
          const size_t o = (size_t)tlq * 512 + hd * 64 + mi * 32 + 8 * g4 + 4 * hh;
          pp[mi * 4 + g4] = *(const bf16x4*)(ofb + o);
          pg[mi * 4 + g4] = *(const bf16x4*)(rg + o);
        }
    } else {
#pragma unroll
      for (int i = 0; i < 8; ++i) {
        pp[i] = bf16x4{0, 0, 0, 0};
        pg[i] = bf16x4{0, 0, 0, 0};
      }
    }
    {
#pragma unroll
      for (int i = 0; i < 4; ++i) {
        const int j = (dt + 256 * i) >> 3;
        const float kd = exp2f(lg2 * (float)(dir ? j : 127 - j)) * 0.125f;
        *(bf16x8*)(Ks + j * 72 + kq * 8) = kv[i];
        const int js = j ^ (kq << 3);
#pragma unroll
        for (int jj = 0; jj < 8; ++jj) {
          KdT[(kq * 8 + jj) * 136 + js] = f2bf(bf2f((bf16)kv[i][jj]) * kd);
          VT[(kq * 8 + jj) * 136 + js] = (bf16)vv[i][jj];
        }
      }
    }
    __syncthreads();
    f32x16 O[2];
    {
      const float qd = exp2f(lg2 * (float)(dir ? 128 - iq : iq + 1));
#pragma unroll
      for (int mi = 0; mi < 2; ++mi) {
        f32x16 oc = zero16();
#pragma unroll
        for (int ks = 0; ks < 4; ++ks) {
          const bf16x8 a = *(const bf16x8*)(ST + (mi * 32 + r) * 72 + ks * 16 + hh * 8);
          oc = MFMA(a, bq[ks], oc);
        }
#pragma unroll
        for (int i = 0; i < 16; ++i) O[mi][i] = oc[i] * qd;
      }
    }
#pragma unroll 1
    for (int jt = 0; jt < 4; ++jt) {
      if (dir == 0 ? (jt <= w4) : (jt >= w4)) {
        f32x16 s = zero16();
#pragma unroll
        for (int ks = 0; ks < 4; ++ks) {
          const bf16x8 a = *(const bf16x8*)(Ks + (jt * 32 + r) * 72 + ks * 16 + hh * 8);
          s = MFMA(a, bq[ks], s);
        }
#pragma unroll
        for (int i = 0; i < 16; ++i) {
          const int j = jt * 32 + crow(i, hh);
          const int diff = dir ? j - iq : iq - j;
          s[i] = diff >= 0 ? s[i] * 0.125f * __builtin_amdgcn_exp2f(lg2 * (float)diff) : 0.f;
        }
#pragma unroll
        for (int st = 0; st < 2; ++st) {
          const bf16x8 pf = pack8(s, st);
#pragma unroll
          for (int mi = 0; mi < 2; ++mi) {
            const int key = ((mi * 32 + r) >> 3) & 7, g = jt * 4 + 2 * st;
            const bf16* vrow = VT + (mi * 32 + r) * 136 + 4 * hh;
            const bf16x4 lo = *(const bf16x4*)(vrow + ((g ^ key) << 3)), hi = *(const bf16x4*)(vrow + (((g + 1) ^ key) << 3));
            const bf16x8 va = __builtin_shufflevector(lo, hi, 0, 1, 2, 3, 4, 5, 6, 7);
            O[mi] = MFMA(va, pf, O[mi]);
          }
        }
      }
    }
#pragma unroll
    for (int i = 0; i < 16; ++i) Sacc[i] *= cdec;
#pragma unroll 2
    for (int jk = 0; jk < 8; ++jk) {
      const int ga = (jk * 2 + hh) ^ (((etile * 32 + r) >> 3) & 7), gb = (jk * 2 + hh) ^ (((dtile * 32 + r) >> 3) & 7);
      const bf16x8 a = *(const bf16x8*)(VT + (etile * 32 + r) * 136 + ga * 8);
      const bf16x8 bb = *(const bf16x8*)(KdT + (dtile * 32 + r) * 136 + gb * 8);
      Sacc = MFMA(a, bb, Sacc);
    }
    if (!second) {
#pragma unroll
      for (int mi = 0; mi < 2; ++mi)
#pragma unroll
        for (int g4 = 0; g4 < 4; ++g4) {
          bf16x4 o;
#pragma unroll
          for (int j = 0; j < 4; ++j) o[j] = (short)f2bf(O[mi][4 * g4 + j]);
          *(bf16x4*)(ofb + (size_t)tlq * 512 + hd * 64 + mi * 32 + 8 * g4 + 4 * hh) = o;
        }
    } else {
      float ss = 0.f;
#pragma unroll
      for (int mi = 0; mi < 2; ++mi)
#pragma unroll
        for (int g4 = 0; g4 < 4; ++g4) {
          const bf16x4 pv = pp[mi * 4 + g4];
#pragma unroll
          for (int j = 0; j < 4; ++j) {
            const float v = O[mi][4 * g4 + j] + bf2f((bf16)pv[j]);
            O[mi][4 * g4 + j] = v;
            ss += v * v;
          }
        }
      ss += __shfl_xor(ss, 32);
      const float rn = rsqrtf(ss * (1.f / 64.f) + 1e-6f);
#pragma unroll
      for (int mi = 0; mi < 2; ++mi)
#pragma unroll
        for (int g4 = 0; g4 < 4; ++g4) {
          const int e0 = hd * 64 + mi * 32 + 8 * g4 + 4 * hh;
          bf16* gp = rg + (size_t)tlq * 512 + e0;
          const bf16x4 gv = pg[mi * 4 + g4];
          const float4 gn = *(const float4*)(p.ret_gn + layer * 512 + e0);
          bf16x4 o;
          o[0] = (short)f2bf(O[mi][4 * g4 + 0] * rn * gn.x * siluf(bf2f((bf16)gv[0])));
          o[1] = (short)f2bf(O[mi][4 * g4 + 1] * rn * gn.y * siluf(bf2f((bf16)gv[1])));
          o[2] = (short)f2bf(O[mi][4 * g4 + 2] * rn * gn.z * siluf(bf2f((bf16)gv[2])));
          o[3] = (short)f2bf(O[mi][4 * g4 + 3] * rn * gn.w * siluf(bf2f((bf16)gv[3])));
          *(bf16x4*)gp = o;
        }
    }
    __builtin_amdgcn_fence(__ATOMIC_SEQ_CST, "workgroup");
    __syncthreads();
#pragma unroll
    for (int i = 0; i < 16; ++i) ST[(etile * 32 + crow(i, hh)) * 72 + dtile * 32 + r] = f2bf(Sacc[i]);
  }
  if (!lat) {
    float* so = p.out + OUT_ST + ((((size_t)bglob * 4 + layer) * 2 + dir) * 8 + hd) * 4096;
#pragma unroll
    for (int i = 0; i < 16; ++i) so[(dtile * 32 + r) * 64 + etile * 32 + crow(i, hh)] = Sacc[i];
  }
}

DI void p2(const Params& p, int layer, int grp, char* smem, int* s_item) {
  int* ctr = (int*)(p.ws + OFF_CTR) + layer * 2 + grp;
  const int n_rl = 32, n_hl = 512, n_al = 512;
  const int n_hc = grp ? 0 : 512, n_rc = grp ? 0 : 256, n_ac = grp ? 0 : 256;
  const int total = n_rl + n_hl + n_al + n_hc + n_rc + n_ac;
  const int latbase = grp ? 0 : T_CTX;
  const int latb0 = grp ? 4 : 0;
  for (;;) {
    __syncthreads();
    if (threadIdx.x == 0) *s_item = atomicAdd(ctr, 1);
    __syncthreads();
    int it = *s_item;
    if (it >= total) break;
    if (it < n_rl) {
      const int b = it >> 3, hd = it & 7;
      ret_item(p, layer, true, 32, latbase + b * 4096, latb0 + b, hd, smem);
      continue;
    }
    it -= n_rl;
    if (it < n_hl) { hyena_item<4, 4096>(p, layer, 0, latbase, it, smem); continue; }
    it -= n_hl;
    if (it < n_al) {
      const int b = it >> 7, kvh = (it >> 6) & 1, qb = it & 63;
      attn_item(p, layer, true, latbase + b * 4096, latb0 + b, kvh, qb, smem);
      continue;
    }
    it -= n_al;
    if (it < n_hc) { hyena_item<32, 256>(p, layer, 1, 0, it, smem); continue; }
    it -= n_hc;
    if (it < n_rc) {
      const int b = it >> 3, hd = it & 7;
      ret_item(p, layer, false, 2, b * 256, b, hd, smem);
      continue;
    }
    it -= n_rc;
    {
      const int b = it >> 3, kvh = (it >> 2) & 1, qb = it & 3;
      attn_item(p, layer, false, b * 256, b, kvh, qb, smem);
    }
  }
}

DI unsigned pk2(float a, float b) { return (unsigned)f2bf(a) | ((unsigned)f2bf(b) << 16); }
DI float pklo(unsigned u) { return __uint_as_float(u << 16); }
DI float pkhi(unsigned u) { return __uint_as_float(u & 0xffff0000u); }
DI void p3a(const Params& p, int layer, int grp, char* smem) {
  const int tgn = grp ? 16384 : TG;
  const int mtiles = tgn / 256, ntot = mtiles * 8;
  const int tid = otid(), lane = tid & 63, wave = tid >> 6;
  const int wm = wave >> 1, wn = wave & 1, r = lane & 31, h = lane >> 5;
  const bf16* H = (const bf16*)(p.ws + OFF_H);
  const bf16* wl = (const bf16*)(p.ws + OFF_W) + (size_t)layer * W_LAYER;
  bf16* MG = (bf16*)(p.ws + OFF_MERGED);
  u32x4 ra[2][4], rb[2][2];
  bool pre = false;
  const bf16* YaT = (const bf16*)(p.ws + OFF_YA);
  for (int id = blockIdx.x; id < ntot; id += gridDim.x) {
    const int m0 = ((id >> 7) * 16 + (id & 15)) * 256, n0 = ((id & 127) >> 4) * 128;
    const int idn = id + gridDim.x;
    const bool hn = idn < ntot;
    const int m0n = ((idn >> 7) * 16 + (idn & 15)) * 256, n0n = ((idn & 127) >> 4) * 128;
    unsigned mgp[2][2][8];
#pragma unroll
    for (int a = 0; a < 2; ++a)
#pragma unroll
      for (int b = 0; b < 2; ++b)
#pragma unroll
        for (int i = 0; i < 8; ++i) mgp[a][b][i] = 0u;
#pragma unroll 1
    for (int br = 0; br < 3; ++br) {
      const GemmSrc gate = mksrc(H + (size_t)m0 * 1024, 1024, wl + W_MG + (size_t)(br * 1024 + n0) * 1024, 1024, 0);
      const bf16* WB = wl + (br == 0 ? W_A : br == 1 ? W_B : W_C);
      const GemmSrc bsrc = br == 0 ? mksrc(YaT + m0, TG, WB + (size_t)n0 * 512, 512, 1)
                                   : mksrc((const bf16*)(p.ws + (br == 1 ? OFF_AG : OFF_RG)) + (size_t)m0 * 512, 512, WB + (size_t)n0 * 512, 512, 0);
      const GemmSrc after = br < 2 ? mksrc(H + (size_t)m0 * 1024, 1024, wl + W_MG + (size_t)((br + 1) * 1024 + n0) * 1024, 1024, 0)
                                   : mksrc(H + (size_t)m0n * 1024, 1024, wl + W_MG + (size_t)n0n * 1024, 1024, 0);
      unsigned sg[2][2][8];
      {
        f32x16 ag[2][2];
#pragma unroll
        for (int a = 0; a < 2; ++a)
#pragma unroll
          for (int b = 0; b < 2; ++b) ag[a][b] = zero16();
        gemm_main<2, false>(gate, 1024, ag, smem, ra, rb, false, bsrc, false);
#pragma unroll
        for (int ni = 0; ni < 2; ++ni) {
          const float bias = p.b_merge[layer * 3072 + br * 1024 + n0 + wn * 64 + ni * 32 + r];
#pragma unroll
          for (int mi = 0; mi < 2; ++mi) {
#pragma unroll
            for (int i = 0; i < 8; ++i)
              sg[mi][ni][i] = pk2(sigmf(ag[mi][ni][2 * i] + bias), sigmf(ag[mi][ni][2 * i + 1] + bias));
            __builtin_amdgcn_sched_barrier(0);
          }
        }
      }
      f32x16 ay[2][2];
#pragma unroll
      for (int a = 0; a < 2; ++a)
#pragma unroll
        for (int b = 0; b < 2; ++b) ay[a][b] = zero16();
      if (br == 0) gemm_main<2, true>(bsrc, 512, ay, smem, ra, rb, false, after, false);
      else gemm_main<2, false>(bsrc, 512, ay, smem, ra, rb, false, after, false);
#pragma unroll
      for (int mi = 0; mi < 2; ++mi)
#pragma unroll
        for (int ni = 0; ni < 2; ++ni) {
#pragma unroll
          for (int i = 0; i < 8; ++i) {
            const float lo = pklo(mgp[mi][ni][i]) + pklo(sg[mi][ni][i]) * ay[mi][ni][2 * i];
            const float hi = pkhi(mgp[mi][ni][i]) + pkhi(sg[mi][ni][i]) * ay[mi][ni][2 * i + 1];
            mgp[mi][ni][i] = pk2(lo, hi);
          }
          __builtin_amdgcn_sched_barrier(0);
        }
    }
    {
      const int t2 = otid(), l2 = t2 & 63, w2 = t2 >> 6;
      const int wm2 = w2 >> 1, wn2 = w2 & 1, r2 = l2 & 31, h2 = l2 >> 5;
#pragma unroll
      for (int mi = 0; mi < 2; ++mi)
#pragma unroll
        for (int ni = 0; ni < 2; ++ni)
#pragma unroll
          for (int i = 0; i < 8; ++i) {
            bf16* d = MG + (size_t)(m0 + wm2 * 64 + mi * 32) * 1024 + n0 + wn2 * 64 + ni * 32 + r2;
            d[(size_t)crow(2 * i, h2) * 1024] = (bf16)(mgp[mi][ni][i] & 0xffffu);
            d[(size_t)crow(2 * i + 1, h2) * 1024] = (bf16)(mgp[mi][ni][i] >> 16);
          }
    }
  }
}

DI void p3b(const Params& p, int layer, int grp, char* smem) {
  const int g0 = grp ? TG : 0, tgn = grp ? 16384 : TG;
  const int mtiles = tgn / 256, ntot = mtiles * 8;
  const int tid = otid(), lane = tid & 63, wave = tid >> 6;
  const int wm = wave >> 1, wn = wave & 1, r = lane & 31, h = lane >> 5;
  const bf16* MG = (const bf16*)(p.ws + OFF_MERGED);
  const bf16* WoT = (const bf16*)(p.ws + OFF_W) + (size_t)layer * W_LAYER + W_O;
  const float* mods = (const float*)(p.ws + OFF_MODS);
  u32x4 ra[2][4], rb[2][2];
  bool pre = false;
  for (int id = blockIdx.x; id < ntot; id += gridDim.x) {
    const int band = id >> 7, rem = id & 127;
    const int mt = band * 16 + (rem & 15), nt = rem >> 4;
    const int m0 = mt * 256, n0 = nt * 128;
    const int idn = id + gridDim.x;
    const bool hn = idn < ntot;
    const int m0n = ((idn >> 7) * 16 + (idn & 15)) * 256, n0n = ((idn & 127) >> 4) * 128;
    f32x16 acc[2][2];
#pragma unroll
    for (int a = 0; a < 2; ++a)
#pragma unroll
      for (int b = 0; b < 2; ++b) acc[a][b] = zero16();
    gemm_main<2, false>(mksrc(MG + (size_t)m0 * 1024, 1024, WoT + (size_t)n0 * 1024, 1024, 0), 1024, acc, smem, ra, rb, pre,
                        mksrc(MG + (size_t)m0n * 1024, 1024, WoT + (size_t)n0n * 1024, 1024, 0), hn);
    pre = true;
    const int tg0 = g0 + m0;
    const float* gate = mods + (layer * 9 + cond_of(tg0)) * 3072 + 2048;
    const float *qxp = launder(p.x_prompt), *qxs = launder(p.x_sample), *qo = launder(p.out);
    const float* xsb = layer == 0 ? (tg0 < T_CTX ? qxp + (size_t)tg0 * DM : qxs + (size_t)(tg0 - T_CTX) * DM) : qo + (size_t)tg0 * DM;
    float* xdb = p.out + (size_t)tg0 * DM;
#pragma unroll
    for (int ni = 0; ni < 2; ++ni) {
      const int col = n0 + wn * 64 + ni * 32 + r;
      const float gt = gate[col];
#pragma unroll
      for (int mi = 0; mi < 2; ++mi)
#pragma unroll
        for (int i = 0; i < 16; ++i) {
          const int ro = (wm * 64 + mi * 32 + crow(i, h)) * DM + col;
          xdb[ro] = xsb[ro] + gt * acc[mi][ni][i];
        }
    }
  }
}

DI void final_norm(const Params& p) {
  const int tid_ = otid();
  const int lane = tid_ & 63, wave = tid_ >> 6;
  for (int it = blockIdx.x; it < T_ALL / 8; it += gridDim.x) {
    const int tg = it * 8 + wave;
    float* x = p.out + (size_t)tg * DM;
    float4 v[4];
    float ss = 0.f;
#pragma unroll
    for (int i = 0; i < 4; ++i) {
      v[i] = *(const float4*)(x + (lane + 64 * i) * 4);
      ss += v[i].x * v[i].x + v[i].y * v[i].y + v[i].z * v[i].z + v[i].w * v[i].w;
    }
#pragma unroll
    for (int o = 32; o > 0; o >>= 1) ss += __shfl_xor(ss, o);
    const float rstd = rsqrtf(ss * (1.f / 1024.f) + 1e-6f);
#pragma unroll
    for (int i = 0; i < 4; ++i) {
      const int col = (lane + 64 * i) * 4;
      const float4 w = *(const float4*)(p.final_w + col);
      *(float4*)(x + col) = make_float4(v[i].x * rstd * w.x, v[i].y * rstd * w.y, v[i].z * rstd * w.z, v[i].w * rstd * w.w);
    }
  }
}


#define XB_TMO 128
#define XB_XCNT(j) (256 + 64 * (j))
#define XB_XSUB(j) (1280 + 64 * (j))
#define XB_XGEN(j) (2304 + 64 * (j))
#define XB_TOP 3328
#define XB_TOPGEN 3392
#define XB_SPIN_CAP (1u << 22)
DI unsigned xb_ld(unsigned* p) { return __hip_atomic_load(p, __ATOMIC_RELAXED, __HIP_MEMORY_SCOPE_AGENT); }
DI unsigned xb_add(unsigned* p, unsigned v) { return __hip_atomic_fetch_add(p, v, __ATOMIC_RELAXED, __HIP_MEMORY_SCOPE_AGENT); }
DI unsigned xb_xcc_id() { return (unsigned)__builtin_amdgcn_s_getreg((3 << 11) | 20) & 0xFu; }
#define XB_SPIN(cond, bar)                                          \
  do {                                                              \
    unsigned _sp = 0;                                               \
    while (cond) {                                                  \
      __builtin_amdgcn_s_sleep(1);                                  \
      if ((++_sp & 255u) == 0u) {                                   \
        if (xb_ld(&(bar)[XB_TMO])) break;                           \
        if (_sp > XB_SPIN_CAP) {                                    \
          atomicAdd(&(bar)[XB_TMO], 1u);                            \
          break;                                                    \
        }                                                           \
      }                                                             \
    }                                                               \
  } while (0)
struct XcdBarrier {
  unsigned* bar;
  unsigned x;
  volatile unsigned* st;
};
DI void xcd_barrier_complete(unsigned* bar, unsigned x, unsigned& nloc, unsigned& nx) {
  const unsigned G = gridDim.x;
  unsigned sum, cnt, mine, sp = 0u;
  for (;;) {
    sum = 0u; cnt = 0u; mine = 0u;
#pragma unroll
    for (unsigned j = 0; j < 16; ++j) {
      const unsigned c = xb_ld(&bar[XB_XCNT(j)]);
      sum += c;
      cnt += (c > 0u) ? 1u : 0u;
      mine = (j == x) ? c : mine;
    }
    if (sum == G) break;
    __builtin_amdgcn_s_sleep(1);
    if ((++sp & 255u) == 0u) {
      if (xb_ld(&bar[XB_TMO])) break;
      if (sp > XB_SPIN_CAP) { atomicAdd(&bar[XB_TMO], 1u); break; }
    }
  }
  nloc = mine > 0u ? mine : 1u;
  nx = cnt > 0u ? cnt : 1u;
}
DI void xcd_barrier(char* ws, volatile unsigned* st) {
  asm volatile("" : "+s"(ws));
  XcdBarrier b;
  b.bar = (unsigned*)(ws + OFF_BAR);
  b.x = xb_xcc_id();
  b.st = st;
  asm volatile("s_waitcnt vmcnt(0)" ::: "memory");
  __syncthreads();
  if (threadIdx.x == 0) {
    unsigned* bar = b.bar;
    __builtin_amdgcn_s_waitcnt(0);
    unsigned nloc = b.st[0], nx = b.st[1];
    if (nloc == 0u) {
      xcd_barrier_complete(bar, b.x, nloc, nx);
      b.st[0] = nloc;
      b.st[1] = nx;
    }
    const unsigned old = xb_add(&bar[XB_XSUB(b.x)], 1u);
    const unsigned gen = old / nloc;
    if (old + 1u == (gen + 1u) * nloc) {
      __builtin_amdgcn_fence(__ATOMIC_RELEASE, "agent");
      asm volatile("s_waitcnt vmcnt(0)" ::: "memory");
      const unsigned og = xb_add(&bar[XB_TOP], 1u);
      const unsigned tg = og / nx;
      if (og + 1u == (tg + 1u) * nx) xb_add(&bar[XB_TOPGEN], 1u);
      else XB_SPIN(xb_ld(&bar[XB_TOPGEN]) == tg, bar);
      __builtin_amdgcn_fence(__ATOMIC_ACQUIRE, "agent");
      xb_add(&bar[XB_XGEN(b.x)], 1u);
      asm volatile("s_waitcnt vmcnt(0)" ::: "memory");
    } else {
      XB_SPIN(xb_ld(&bar[XB_XGEN(b.x)]) == gen, bar);
      __builtin_amdgcn_fence(__ATOMIC_ACQUIRE, "agent");
      asm volatile("s_waitcnt vmcnt(0)" ::: "memory");
    }
  }
  __syncthreads();
}

__global__ void __launch_bounds__(512) mega(Params p) {
  __shared__ __attribute__((aligned(16))) char smem[SMEM_BYTES];
  __shared__ __attribute__((aligned(16))) unsigned xb_words[4];
  __shared__ int s_item;
  cg::grid_group grid = cg::this_grid();
  if (threadIdx.x == 0) { xb_words[0] = 0u; xb_words[1] = 0u; xb_words[2] = 0u; xb_words[3] = 0u; }
  __syncthreads();
  if (threadIdx.x == 0) (void)xb_add(&((unsigned*)(p.ws + OFF_BAR))[XB_XCNT(xb_xcc_id())], 1u);
  phase0(p, smem);
  grid.sync();
#pragma unroll 1
  for (int layer = 0; layer < DEPTH; ++layer) {
#pragma unroll 1
    for (int grp = 0; grp < 2; ++grp) {
      int ly = layer, gp = grp;
      asm volatile("" : "+s"(ly), "+s"(gp));
      p1a(p, ly, gp, smem);
      xcd_barrier(p.ws, xb_words);
      asm volatile("" : "+s"(ly), "+s"(gp));
      p1b(p, ly, gp, smem);
      xcd_barrier(p.ws, xb_words);
      asm volatile("" : "+s"(ly), "+s"(gp));
      p2(p, ly, gp, smem, &s_item);
      xcd_barrier(p.ws, xb_words);
      asm volatile("" : "+s"(ly), "+s"(gp));
      p3a(p, ly, gp, smem);
      xcd_barrier(p.ws, xb_words);
      asm volatile("" : "+s"(ly), "+s"(gp));
      p3b(p, ly, gp, smem);
      xcd_barrier(p.ws, xb_words);
    }
  }
  final_norm(p);
}

extern "C" void kernel_launch(void* const* d_in, const int* in_sizes, int n_in, void* d_out, int out_size, void* d_ws,
                              size_t ws_size, hipStream_t stream) {
  static int grid_blocks = 0;
  if (!grid_blocks) {
    int dev = 0, cus = 0, per_cu = 0;
    hipGetDevice(&dev);
    hipDeviceGetAttribute(&cus, hipDeviceAttributeMultiprocessorCount, dev);
    hipOccupancyMaxActiveBlocksPerMultiprocessor(&per_cu, mega, 512, 0);
    if (per_cu < 1) per_cu = 1;
    if (per_cu > 1) per_cu = 1;
    grid_blocks = cus * per_cu;
  }
  Params p{};
  const float** pp = (const float**)&p;
  for (int i = 0; i < 27; ++i) pp[i] = (const float*)d_in[i];
  p.out = (float*)d_out;
  p.ws = (char*)d_ws;
  if (ws_size < WS_NEEDED) fprintf(stderr, "workspace too small: %zu < %zu\n", ws_size, (size_t)WS_NEEDED);
  hipMemsetAsync(d_ws, 0, ZERO_BYTES, stream);
  void* args[] = {&p};
  hipError_t e = hipLaunchCooperativeKernel((void*)mega, dim3(grid_blocks), dim3(512), args, 0, stream);
  if (e != hipSuccess) fprintf(stderr, "cooperative launch failed: %s (grid %d)\n", hipGetErrorString(e), grid_blocks);
}
```

```cpp
#include <hip/hip_runtime.h>
#include <hip/hip_cooperative_groups.h>
#include <cstdio>
namespace cg = cooperative_groups;

#define DI __device__ __forceinline__
typedef unsigned short bf16;
typedef __attribute__((ext_vector_type(8))) short bf16x8;
typedef __attribute__((ext_vector_type(4))) short bf16x4;
typedef __attribute__((ext_vector_type(16))) float f32x16;
typedef __attribute__((ext_vector_type(4))) unsigned u32x4;
typedef __attribute__((ext_vector_type(4))) float f32x4v;
#define MFMA(a, b, c) __builtin_amdgcn_mfma_f32_32x32x16_bf16((a), (b), (c), 0, 0, 0)

constexpr int DM = 1024;
constexpr int DEPTH = 4;
constexpr int T_CTX = 8192;
constexpr int T_ALL = 40960;
constexpr int TG = 24576;
constexpr int IN_DIM = 5376;
constexpr float LOG2E = 1.4426950408889634f;

constexpr size_t OFF_MODS = 0;
constexpr size_t OFF_FSUM = 458752;
constexpr size_t OFF_CTR = 491520;
constexpr size_t OFF_BAR = 495616;
constexpr size_t ZERO_BYTES = 524288;
constexpr size_t OFF_ROPE = ZERO_BYTES;
constexpr size_t OFF_W = OFF_ROPE + 1048576;
constexpr size_t W_IN = 0, W_MG = 5505024, W_A = 8650752, W_B = 9175040, W_C = 9699328, W_O = 10223616, W_LAYER = 11272192;
constexpr size_t OFF_GL = OFF_W + W_LAYER * 2 * 4;
constexpr size_t OFF_GC = OFF_GL + 33554432;
constexpr size_t OFF_H = OFF_GC + 2097152;
constexpr size_t OFF_HYT = OFF_H + (size_t)TG * 2048;
constexpr size_t OFF_AQ = OFF_HYT + (size_t)TG * 4096;
constexpr size_t OFF_AK = OFF_AQ + (size_t)TG * 1024;
constexpr size_t OFF_AV = OFF_AK + (size_t)TG * 256;
constexpr size_t OFF_AG = OFF_AV + (size_t)TG * 256;
constexpr size_t OFF_RQ = OFF_AG + (size_t)TG * 1024;
constexpr size_t OFF_RK = OFF_RQ + (size_t)TG * 1024;
constexpr size_t OFF_RV = OFF_RK + (size_t)TG * 1024;
constexpr size_t OFF_RG = OFF_RV + (size_t)TG * 1024;
constexpr size_t OFF_YA = OFF_RG + (size_t)TG * 1024;
constexpr size_t OFF_OFB = OFF_YA + (size_t)TG * 1024;
constexpr size_t WS_NEEDED = OFF_OFB + (size_t)TG * 1024;
constexpr size_t OFF_MERGED = OFF_RQ;

constexpr size_t OUT_CK = 41943040, OUT_CV = 46137344, OUT_ST = 50331648;

constexpr int SMEM_BYTES = 135168;

struct Params {
  const float *x_prompt, *x_sample, *c, *cache_k, *cache_v, *state_ret, *c_ctx, *norm_w, *w_mod, *b_mod, *w_in, *hy_conv,
      *hy_w1, *hy_b1, *hy_freq, *hy_w2, *hy_skip, *attn_sink, *ret_theta, *ret_gn, *w_a, *w_b, *w_c, *w_merge, *b_merge,
      *w_out, *final_w;
  float* out;
  char* ws;
};

DI bf16 f2bf(float x) {
  __bf16 b = (__bf16)x;
  return __builtin_bit_cast(unsigned short, b);
}
DI float bf2f(bf16 u) { return __uint_as_float(((unsigned)u) << 16); }
DI int crow(int reg, int h) { return (reg & 3) + 8 * (reg >> 2) + 4 * h; }
DI float siluf(float x) { return x / (1.f + __expf(-x)); }
DI float sigmf(float x) { return 1.f / (1.f + __expf(-x)); }
DI bf16x8 pack8(const f32x16& x, int s) {
  bf16x8 r;
#pragma unroll
  for (int j = 0; j < 8; ++j) r[j] = (short)f2bf(x[8 * s + j]);
  return r;
}
DI f32x16 zero16() {
  f32x16 z;
#pragma unroll
  for (int i = 0; i < 16; ++i) z[i] = 0.f;
  return z;
}
DI const float* launder(const float* q) {
  asm volatile("" : "+s"(q));
  return q;
}
DI int otid() {
  int t = threadIdx.x;
  asm volatile("" : "+v"(t));
  return t;
}
DI unsigned pk2f(float a, float b) { return (unsigned)f2bf(a) | ((unsigned)f2bf(b) << 16); }
DI float bflo(unsigned u) { return __uint_as_float(u << 16); }
DI float bfhi(unsigned u) { return __uint_as_float(u & 0xffff0000u); }
DI void swap32(unsigned& x, unsigned& y) {
  const auto rr = __builtin_amdgcn_permlane32_swap(x, y, false, false);
  x = rr[0];
  y = rr[1];
}
DI int cond_of(int tg) { return tg < T_CTX ? 0 : 1 + ((tg - T_CTX) >> 12); }

DI void lds_barrier() { asm volatile("s_waitcnt lgkmcnt(0)\n\ts_barrier" ::: "memory"); }

struct GemmSrc {
  const bf16* A;
  const bf16* B;
  int lda, ldb, atr;
};
DI GemmSrc mksrc(const bf16* A, int lda, const bf16* B, int ldb, int atr) {
  GemmSrc g;
  g.A = A; g.B = B; g.lda = lda; g.ldb = ldb; g.atr = atr;
  return g;
}
template <int NI>
DI void gemm_issue(const GemmSrc& g, int kt, int tid, u32x4 (&ra)[4], u32x4 (&rb)[NI]) {
  const int lrow = tid >> 3, lkc = (tid & 7) * 8;
  const bf16* ab = g.atr ? g.A + (size_t)(((tid >> 6) * 8 + ((tid >> 3) & 7)) + kt * 64) * g.lda + (tid & 7) * 8
                         : g.A + (size_t)lrow * g.lda + lkc + kt * 64;
  const size_t astep = g.atr ? (size_t)64 : (size_t)64 * g.lda;
#pragma unroll
  for (int i = 0; i < 4; ++i) ra[i] = *(const u32x4*)(ab + astep * i);
  const bf16* bb = g.B + (size_t)lrow * g.ldb + lkc + kt * 64;
#pragma unroll
  for (int i = 0; i < NI; ++i) rb[i] = *(const u32x4*)(bb + (size_t)(64 * i) * g.ldb);
}
template <int NI, bool ATR>
DI void gemm_stage(bf16* As, bf16* Bs, int tid, const u32x4 (&ra)[4], const u32x4 (&rb)[NI]) {
  constexpr int PITCH = 72;
  const int lrow = tid >> 3, lkc = (tid & 7) * 8;
#pragma unroll
  for (int i = 0; i < 4; ++i) {
    if (ATR) {
      const int kk = (tid >> 6) * 8 + ((tid >> 3) & 7), tc = (tid & 7) + 8 * i;
      bf16* d = As + (tc * 8) * PITCH + (kk ^ ((tid & 7) << 3));
      const bf16x8 v = __builtin_bit_cast(bf16x8, ra[i]);
#pragma unroll
      for (int e = 0; e < 8; ++e) d[e * PITCH] = (bf16)v[e];
    } else {
      *(u32x4*)(As + (lrow + 64 * i) * PITCH + lkc) = ra[i];
    }
  }
#pragma unroll
  for (int i = 0; i < NI; ++i) *(u32x4*)(Bs + (lrow + 64 * i) * PITCH + lkc) = rb[i];
}

template <int NI, bool ATR>
DI void gemm_stage_part(bf16* As, bf16* Bs, int tid, const u32x4 (&ra)[4], const u32x4 (&rb)[NI], int part) {
  constexpr int PITCH = 72;
  const int lrow = tid >> 3, lkc = (tid & 7) * 8;
#pragma unroll
  for (int i = 0; i < 4; ++i) {
    if (i != part) continue;
    if (ATR) {
      const int kk = (tid >> 6) * 8 + ((tid >> 3) & 7), tc = (tid & 7) + 8 * i;
      bf16* d = As + (tc * 8) * PITCH + (kk ^ ((tid & 7) << 3));
      const bf16x8 v = __builtin_bit_cast(bf16x8, ra[i]);
#pragma unroll
      for (int e = 0; e < 8; ++e) d[e * PITCH] = (bf16)v[e];
    } else {
      *(u32x4*)(As + (lrow + 64 * i) * PITCH + lkc) = ra[i];
    }
  }
#pragma unroll
  for (int i = 0; i < NI; ++i)
    if (2 * i == part) *(u32x4*)(Bs + (lrow + 64 * i) * PITCH + lkc) = rb[i];
}

template <int NI, bool ATR>
DI void gemm_main(const GemmSrc& cur, int K, f32x16 (&acc)[2][NI], char* smem, u32x4 (&ra)[2][4], u32x4 (&rb)[2][NI],
                  bool preloaded, const GemmSrc& nxt, bool has_next) {
  constexpr int BN = 64 * NI;
  constexpr int PITCH = 72;
  bf16* As = (bf16*)smem;
  bf16* Bs = As + 2 * 256 * PITCH;
  const int tid = otid(), lane = tid & 63, wave = tid >> 6;
  const int wm = wave >> 1, wn = wave & 1, r = lane & 31, h = lane >> 5;
  const int nk = K / 64;
  if (!preloaded) {
    gemm_issue<NI>(cur, 0, tid, ra[0], rb[0]);
    gemm_issue<NI>(cur, 1, tid, ra[1], rb[1]);
  }
  lds_barrier();
  gemm_stage<NI, ATR>(As, Bs, tid, ra[0], rb[0]);
  lds_barrier();
#pragma unroll 1
  for (int kt = 0; kt < nk; kt += 2) {
#pragma unroll
    for (int u = 0; u < 2; ++u) {
      const int k = kt + u;
      {
        const bool inr = k + 2 < nk;
        GemmSrc g = (inr || !has_next) ? cur : nxt;
        const int kk = inr ? k + 2 : (has_next ? k + 2 - nk : nk - 1);
        gemm_issue<NI>(g, kk, tid, ra[u], rb[u]);
      }
      const bf16* Ab = As + u * 256 * PITCH + (wm * 64 + r) * PITCH + h * 8;
      const bf16* Bb = Bs + u * BN * PITCH + (wn * 32 * NI + r) * PITCH + h * 8;
#pragma unroll
      for (int ks = 0; ks < 4; ++ks) {
        bf16x8 a[2], b[NI];
#pragma unroll
        for (int mi = 0; mi < 2; ++mi)
          a[mi] = ATR ? *(const bf16x8*)(Ab - h * 8 + mi * 32 * PITCH + ((ks * 16 + h * 8) ^ (((mi * 4 + (r >> 3)) & 7) << 3)))
                      : *(const bf16x8*)(Ab + mi * 32 * PITCH + ks * 16);
#pragma unroll
        for (int ni = 0; ni < NI; ++ni) b[ni] = *(const bf16x8*)(Bb + ni * 32 * PITCH + ks * 16);
#pragma unroll
        for (int mi = 0; mi < 2; ++mi)
#pragma unroll
          for (int ni = 0; ni < NI; ++ni) acc[mi][ni] = MFMA(a[mi], b[ni], acc[mi][ni]);
        gemm_stage_part<NI, ATR>(As + (u ^ 1) * 256 * PITCH, Bs + (u ^ 1) * BN * PITCH, tid, ra[u ^ 1], rb[u ^ 1], ks);
      }
      lds_barrier();
    }
  }
}

DI void p0_mod_item(const Params& p, int item, char* smem) {
  const int tid = otid();
  const int l = item / 48, rem = item % 48, nch = rem / 8, ks = rem % 8;
  float* sc = (float*)smem;
  __syncthreads();
  for (int idx = tid; idx < 9 * 128; idx += 512) {
    const int cnd = idx >> 7, k = ks * 128 + (idx & 127);
    const float *qcc = launder(p.c_ctx), *qc = launder(p.c);
    const float v = cnd == 0 ? qcc[k] : qc[(cnd - 1) * 1024 + k];
    sc[idx] = v / (1.f + expf(-v));
  }
  __syncthreads();
  const int n = nch * 512 + tid;
  float acc[9];
#pragma unroll
  for (int i = 0; i < 9; ++i) acc[i] = 0.f;
  const float* w = p.w_mod + ((size_t)l * 1024 + ks * 128) * 3072 + n;
#pragma unroll 16
  for (int kk = 0; kk < 128; ++kk) {
    const float wv = w[(size_t)kk * 3072];
#pragma unroll
    for (int i = 0; i < 9; ++i) acc[i] += sc[i * 128 + kk] * wv;
  }
  float* mods = (float*)(p.ws + OFF_MODS);
  const float bias = ks == 0 ? p.b_mod[l * 3072 + n] : 0.f;
#pragma unroll
  for (int i = 0; i < 9; ++i) atomicAdd(&mods[(l * 9 + i) * 3072 + n], acc[i] + bias);
}

DI void transpose_tile(const float* __restrict__ src, int ldn, bf16* __restrict__ dst, int ldk, int k0, int n0, char* smem) {
  float* T = (float*)smem;
  const int tid = otid();
  __syncthreads();
  {
    const int k = tid >> 3, nc = (tid & 7) * 8;
    const float* s = src + (size_t)(k0 + k) * ldn + n0 + nc;
    const float4 a = *(const float4*)s, b = *(const float4*)(s + 4);
    float* t = T + k * 65 + nc;
    t[0] = a.x; t[1] = a.y; t[2] = a.z; t[3] = a.w; t[4] = b.x; t[5] = b.y; t[6] = b.z; t[7] = b.w;
  }
  __syncthreads();
  {
    const int n = tid >> 3, kc = (tid & 7) * 8;
    bf16x8 v;
#pragma unroll
    for (int j = 0; j < 8; ++j) v[j] = (short)f2bf(T[(kc + j) * 65 + n]);
    *(bf16x8*)(dst + (size_t)(n0 + n) * ldk + k0 + kc) = v;
  }
}

DI void p0_transpose_item(const Params& p, int item, char* smem) {
  const int l = item / 2752;
  int rem = item % 2752;
  bf16* wl = (bf16*)(p.ws + OFF_W) + (size_t)l * W_LAYER;
  if (rem < 1344) {
    const int kt = rem / 84, nt = rem % 84;
    transpose_tile(p.w_in + (size_t)l * 1024 * IN_DIM, IN_DIM, wl + W_IN, 1024, kt * 64, nt * 64, smem);
    return;
  }
  rem -= 1344;
  if (rem < 768) {
    const int kt = rem / 48, nt = rem % 48;
    transpose_tile(p.w_merge + (size_t)l * 1024 * 3072, 3072, wl + W_MG, 1024, kt * 64, nt * 64, smem);
    return;
  }
  rem -= 768;
  if (rem < 384) {
    const int br = rem / 128, r2 = rem % 128, kt = r2 / 16, nt = r2 % 16;
    const float *qa = launder(p.w_a), *qb = launder(p.w_b), *qc = launder(p.w_c);
    const float* src = (br == 0 ? qa : br == 1 ? qb : qc) + (size_t)l * 512 * 1024;
    transpose_tile(src, 1024, wl + (br == 0 ? W_A : br == 1 ? W_B : W_C), 512, kt * 64, nt * 64, smem);
    return;
  }
  rem -= 384;
  {
    const int kt = rem / 16, nt = rem % 16;
    transpose_tile(p.w_out + (size_t)l * 1024 * 1024, 1024, wl + W_O, 1024, kt * 64, nt * 64, smem);
  }
}

DI void p0_rope_item(const Params& p, int item) {
  const int idx = item * 512 + otid();
  const int t = idx >> 5, f = idx & 31;
  const float inv = powf(10000.f, -(float)(f & 15) / 16.f);
  const float ang = (float)(f < 16 ? (t >> 6) : (t & 63)) * inv;
  float2 cs;
  cs.x = cosf(ang);
  cs.y = sinf(ang);
  ((float2*)(p.ws + OFF_ROPE))[idx] = cs;
}

DI void phase0(const Params& p, char* smem) {
  const int n_mod = 192, n_tr = 11008, n_rope = 256;
  for (int it = blockIdx.x; it < n_mod + n_tr + n_rope; it += gridDim.x) {
    if (it < n_mod) p0_mod_item(p, it, smem);
    else if (it < n_mod + n_tr) p0_transpose_item(p, it - n_mod, smem);
    else p0_rope_item(p, it - n_mod - n_tr);
  }
}

DI void filter_item(const Params& p, int layer, int item, char* smem) {
  const int tid = otid();
  int var, pc, cc, L;
  if (item < 512) { var = 0; pc = item >> 3; cc = item & 7; L = 4096; }
  else { var = 1; pc = (item - 512) >> 3; cc = (item - 512) & 7; L = 256; }
  float* z = (float*)smem;
  float* hid = z + 64 * 17;
  float* w2s = hid + 64 * 65;
  __syncthreads();
  {
    const int pos = tid >> 3, band = tid & 7;
    const int pa = pc * 64 + pos;
    const float w = 6.283185307179586f * (float)pa / (float)L;
    const float f = 1e-4f + (float)band * ((7.f - 1e-4f) / 7.f);
    z[pos * 17 + 1 + band] = cosf(f * w);
    z[pos * 17 + 9 + band] = -sinf(f * w);
    if (band == 0) z[pos * 17] = (float)pa / (float)(L - 1);
  }
  __syncthreads();
  {
    const int pos = tid >> 3, j0 = (tid & 7) * 8;
    const float* w1 = p.hy_w1 + layer * 17 * 64;
#pragma unroll
    for (int jj = 0; jj < 8; ++jj) {
      const int j = j0 + jj;
      float pre = p.hy_b1[layer * 64 + j];
      for (int f = 0; f < 17; ++f) pre += z[pos * 17 + f] * w1[f * 64 + j];
      hid[pos * 65 + j] = sinf(p.hy_freq[layer * 64 + j] * pre);
    }
    const float* w2 = p.hy_w2 + (size_t)layer * 64 * 2048 + cc * 256;
    for (int idx = tid; idx < 64 * 256; idx += 512) w2s[idx] = w2[(idx >> 8) * 2048 + (idx & 255)];
  }
  __syncthreads();
  {
    const int lane = tid & 63, wave = tid >> 6, r = lane & 31, hh = lane >> 5;
    f32x16 acc[2];
    acc[0] = zero16();
    acc[1] = zero16();
#pragma unroll 4
    for (int ks = 0; ks < 32; ++ks) {
      const float bv = w2s[(2 * ks + hh) * 256 + wave * 32 + r];
#pragma unroll
      for (int mi = 0; mi < 2; ++mi) {
        const float av = hid[(mi * 32 + r) * 65 + 2 * ks + hh];
        acc[mi] = __builtin_amdgcn_mfma_f32_32x32x2f32(av, bv, acc[mi], 0, 0, 0);
      }
    }
    const int n = cc * 256 + wave * 32 + r;
    const int o = n >> 10, dir = (n >> 9) & 1, c = n & 511;
    const float min_d = -3.0701134573253945f, max_d = -15.350567286626973f;
    const float ad = fabsf(min_d + (float)c * ((max_d - min_d) / 511.f));
    float* g = (float*)(p.ws + (var == 0 ? OFF_GL : OFF_GC)) + ((size_t)(o * 512 + c)) * (2 * L);
    float asum = 0.f;
#pragma unroll
    for (int mi = 0; mi < 2; ++mi)
#pragma unroll
      for (int i = 0; i < 16; ++i) {
        const int pa = pc * 64 + mi * 32 + crow(i, hh);
        const float t = (float)pa / (float)(L - 1);
        const float v = acc[mi][i] * expf(-t * ad);
        asum += fabsf(v);
        int y;
        if (dir == 0) y = L - pa;
        else y = (pa == 0) ? 0 : L + pa;
        g[y] = v;
      }
    atomicAdd((float*)(p.ws + OFF_FSUM) + ((layer * 2 + var) * 2 + o) * 512 + c, asum);
  }
}

DI void p1a(const Params& p, int layer, int grp, char* smem) {
  const int g0 = grp ? TG : 0, tgn = grp ? 16384 : TG;
  const int nfilt = grp ? 0 : 544;
  const int nrow_items = tgn / 8;
  const int tid_ = otid();
  const int lane = tid_ & 63, wave = tid_ >> 6;
  bf16* H = (bf16*)(p.ws + OFF_H);
  const float* mods = (const float*)(p.ws + OFF_MODS);
  for (int it = blockIdx.x; it < nfilt + nrow_items; it += gridDim.x) {
    if (it < nfilt) { filter_item(p, layer, it, smem); continue; }
    const int tl = (it - nfilt) * 8 + wave, tg = g0 + tl;
    const float *qxp = launder(p.x_prompt), *qxs = launder(p.x_sample), *qo = launder(p.out);
    const float* x = layer == 0 ? (tg < T_CTX ? qxp + (size_t)tg * DM : qxs + (size_t)(tg - T_CTX) * DM) : qo + (size_t)tg * DM;
    float4 v[4];
    float ss = 0.f;
#pragma unroll
    for (int i = 0; i < 4; ++i) {
      v[i] = *(const float4*)(x + (lane + 64 * i) * 4);
      ss += v[i].x * v[i].x + v[i].y * v[i].y + v[i].z * v[i].z + v[i].w * v[i].w;
    }
#pragma unroll
    for (int o = 32; o > 0; o >>= 1) ss += __shfl_xor(ss, o);
    const float rstd = rsqrtf(ss * (1.f / 1024.f) + 1e-6f);
    const float* md = mods + (layer * 9 + cond_of(tg)) * 3072;
    const float* nw = p.norm_w + layer * 1024;
#pragma unroll
    for (int i = 0; i < 4; ++i) {
      const int col = (lane + 64 * i) * 4;
      const float4 sh = *(const float4*)(md + col), sc = *(const float4*)(md + 1024 + col), w = *(const float4*)(nw + col);
      bf16x4 o;
      o[0] = (short)f2bf(v[i].x * rstd * w.x * (1.f + sc.x) + sh.x);
      o[1] = (short)f2bf(v[i].y * rstd * w.y * (1.f + sc.y) + sh.y);
      o[2] = (short)f2bf(v[i].z * rstd * w.z * (1.f + sc.z) + sh.z);
      o[3] = (short)f2bf(v[i].w * rstd * w.w * (1.f + sc.w) + sh.w);
      *(bf16x4*)(H + (size_t)tl * 1024 + col) = o;
    }
  }
}

DI void p1b(const Params& p, int layer, int grp, char* smem) {
  const int g0 = grp ? TG : 0, tgn = grp ? 16384 : TG;
  const int mtiles = tgn / 256, ntot = mtiles * 42;
  const int tid = otid(), lane = tid & 63, wave = tid >> 6;
  const int wm = wave >> 1, wn = wave & 1, r = lane & 31, h = lane >> 5;
  const bf16* H = (const bf16*)(p.ws + OFF_H);
  const bf16* WinT = (const bf16*)(p.ws + OFF_W) + (size_t)layer * W_LAYER + W_IN;
  float* S = (float*)smem;
  u32x4 ra[2][4], rb[2][2];
  bool pre = false;
  for (int id = blockIdx.x; id < ntot; id += gridDim.x) {
    const int band = id / (32 * 42), rem = id % (32 * 42);
    const int mt = band * 32 + (rem & 31), nt = rem >> 5;
    const int idn = id + gridDim.x;
    const bool hn = idn < ntot;
    const int bandn = idn / (32 * 42), remn = idn % (32 * 42);
    const int mtn = bandn * 32 + (remn & 31), ntn = remn >> 5;
    f32x16 acc[2][2];
#pragma unroll
    for (int a = 0; a < 2; ++a)
#pragma unroll
      for (int b = 0; b < 2; ++b) acc[a][b] = zero16();
    gemm_main<2, false>(mksrc(H + (size_t)mt * 256 * 1024, 1024, WinT + (size_t)nt * 128 * 1024, 1024, 0), 1024, acc, smem, ra, rb, pre,
                        mksrc(H + (size_t)mtn * 256 * 1024, 1024, WinT + (size_t)ntn * 128 * 1024, 1024, 0), hn);
    pre = true;
    const int m0 = mt * 256, tg0 = g0 + m0;
    const bool lat = tg0 >= T_CTX;
    if (nt < 16) {
#pragma unroll
      for (int mi = 0; mi < 2; ++mi)
#pragma unroll
        for (int ni = 0; ni < 2; ++ni)
#pragma unroll
          for (int g4 = 0; g4 < 4; ++g4) {
            f32x4v v;
#pragma unroll
            for (int j = 0; j < 4; ++j) v[j] = acc[mi][ni][4 * g4 + j];
            *(f32x4v*)(S + (wn * 64 + ni * 32 + r) * 260 + wm * 64 + mi * 32 + 8 * g4 + 4 * h) = v;
          }
      __syncthreads();
      const int part = nt >> 2;
#pragma unroll 2
      for (int it = 0; it < 8; ++it) {
        const int pid = tid + 512 * it, cl = pid >> 5, q = pid & 31;
        const f32x4v a = *(const f32x4v*)(S + cl * 260 + q * 8), b = *(const f32x4v*)(S + cl * 260 + q * 8 + 4);
        bf16x8 v;
#pragma unroll
        for (int j = 0; j < 4; ++j) {
          v[j] = (short)f2bf(a[j]);
          v[4 + j] = (short)f2bf(b[j]);
        }
        *(bf16x8*)((bf16*)(p.ws + OFF_HYT) + ((size_t)(part * 512 + (nt & 3) * 128 + cl)) * TG + m0 + q * 8) = v;
      }
    } else {
#pragma unroll
      for (int mi = 0; mi < 2; ++mi)
#pragma unroll
        for (int ni = 0; ni < 2; ++ni)
#pragma unroll
          for (int i = 0; i < 16; ++i) S[(wm * 64 + mi * 32 + crow(i, h)) * 132 + wn * 64 + ni * 32 + r] = acc[mi][ni][i];
      __syncthreads();
      size_t off; int pitch, coloff; bool rope = false; int cache = 0;
      if (nt < 20) { off = OFF_AQ; pitch = 512; coloff = (nt - 16) * 128; rope = lat; }
      else if (nt == 20) { off = OFF_AK; pitch = 128; coloff = 0; rope = lat; cache = lat ? 0 : 1; }
      else if (nt == 21) { off = OFF_AV; pitch = 128; coloff = 0; cache = lat ? 0 : 2; }
      else if (nt < 26) { off = OFF_AG; pitch = 512; coloff = (nt - 22) * 128; }
      else if (nt < 30) { off = OFF_RQ; pitch = 512; coloff = (nt - 26) * 128; rope = lat; }
      else if (nt < 34) { off = OFF_RK; pitch = 512; coloff = (nt - 30) * 128; rope = lat; }
      else if (nt < 38) { off = OFF_RV; pitch = 512; coloff = (nt - 34) * 128; }
      else { off = OFF_RG; pitch = 512; coloff = (nt - 38) * 128; }
      bf16* dst = (bf16*)(p.ws + off);
      const float2* rt = (const float2*)(p.ws + OFF_ROPE);
#pragma unroll 2
      for (int it = 0; it < 8; ++it) {
        const int cid = tid + 512 * it, row = cid >> 4, cc = cid & 15;
        const float* sp = S + row * 132 + cc * 8;
        float v[8];
#pragma unroll
        for (int j = 0; j < 8; ++j) v[j] = sp[j];
        if (cache) {
          float* co = p.out + (cache == 1 ? OUT_CK : OUT_CV) + ((size_t)((tg0 >> 8) * 4 + layer) * 256 + row) * 128 + cc * 8;
          *(float4*)co = make_float4(v[0], v[1], v[2], v[3]);
          *(float4*)(co + 4) = make_float4(v[4], v[5], v[6], v[7]);
        }
        if (rope) {
          const int hd0 = (cc * 8) & 63, q = hd0 >> 4;
          const int tpos = (tg0 - T_CTX + row) & 4095;
          const float2* tb = rt + tpos * 32 + (q >> 1) * 16 + (hd0 & 15);
          const float* pp = sp + ((q & 1) ? -16 : 16);
          const float sg = (q & 1) ? 1.f : -1.f;
#pragma unroll
          for (int j = 0; j < 8; ++j) {
            const float2 cs = tb[j];
            v[j] = v[j] * cs.x + sg * pp[j] * cs.y;
          }
        }
        bf16x8 o;
#pragma unroll
        for (int j = 0; j < 8; ++j) o[j] = (short)f2bf(v[j]);
        *(bf16x8*)(dst + (size_t)(m0 + row) * pitch + coloff + cc * 8) = o;
      }
    }
  }
}

template <int NBT, int L>
DI void hyena_item(const Params& p, int layer, int var, int tlbase, int c, char* smem) {
  constexpr int NP = 32 / NBT, NT = (L / 8) / (32 * NP), UP = L + 8;
  bf16* U = (bf16*)smem;
  bf16* X1 = U + NBT * UP;
  bf16* X2 = X1 + NBT * UP;
  bf16* GR = X2 + NBT * UP;
  bf16* GR1 = GR + 2 * L + 8;
  const int tid = otid(), lane = tid & 63, wave = tid >> 6;
  const int n = lane & 31, hh = lane >> 5, b = n & (NBT - 1), pp = n / NBT;
  const bf16* hyT = (const bf16*)(p.ws + OFF_HYT);
  const float* fs = (const float*)(p.ws + OFF_FSUM) + (layer * 2 + var) * 1024;
  const float* gsrc = (const float*)(p.ws + (var == 0 ? OFF_GL : OFF_GC));
  __syncthreads();
#pragma unroll 1
  for (int part = 0; part < 3; ++part) {
    const bf16* src = hyT + ((size_t)(part * 512 + c)) * TG + tlbase;
    bf16* dstb = part == 0 ? U : part == 1 ? X1 : X2;
    const float w0 = p.hy_conv[(layer * 3 + 0) * 1536 + part * 512 + c];
    const float w1 = p.hy_conv[(layer * 3 + 1) * 1536 + part * 512 + c];
    const float w2 = p.hy_conv[(layer * 3 + 2) * 1536 + part * 512 + c];
#pragma unroll
    for (int it = 0; it < NBT * L / 8 / 512; ++it) {
      const int id = tid + 512 * it;
      const int bb = id / (L / 8), t8 = (id % (L / 8)) * 8;
      const bf16* s = src + bb * L + t8;
      const bf16x8 xv = *(const bf16x8*)s;
      float x[10];
      x[0] = t8 > 0 ? bf2f(s[-1]) : 0.f;
      x[9] = t8 + 8 < L ? bf2f(s[8]) : 0.f;
#pragma unroll
      for (int j = 0; j < 8; ++j) x[j + 1] = bf2f((bf16)xv[j]);
      bf16x8 o;
#pragma unroll
      for (int j = 0; j < 8; ++j) o[j] = (short)f2bf(w0 * x[j] + w1 * x[j + 1] + w2 * x[j + 2]);
      *(bf16x8*)(dstb + bb * UP + t8) = o;
    }
  }
  const int wbase = wave * (L / 8);
  const int dmin = -(wbase + (NT - 1) * 32 * NP + 32 * (NP - 1)), dmax = L - 16 - wbase;
  f32x16 acc[NT];
#pragma unroll 1
  for (int o = 0; o < 2; ++o) {
    {
      const float inv = 1.f / fs[o * 512 + c];
      const float* gs = gsrc + ((size_t)(o * 512 + c)) * (2 * L);
      const float skip = p.hy_skip[(layer * 2 + o) * 512 + c];
#pragma unroll 8
      for (int y = tid; y < 2 * L; y += 512) {
        float v = gs[y] * inv;
        if (y == L) v = (gs[L] + gs[0]) * inv + skip;
        if (y == 0) v = 0.f;
        const bf16 bv = f2bf(v);
        GR[y] = bv;
        if (y > 0) GR1[y - 1] = bv;
      }
      if (tid == 0) GR1[2 * L - 1] = 0;
    }
    __syncthreads();
#pragma unroll
    for (int q = 0; q < NT; ++q) acc[q] = zero16();
#pragma unroll 1
    for (int d = dmin; d <= dmax; d += 16) {
      const unsigned* gp = (const unsigned*)(((n & 1) ? GR1 - 1 : GR) + (L - n + d + 8 * hh));
      typedef __attribute__((ext_vector_type(4))) unsigned u4;
      u4 aw;
#pragma unroll
      for (int j = 0; j < 4; ++j) aw[j] = gp[j];
      const bf16x8 a = __builtin_bit_cast(bf16x8, aw);
#pragma unroll
      for (int q = 0; q < NT; ++q) {
        const int s0 = wbase + q * 32 * NP + 32 * pp + d;
        bf16x8 bb;
#pragma unroll
        for (int j = 0; j < 8; ++j) bb[j] = 0;
        if (s0 >= 0 && s0 <= L - 16) bb = *(const bf16x8*)(U + b * UP + s0 + 8 * hh);
        acc[q] = MFMA(a, bb, acc[q]);
      }
    }
    __syncthreads();
    if (o == 0) {
#pragma unroll
      for (int q = 0; q < NT; ++q)
#pragma unroll
        for (int i = 0; i < 16; ++i) {
          const int t = wbase + q * 32 * NP + 32 * pp + crow(i, hh);
          U[b * UP + t] = f2bf(bf2f(X1[b * UP + t]) * acc[q][i]);
        }
    } else {
      const bf16* gate = hyT + ((size_t)(3 * 512 + c)) * TG + tlbase;
#pragma unroll
      for (int q = 0; q < NT; ++q)
#pragma unroll
        for (int g4 = 0; g4 < 4; ++g4) {
          const int t = wbase + q * 32 * NP + 32 * pp + 8 * g4 + 4 * hh;
          const bf16x4 gv = *(const bf16x4*)(gate + b * L + t);
          bf16x4 ov;
#pragma unroll
          for (int j = 0; j < 4; ++j)
            ov[j] = (short)f2bf(bf2f(X2[b * UP + t + j]) * acc[q][4 * g4 + j] * siluf(bf2f((bf16)gv[j])));
          *(bf16x4*)(U + b * UP + t) = ov;
        }
      __syncthreads();
      bf16* yat = (bf16*)(p.ws + OFF_YA) + (size_t)c * TG + tlbase;
      for (int id = tid; id < NBT * L / 8; id += 512) {
        const int bb = id / (L / 8), t8 = (id % (L / 8)) * 8;
        *(bf16x8*)(yat + bb * L + t8) = *(const bf16x8*)(U + bb * UP + t8);
      }
    }
  }
}

DI void attn_item(const Params& p, int layer, bool lat, int tlbase, int bglob, int kvh, int qblk, char* smem) {
  bf16* Ks = (bf16*)smem;
  bf16* VT = Ks + 64 * 72;
  const int tid = otid(), lane = tid & 63, wave = tid >> 6;
  const int r = lane & 31, hh = lane >> 5;
  const int head = kvh * 4 + (wave >> 1);
  const int qi = qblk * 64 + (wave & 1) * 32 + r;
  const int tlq = tlbase + qi;
  const bf16* aq = (const bf16*)(p.ws + OFF_AQ);
  const bf16* ak = (const bf16*)(p.ws + OFF_AK);
  const bf16* av = (const bf16*)(p.ws + OFF_AV);
  bf16* ag = (bf16*)(p.ws + OFF_AG);
  bf16x8 bq[4];
#pragma unroll
  for (int ks = 0; ks < 4; ++ks) bq[ks] = *(const bf16x8*)(aq + (size_t)tlq * 512 + head * 64 + ks * 16 + hh * 8);
  const float sink2 = p.attn_sink[layer * 8 + head] * LOG2E;
  const float SC = 0.125f * LOG2E;
  float m = sink2, lsum = 0.f;
  f32x16 O[2];
  O[0] = zero16();
  O[1] = zero16();
  const int t_lo = lat ? (2 - qblk > 0 ? 2 - qblk : 0) : 0;
  const int t_hi = lat ? (65 - qblk < 4 ? 65 - qblk : 4) : 3;
  const int nw = t_hi - t_lo + 1;
  const int ntot = lat ? nw + 8 : nw;
  const int lj = tid >> 3, lkc = (tid & 7) * 8;
  u32x4 pr0, pr1, pr2, pr3;
  pr2 = u32x4{0, 0, 0, 0};
  pr3 = u32x4{0, 0, 0, 0};
  {
    const int kp = lat ? qblk * 64 - 128 + t_lo * 64 : 0;
    const size_t o = (size_t)(tlbase + kp + lj) * 128 + kvh * 64 + lkc;
    pr0 = *(const u32x4*)(ak + o);
    pr1 = *(const u32x4*)(av + o);
  }
#pragma unroll 1
  for (int n = 0; n < ntot; ++n) {
    const bool from_cache = lat && n >= nw;
    const bool window = lat && n < nw && (t_lo + n == 0 || t_lo + n == 4);
    const int kpos0 = from_cache ? (n - nw) * 64 : (lat ? qblk * 64 - 128 + (t_lo + n) * 64 : n * 64);
    lds_barrier();
    {
      bf16x8 kv, vv;
      if (from_cache) {
        const f32x4v k0 = __builtin_bit_cast(f32x4v, pr0), k1 = __builtin_bit_cast(f32x4v, pr1);
        const f32x4v v0 = __builtin_bit_cast(f32x4v, pr2), v1 = __builtin_bit_cast(f32x4v, pr3);
#pragma unroll
        for (int e = 0; e < 4; ++e) {
          kv[e] = (short)f2bf(k0[e]);
          kv[4 + e] = (short)f2bf(k1[e]);
          vv[e] = (short)f2bf(v0[e]);
          vv[4 + e] = (short)f2bf(v1[e]);
        }
      } else {
        kv = __builtin_bit_cast(bf16x8, pr0);
        vv = __builtin_bit_cast(bf16x8, pr1);
      }
      *(bf16x8*)(Ks + lj * 72 + lkc) = kv;
#pragma unroll
      for (int jj = 0; jj < 8; ++jj) VT[(lkc + jj) * 68 + lj] = (bf16)vv[jj];
    }
    lds_barrier();
    {
      const int nn = n + 1 < ntot ? n + 1 : n;
      if (lat && nn >= nw) {
        const size_t o = ((((size_t)bglob * 4 + layer) * 512 + (nn - nw) * 64 + lj) * 2 + kvh) * 64 + lkc;
        pr0 = *(const u32x4*)(p.cache_k + o);
        pr1 = *(const u32x4*)(p.cache_k + o + 4);
        pr2 = *(const u32x4*)(p.cache_v + o);
        pr3 = *(const u32x4*)(p.cache_v + o + 4);
      } else {
        const int kp = lat ? qblk * 64 - 128 + (t_lo + nn) * 64 : nn * 64;
        const size_t o = (size_t)(tlbase + kp + lj) * 128 + kvh * 64 + lkc;
        pr0 = *(const u32x4*)(ak + o);
        pr1 = *(const u32x4*)(av + o);
      }
    }
    f32x16 sc[2];
#pragma unroll
    for (int sub = 0; sub < 2; ++sub) {
      sc[sub] = zero16();
#pragma unroll
      for (int ks = 0; ks < 4; ++ks) {
        const bf16x8 a = *(const bf16x8*)(Ks + (sub * 32 + r) * 72 + ks * 16 + hh * 8);
        sc[sub] = MFMA(a, bq[ks], sc[sub]);
      }
    }
    float mx = -3.0e38f;
#pragma unroll
    for (int sub = 0; sub < 2; ++sub)
#pragma unroll
      for (int i = 0; i < 16; ++i) {
        float sv = sc[sub][i] * SC;
        if (window) {
          const int diff = qi - (kpos0 + sub * 32 + crow(i, hh));
          if (diff > 128 || diff < -128) sv = -1e30f;
        }
        sc[sub][i] = sv;
        mx = fmaxf(mx, sv);
      }
    mx = fmaxf(mx, __shfl_xor(mx, 32));
    const float mnew = fmaxf(m, mx);
    const float alpha = __builtin_amdgcn_exp2f(m - mnew);
    m = mnew;
    float ps = 0.f;
#pragma unroll
    for (int sub = 0; sub < 2; ++sub)
#pragma unroll
      for (int i = 0; i < 16; ++i) {
        sc[sub][i] = __builtin_amdgcn_exp2f(sc[sub][i] - m);
        ps += sc[sub][i];
      }
    lsum = lsum * alpha + ps;
    if (__builtin_amdgcn_ballot_w64(alpha != 1.f) != 0) {
#pragma unroll
      for (int i = 0; i < 16; ++i) {
        O[0][i] *= alpha;
        O[1][i] *= alpha;
      }
    }
#pragma unroll
    for (int sub = 0; sub < 2; ++sub)
#pragma unroll
      for (int st = 0; st < 2; ++st) {
        const bf16x8 pf = pack8(sc[sub], st);
#pragma unroll
        for (int mi = 0; mi < 2; ++mi) {
          const bf16* vp = VT + (mi * 32 + r) * 68 + sub * 32 + 16 * st + 4 * hh;
          const bf16x4 lo = *(const bf16x4*)vp, hi = *(const bf16x4*)(vp + 8);
          const bf16x8 va = __builtin_shufflevector(lo, hi, 0, 1, 2, 3, 4, 5, 6, 7);
          O[mi] = MFMA(va, pf, O[mi]);
        }
      }
  }
  const float ltot = lsum + __shfl_xor(lsum, 32) + exp2f(sink2 - m);
  const float inv = 1.f / ltot;
#pragma unroll
  for (int mi = 0; mi < 2; ++mi)
#pragma unroll
    for (int g4 = 0; g4 < 4; ++g4) {
      bf16* gp = ag + (size_t)tlq * 512 + head * 64 + mi * 32 + 8 * g4 + 4 * hh;
      const bf16x4 gv = *(const bf16x4*)gp;
      bf16x4 o;
#pragma unroll
      for (int j = 0; j < 4; ++j) o[j] = (short)f2bf(O[mi][4 * g4 + j] * inv * siluf(bf2f((bf16)gv[j])));
      *(bf16x4*)gp = o;
    }
}

DI void ret_item(const Params& p, int layer, bool lat, int NC, int tlbase, int bglob, int hd, char* smem) {
  const int tid = otid(), lane = tid & 63, wave = tid >> 6;
  const int dir = wave >> 2, w4 = wave & 3, r = lane & 31, hh = lane >> 5, dt = tid & 255;
  bf16* Ks = (bf16*)smem + dir * 31232;
  bf16* KdT = Ks + 128 * 72;
  bf16* VT = KdT + 64 * 136;
  bf16* ST = VT + 64 * 136;
  const bf16* rq = (const bf16*)(p.ws + OFF_RQ);
  const bf16* rk = (const bf16*)(p.ws + OFF_RK);
  const bf16* rv = (const bf16*)(p.ws + OFF_RV);
  bf16* rg = (bf16*)(p.ws + OFF_RG);
  bf16* ofb = (bf16*)(p.ws + OFF_OFB);
  const float theta = p.ret_theta[(layer * 2 + dir) * 8 + hd];
  const float lg2 = -log1pf(expf(-theta)) * LOG2E;
  const float cdec = exp2f(lg2 * 128.f);
  const int etile = w4 >> 1, dtile = w4 & 1;
  f32x16 Sacc;
  if (lat) {
    const float* s0 = p.state_ret + ((((size_t)bglob * 4 + layer) * 2 + dir) * 8 + hd) * 4096;
#pragma unroll
    for (int i = 0; i < 16; ++i) Sacc[i] = s0[(dtile * 32 + r) * 64 + etile * 32 + crow(i, hh)];
  } else {
    Sacc = zero16();
  }
  __syncthreads();
#pragma unroll
  for (int i = 0; i < 16; ++i) ST[(etile * 32 + crow(i, hh)) * 72 + dtile * 32 + r] = f2bf(Sacc[i]);
#pragma unroll 1
  for (int step = 0; step < NC; ++step) {
    const int tid_s = otid();
    const int r = tid_s & 31, hh = (tid_s >> 5) & 1, dt = tid_s & 255;
    const int ch = dir ? NC - 1 - step : step;
    const int tl0 = tlbase + ch * 128;
    const int iq = w4 * 32 + r, tlq = tl0 + iq;
    const bool second = step >= NC / 2;
    bf16x8 kv[4], vv[4], bq[4];
    u32x4 pp4[4], pg4[4];
    const int kq = dt & 7;
#pragma unroll
    for (int i = 0; i < 4; ++i) {
      const int j = (dt + 256 * i) >> 3;
      const size_t o = (size_t)(tl0 + j) * 512 + hd * 64 + kq * 8;
      kv[i] = *(const bf16x8*)(rk + o);
      vv[i] = *(const bf16x8*)(rv + o);
    }
#pragma unroll
    for (int ks = 0; ks < 4; ++ks) bq[ks] = *(const bf16x8*)(rq + (size_t)tlq * 512 + hd * 64 + ks * 16 + hh * 8);
    if (second) {
#pragma unroll
      for (int mi = 0; mi < 2; ++mi)
#pragma unroll
        for (int k = 0; k < 2; ++k) {
          const size_t o = (size_t)tlq * 512 + hd * 64 + mi * 32 + 16 * k + 8 * hh;
          pp4[mi * 2 + k] = *(const u32x4*)(ofb + o);
          pg4[mi * 2 + k] = *(const u32x4*)(rg + o);
        }
    } else {
#pragma unroll
      for (int i = 0; i < 4; ++i) {
        pp4[i] = u32x4{0, 0, 0, 0};
        pg4[i] = u32x4{0, 0, 0, 0};
      }
    }
    {
#pragma unroll
      for (int i = 0; i < 4; ++i) {
        const int j = (dt + 256 * i) >> 3;
        const float kd = exp2f(lg2 * (float)(dir ? j : 127 - j)) * 0.125f;
        *(bf16x8*)(Ks + j * 72 + kq * 8) = kv[i];
        const int js = j ^ (kq << 3);
#pragma unroll
        for (int jj = 0; jj < 8; ++jj) {
          KdT[(kq * 8 + jj) * 136 + js] = f2bf(bf2f((bf16)kv[i][jj]) * kd);
          VT[(kq * 8 + jj) * 136 + js] = (bf16)vv[i][jj];
        }
      }
    }
    __syncthreads();
    f32x16 O[2];
    {
      const float qd = exp2f(lg2 * (float)(dir ? 128 - iq : iq + 1));
#pragma unroll
      for (int mi = 0; mi < 2; ++mi) {
        f32x16 oc = zero16();
#pragma unroll
        for (int ks = 0; ks < 4; ++ks) {
          const bf16x8 a = *(const bf16x8*)(ST + (mi * 32 + r) * 72 + ks * 16 + hh * 8);
          oc = MFMA(a, bq[ks], oc);
        }
#pragma unroll
        for (int i = 0; i < 16; ++i) O[mi][i] = oc[i] * qd;
      }
    }
#pragma unroll 1
    for (int jt = 0; jt < 4; ++jt) {
      if (dir == 0 ? (jt <= w4) : (jt >= w4)) {
        f32x16 s = zero16();
#pragma unroll
        for (int ks = 0; ks < 4; ++ks) {
          const bf16x8 a = *(const bf16x8*)(Ks + (jt * 32 + r) * 72 + ks * 16 + hh * 8);
          s = MFMA(a, bq[ks], s);
        }
#pragma unroll
        for (int i = 0; i < 16; ++i) {
          const int j = jt * 32 + crow(i, hh);
          const int diff = dir ? j - iq : iq - j;
          s[i] = diff >= 0 ? s[i] * 0.125f * __builtin_amdgcn_exp2f(lg2 * (float)diff) : 0.f;
        }
#pragma unroll
        for (int st = 0; st < 2; ++st) {
          const bf16x8 pf = pack8(s, st);
#pragma unroll
          for (int mi = 0; mi < 2; ++mi) {
            const int key = ((mi * 32 + r) >> 3) & 7, g = jt * 4 + 2 * st;
            const bf16* vrow = VT + (mi * 32 + r) * 136 + 4 * hh;
            const bf16x4 lo = *(const bf16x4*)(vrow + ((g ^ key) << 3)), hi = *(const bf16x4*)(vrow + (((g + 1) ^ key) << 3));
            const bf16x8 va = __builtin_shufflevector(lo, hi, 0, 1, 2, 3, 4, 5, 6, 7);
            O[mi] = MFMA(va, pf, O[mi]);
          }
        }
      }
    }
#pragma unroll
    for (int i = 0; i < 16; ++i) Sacc[i] *= cdec;
#pragma unroll 2
    for (int jk = 0; jk < 8; ++jk) {
      const int ga = (jk * 2 + hh) ^ (((etile * 32 + r) >> 3) & 7), gb = (jk * 2 + hh) ^ (((dtile * 32 + r) >> 3) & 7);
      const bf16x8 a = *(const bf16x8*)(VT + (etile * 32 + r) * 136 + ga * 8);
      const bf16x8 bb = *(const bf16x8*)(KdT + (dtile * 32 + r) * 136 + gb * 8);
      Sacc = MFMA(a, bb, Sacc);
    }
    if (!second) {
#pragma unroll
      for (int mi = 0; mi < 2; ++mi)
#pragma unroll
        for (int k = 0; k < 2; ++k) {
          unsigned a0 = pk2f(O[mi][8 * k + 0], O[mi][8 * k + 1]), a1 = pk2f(O[mi][8 * k + 2], O[mi][8 * k + 3]);
          unsigned b0 = pk2f(O[mi][8 * k + 4], O[mi][8 * k + 5]), b1 = pk2f(O[mi][8 * k + 6], O[mi][8 * k + 7]);
          swap32(a0, b0);
          swap32(a1, b1);
          *(u32x4*)(ofb + (size_t)tlq * 512 + hd * 64 + mi * 32 + 16 * k + 8 * hh) = u32x4{a0, a1, b0, b1};
        }
    } else {
      float ss = 0.f;
#pragma unroll
      for (int mi = 0; mi < 2; ++mi)
#pragma unroll
        for (int k = 0; k < 2; ++k) {
          unsigned w0 = pp4[mi * 2 + k][0], w1 = pp4[mi * 2 + k][1], w2 = pp4[mi * 2 + k][2], w3 = pp4[mi * 2 + k][3];
          swap32(w0, w2);
          swap32(w1, w3);
          const float pv[8] = {bflo(w0), bfhi(w0), bflo(w1), bfhi(w1), bflo(w2), bfhi(w2), bflo(w3), bfhi(w3)};
#pragma unroll
          for (int j = 0; j < 8; ++j) {
            const float v = O[mi][8 * k + j] + pv[j];
            O[mi][8 * k + j] = v;
            ss += v * v;
          }
        }
      ss += __shfl_xor(ss, 32);
      const float rn = rsqrtf(ss * (1.f / 64.f) + 1e-6f);
#pragma unroll
      for (int mi = 0; mi < 2; ++mi)
#pragma unroll
        for (int k = 0; k < 2; ++k) {
          unsigned w0 = pg4[mi * 2 + k][0], w1 = pg4[mi * 2 + k][1], w2 = pg4[mi * 2 + k][2], w3 = pg4[mi * 2 + k][3];
          swap32(w0, w2);
          swap32(w1, w3);
          const float gv[8] = {bflo(w0), bfhi(w0), bflo(w1), bfhi(w1), bflo(w2), bfhi(w2), bflo(w3), bfhi(w3)};
          float ov[8];
#pragma unroll
          for (int half = 0; half < 2; ++half) {
            const int e0 = hd * 64 + mi * 32 + 8 * (2 * k + half) + 4 * hh;
            const f32x4v gn = *(const f32x4v*)(p.ret_gn + layer * 512 + e0);
#pragma unroll
            for (int j = 0; j < 4; ++j) ov[4 * half + j] = O[mi][8 * k + 4 * half + j] * rn * gn[j] * siluf(gv[4 * half + j]);
          }
          unsigned a0 = pk2f(ov[0], ov[1]), a1 = pk2f(ov[2], ov[3]), b0 = pk2f(ov[4], ov[5]), b1 = pk2f(ov[6], ov[7]);
          swap32(a0, b0);
          swap32(a1, b1);
          *(u32x4*)(rg + (size_t)tlq * 512 + hd * 64 + mi * 32 + 16 * k + 8 * hh) = u32x4{a0, a1, b0, b1};
        }
    }
    __builtin_amdgcn_fence(__ATOMIC_SEQ_CST, "workgroup");
    __syncthreads();
#pragma unroll
    for (int i = 0; i < 16; ++i) ST[(etile * 32 + crow(i, hh)) * 72 + dtile * 32 + r] = f2bf(Sacc[i]);
  }
  if (!lat) {
    float* so = p.out + OUT_ST + ((((size_t)bglob * 4 + layer) * 2 + dir) * 8 + hd) * 4096;
#pragma unroll
    for (int i = 0; i < 16; ++i) so[(dtile * 32 + r) * 64 + etile * 32 + crow(i, hh)] = Sacc[i];
  }
}

DI void p2(const Params& p, int layer, int grp, char* smem, int* s_item) {
  int* ctr = (int*)(p.ws + OFF_CTR) + layer * 2 + grp;
  const int n_rl = 32, n_hl = 512, n_al = 512;
  const int n_hc = grp ? 0 : 512, n_rc = grp ? 0 : 256, n_ac = grp ? 0 : 256;
  const int total = n_rl + n_hl + n_al + n_hc + n_rc + n_ac;
  const int latbase = grp ? 0 : T_CTX;
  const int latb0 = grp ? 4 : 0;
  for (;;) {
    __syncthreads();
    if (threadIdx.x == 0) *s_item = atomicAdd(ctr, 1);
    __syncthreads();
    int it = *s_item;
    if (it >= total) break;
    if (it < n_rl) {
      const int b = it >> 3, hd = it & 7;
      ret_item(p, layer, true, 32, latbase + b * 4096, latb0 + b, hd, smem);
      continue;
    }
    it -= n_rl;
    if (it < n_hl) { hyena_item<4, 4096>(p, layer, 0, latbase, it, smem); continue; }
    it -= n_hl;
    if (it < n_al) {
      const int b = it >> 7, kvh = (it >> 6) & 1, qb = it & 63;
      attn_item(p, layer, true, latbase + b * 4096, latb0 + b, kvh, qb, smem);
      continue;
    }
    it -= n_al;
    if (it < n_hc) { hyena_item<32, 256>(p, layer, 1, 0, it, smem); continue; }
    it -= n_hc;
    if (it < n_rc) {
      const int b = it >> 3, hd = it & 7;
      ret_item(p, layer, false, 2, b * 256, b, hd, smem);
      continue;
    }
    it -= n_rc;
    {
      const int b = it >> 3, kvh = (it >> 2) & 1, qb = it & 3;
      attn_item(p, layer, false, b * 256, b, kvh, qb, smem);
    }
  }
}

DI unsigned pk2(float a, float b) { return (unsigned)f2bf(a) | ((unsigned)f2bf(b) << 16); }
DI float pklo(unsigned u) { return __uint_as_float(u << 16); }
DI float pkhi(unsigned u) { return __uint_as_float(u & 0xffff0000u); }
DI void p3a(const Params& p, int layer, int grp, char* smem) {
  const int tgn = grp ? 16384 : TG;
  const int mtiles = tgn / 256, ntot = mtiles * 8;
  const int tid = otid(), lane = tid & 63, wave = tid >> 6;
  const int wm = wave >> 1, wn = wave & 1, r = lane & 31, h = lane >> 5;
  const bf16* H = (const bf16*)(p.ws + OFF_H);
  const bf16* wl = (const bf16*)(p.ws + OFF_W) + (size_t)layer * W_LAYER;
  bf16* MG = (bf16*)(p.ws + OFF_MERGED);
  u32x4 ra[2][4], rb[2][2];
  bool pre = false;
  const bf16* YaT = (const bf16*)(p.ws + OFF_YA);
  for (int id = blockIdx.x; id < ntot; id += gridDim.x) {
    const int m0 = ((id >> 7) * 16 + (id & 15)) * 256, n0 = ((id & 127) >> 4) * 128;
    const int idn = id + gridDim.x;
    const bool hn = idn < ntot;
    const int m0n = ((idn >> 7) * 16 + (idn & 15)) * 256, n0n = ((idn & 127) >> 4) * 128;
    unsigned mgp[2][2][8];
#pragma unroll
    for (int a = 0; a < 2; ++a)
#pragma unroll
      for (int b = 0; b < 2; ++b)
#pragma unroll
        for (int i = 0; i < 8; ++i) mgp[a][b][i] = 0u;
#pragma unroll 1
    for (int br = 0; br < 3; ++br) {
      const GemmSrc gate = mksrc(H + (size_t)m0 * 1024, 1024, wl + W_MG + (size_t)(br * 1024 + n0) * 1024, 1024, 0);
      const bf16* WB = wl + (br == 0 ? W_A : br == 1 ? W_B : W_C);
      const GemmSrc bsrc = br == 0 ? mksrc(YaT + m0, TG, WB + (size_t)n0 * 512, 512, 1)
                                   : mksrc((const bf16*)(p.ws + (br == 1 ? OFF_AG : OFF_RG)) + (size_t)m0 * 512, 512, WB + (size_t)n0 * 512, 512, 0);
      const GemmSrc after = br < 2 ? mksrc(H + (size_t)m0 * 1024, 1024, wl + W_MG + (size_t)((br + 1) * 1024 + n0) * 1024, 1024, 0)
                                   : mksrc(H + (size_t)m0n * 1024, 1024, wl + W_MG + (size_t)n0n * 1024, 1024, 0);
      unsigned sg[2][2][8];
      {
        f32x16 ag[2][2];
#pragma unroll
        for (int a = 0; a < 2; ++a)
#pragma unroll
          for (int b = 0; b < 2; ++b) ag[a][b] = zero16();
        gemm_main<2, false>(gate, 1024, ag, smem, ra, rb, false, bsrc, false);
#pragma unroll
        for (int ni = 0; ni < 2; ++ni) {
          const float bias = p.b_merge[layer * 3072 + br * 1024 + n0 + wn * 64 + ni * 32 + r];
#pragma unroll
          for (int mi = 0; mi < 2; ++mi) {
#pragma unroll
            for (int i = 0; i < 8; ++i)
              sg[mi][ni][i] = pk2(sigmf(ag[mi][ni][2 * i] + bias), sigmf(ag[mi][ni][2 * i + 1] + bias));
            __builtin_amdgcn_sched_barrier(0);
          }
        }
      }
      f32x16 ay[2][2];
#pragma unroll
      for (int a = 0; a < 2; ++a)
#pragma unroll
        for (int b = 0; b < 2; ++b) ay[a][b] = zero16();
      if (br == 0) gemm_main<2, true>(bsrc, 512, ay, smem, ra, rb, false, after, false);
      else gemm_main<2, false>(bsrc, 512, ay, smem, ra, rb, false, after, false);
#pragma unroll
      for (int mi = 0; mi < 2; ++mi)
#pragma unroll
        for (int ni = 0; ni < 2; ++ni) {
#pragma unroll
          for (int i = 0; i < 8; ++i) {
            const float lo = pklo(mgp[mi][ni][i]) + pklo(sg[mi][ni][i]) * ay[mi][ni][2 * i];
            const float hi = pkhi(mgp[mi][ni][i]) + pkhi(sg[mi][ni][i]) * ay[mi][ni][2 * i + 1];
            mgp[mi][ni][i] = pk2(lo, hi);
          }
          __builtin_amdgcn_sched_barrier(0);
        }
    }
    {
      const int t2 = otid(), l2 = t2 & 63, w2 = t2 >> 6;
      const int wm2 = w2 >> 1, wn2 = w2 & 1, r2 = l2 & 31, h2 = l2 >> 5;
#pragma unroll
      for (int mi = 0; mi < 2; ++mi)
#pragma unroll
        for (int ni = 0; ni < 2; ++ni)
#pragma unroll
          for (int i = 0; i < 8; ++i) {
            bf16* d = MG + (size_t)(m0 + wm2 * 64 + mi * 32) * 1024 + n0 + wn2 * 64 + ni * 32 + r2;
            d[(size_t)crow(2 * i, h2) * 1024] = (bf16)(mgp[mi][ni][i] & 0xffffu);
            d[(size_t)crow(2 * i + 1, h2) * 1024] = (bf16)(mgp[mi][ni][i] >> 16);
          }
    }
  }
}

DI void p3b(const Params& p, int layer, int grp, char* smem) {
  const int g0 = grp ? TG : 0, tgn = grp ? 16384 : TG;
  const int mtiles = tgn / 256, ntot = mtiles * 8;
  const int tid = otid(), lane = tid & 63, wave = tid >> 6;
  const int wm = wave >> 1, wn = wave & 1, r = lane & 31, h = lane >> 5;
  const bf16* MG = (const bf16*)(p.ws + OFF_MERGED);
  const bf16* WoT = (const bf16*)(p.ws + OFF_W) + (size_t)layer * W_LAYER + W_O;
  const float* mods = (const float*)(p.ws + OFF_MODS);
  u32x4 ra[2][4], rb[2][2];
  bool pre = false;
  for (int id = blockIdx.x; id < ntot; id += gridDim.x) {
    const int band = id >> 7, rem = id & 127;
    const int mt = band * 16 + (rem & 15), nt = rem >> 4;
    const int m0 = mt * 256, n0 = nt * 128;
    const int idn = id + gridDim.x;
    const bool hn = idn < ntot;
    const int m0n = ((idn >> 7) * 16 + (idn & 15)) * 256, n0n = ((idn & 127) >> 4) * 128;
    f32x16 acc[2][2];
#pragma unroll
    for (int a = 0; a < 2; ++a)
#pragma unroll
      for (int b = 0; b < 2; ++b) acc[a][b] = zero16();
    gemm_main<2, false>(mksrc(MG + (size_t)m0 * 1024, 1024, WoT + (size_t)n0 * 1024, 1024, 0), 1024, acc, smem, ra, rb, pre,
                        mksrc(MG + (size_t)m0n * 1024, 1024, WoT + (size_t)n0n * 1024, 1024, 0), hn);
    pre = true;
    const int tg0 = g0 + m0;
    const float* gate = mods + (layer * 9 + cond_of(tg0)) * 3072 + 2048;
    const float *qxp = launder(p.x_prompt), *qxs = launder(p.x_sample), *qo = launder(p.out);
    const float* xsb = layer == 0 ? (tg0 < T_CTX ? qxp + (size_t)tg0 * DM : qxs + (size_t)(tg0 - T_CTX) * DM) : qo + (size_t)tg0 * DM;
    float* xdb = p.out + (size_t)tg0 * DM;
#pragma unroll
    for (int ni = 0; ni < 2; ++ni) {
      const int col = n0 + wn * 64 + ni * 32 + r;
      const float gt = gate[col];
#pragma unroll
      for (int mi = 0; mi < 2; ++mi)
#pragma unroll
        for (int i = 0; i < 16; ++i) {
          const int ro = (wm * 64 + mi * 32 + crow(i, h)) * DM + col;
          xdb[ro] = xsb[ro] + gt * acc[mi][ni][i];
        }
    }
  }
}

DI void final_norm(const Params& p) {
  const int tid_ = otid();
  const int lane = tid_ & 63, wave = tid_ >> 6;
  for (int it = blockIdx.x; it < T_ALL / 8; it += gridDim.x) {
    const int tg = it * 8 + wave;
    float* x = p.out + (size_t)tg * DM;
    float4 v[4];
    float ss = 0.f;
#pragma unroll
    for (int i = 0; i < 4; ++i) {
      v[i] = *(const float4*)(x + (lane + 64 * i) * 4);
      ss += v[i].x * v[i].x + v[i].y * v[i].y + v[i].z * v[i].z + v[i].w * v[i].w;
    }
#pragma unroll
    for (int o = 32; o > 0; o >>= 1) ss += __shfl_xor(ss, o);
    const float rstd = rsqrtf(ss * (1.f / 1024.f) + 1e-6f);
#pragma unroll
    for (int i = 0; i < 4; ++i) {
      const int col = (lane + 64 * i) * 4;
      const float4 w = *(const float4*)(p.final_w + col);
      *(float4*)(x + col) = make_float4(v[i].x * rstd * w.x, v[i].y * rstd * w.y, v[i].z * rstd * w.z, v[i].w * rstd * w.w);
    }
  }
}


#define XB_TMO 128
#define XB_XCNT(j) (256 + 64 * (j))
#define XB_XSUB(j) (1280 + 64 * (j))
#define XB_XGEN(j) (2304 + 64 * (j))
#define XB_TOP 3328
#define XB_TOPGEN 3392
#define XB_SPIN_CAP (1u << 22)
DI unsigned xb_ld(unsigned* p) { return __hip_atomic_load(p, __ATOMIC_RELAXED, __HIP_MEMORY_SCOPE_AGENT); }
DI unsigned xb_add(unsigned* p, unsigned v) { return __hip_atomic_fetch_add(p, v, __ATOMIC_RELAXED, __HIP_MEMORY_SCOPE_AGENT); }
DI unsigned xb_xcc_id() { return (unsigned)__builtin_amdgcn_s_getreg((3 << 11) | 20) & 0xFu; }
#define XB_SPIN(cond, bar)                                          \
  do {                                                              \
    unsigned _sp = 0;                                               \
    while (cond) {                                                  \
      __builtin_amdgcn_s_sleep(1);                                  \
      if ((++_sp & 255u) == 0u) {                                   \
        if (xb_ld(&(bar)[XB_TMO])) break;                           \
        if (_sp > XB_SPIN_CAP) {                                    \
          atomicAdd(&(bar)[XB_TMO], 1u);                            \
          break;                                                    \
        }                                                           \
      }                                                             \
    }                                                               \
  } while (0)
struct XcdBarrier {
  unsigned* bar;
  unsigned x;
  volatile unsigned* st;
};
DI void xcd_barrier_complete(unsigned* bar, unsigned x, unsigned& nloc, unsigned& nx) {
  const unsigned G = gridDim.x;
  unsigned sum, cnt, mine, sp = 0u;
  for (;;) {
    sum = 0u; cnt = 0u; mine = 0u;
#pragma unroll
    for (unsigned j = 0; j < 16; ++j) {
      const unsigned c = xb_ld(&bar[XB_XCNT(j)]);
      sum += c;
      cnt += (c > 0u) ? 1u : 0u;
      mine = (j == x) ? c : mine;
    }
    if (sum == G) break;
    __builtin_amdgcn_s_sleep(1);
    if ((++sp & 255u) == 0u) {
      if (xb_ld(&bar[XB_TMO])) break;
      if (sp > XB_SPIN_CAP) { atomicAdd(&bar[XB_TMO], 1u); break; }
    }
  }
  nloc = mine > 0u ? mine : 1u;
  nx = cnt > 0u ? cnt : 1u;
}
DI void xcd_barrier(char* ws, volatile unsigned* st) {
  asm volatile("" : "+s"(ws));
  XcdBarrier b;
  b.bar = (unsigned*)(ws + OFF_BAR);
  b.x = xb_xcc_id();
  b.st = st;
  asm volatile("s_waitcnt vmcnt(0)" ::: "memory");
  __syncthreads();
  if (threadIdx.x == 0) {
    unsigned* bar = b.bar;
    __builtin_amdgcn_s_waitcnt(0);
    unsigned nloc = b.st[0], nx = b.st[1];
    if (nloc == 0u) {
      xcd_barrier_complete(bar, b.x, nloc, nx);
      b.st[0] = nloc;
      b.st[1] = nx;
    }
    const unsigned old = xb_add(&bar[XB_XSUB(b.x)], 1u);
    const unsigned gen = old / nloc;
    if (old + 1u == (gen + 1u) * nloc) {
      __builtin_amdgcn_fence(__ATOMIC_RELEASE, "agent");
      asm volatile("s_waitcnt vmcnt(0)" ::: "memory");
      const unsigned og = xb_add(&bar[XB_TOP], 1u);
      const unsigned tg = og / nx;
      if (og + 1u == (tg + 1u) * nx) xb_add(&bar[XB_TOPGEN], 1u);
      else XB_SPIN(xb_ld(&bar[XB_TOPGEN]) == tg, bar);
      __builtin_amdgcn_fence(__ATOMIC_ACQUIRE, "agent");
      xb_add(&bar[XB_XGEN(b.x)], 1u);
      asm volatile("s_waitcnt vmcnt(0)" ::: "memory");
    } else {
      XB_SPIN(xb_ld(&bar[XB_XGEN(b.x)]) == gen, bar);
      __builtin_amdgcn_fence(__ATOMIC_ACQUIRE, "agent");
      asm volatile("s_waitcnt vmcnt(0)" ::: "memory");
    }
  }
  __syncthreads();
}

__global__ void __launch_bounds__(512) mega(Params p) {
  __shared__ __attribute__((aligned(16))) char smem[SMEM_BYTES];
  __shared__ __attribute__((aligned(16))) unsigned xb_words[4];
  __shared__ int s_item;
  cg::grid_group grid = cg::this_grid();
  if (threadIdx.x == 0) { xb_words[0] = 0u; xb_words[1] = 0u; xb_words[2] = 0u; xb_words[3] = 0u; }
  __syncthreads();
  if (threadIdx.x == 0) (void)xb_add(&((unsigned*)(p.ws + OFF_BAR))[XB_XCNT(xb_xcc_id())], 1u);
  phase0(p, smem);
  grid.sync();
#pragma unroll 1
  for (int layer = 0; layer < DEPTH; ++layer) {
#pragma unroll 1
    for (int grp = 0; grp < 2; ++grp) {
      int ly = layer, gp = grp;
      asm volatile("" : "+s"(ly), "+s"(gp));
      p1a(p, ly, gp, smem);
      xcd_barrier(p.ws, xb_words);
      asm volatile("" : "+s"(ly), "+s"(gp));
      p1b(p, ly, gp, smem);
      xcd_barrier(p.ws, xb_words);
      asm volatile("" : "+s"(ly), "+s"(gp));
      p2(p, ly, gp, smem, &s_item);
      xcd_barrier(p.ws, xb_words);
      asm volatile("" : "+s"(ly), "+s"(gp));
      p3a(p, ly, gp, smem);
      xcd_barrier(p.ws, xb_words);
      asm volatile("" : "+s"(ly), "+s"(gp));
      p3b(p, ly, gp, smem);
      xcd_barrier(p.ws, xb_words);
    }
  }
  final_norm(p);
}

extern "C" void kernel_launch(void* const* d_in, const int* in_sizes, int n_in, void* d_out, int out_size, void* d_ws,
                              size_t ws_size, hipStream_t stream) {
  static int grid_blocks = 0;
  if (!grid_blocks) {
    int dev = 0, cus = 0, per_cu = 0;
    hipGetDevice(&dev);
    hipDeviceGetAttribute(&cus, hipDeviceAttributeMultiprocessorCount, dev);
    hipOccupancyMaxActiveBlocksPerMultiprocessor(&per_cu, mega, 512, 0);
    if (per_cu < 1) per_cu = 1;
    if (per_cu > 1) per_cu = 1;
    grid_blocks = cus * per_cu;
  }
  Params p{};
  const float** pp = (const float**)&p;
  for (int i = 0; i < 27; ++i) pp[i] = (const float*)d_in[i];
  p.out = (float*)d_out;
  p.ws = (char*)d_ws;
  if (ws_size < WS_NEEDED) fprintf(stderr, "workspace too small: %zu < %zu\n", ws_size, (size_t)WS_NEEDED);
  hipMemsetAsync(d_ws, 0, ZERO_BYTES, stream);
  void* args[] = {&p};
  hipError_t e = hipLaunchCooperativeKernel((void*)mega, dim3(grid_blocks), dim3(512), args, 0, stream);
  if (e != hipSuccess) fprintf(stderr, "cooperative launch failed: %s (grid %d)\n", hipGetErrorString(e), grid_blocks);
}
```
